# Optimizing an MI355X kernel written in HIP

```python
import math
import jax, jax.numpy as jnp
from jax import lax
import numpy as np

D_MODEL = 1024
BATCH = 16
SEQ = 4096
DEPTH = 4

CHUNK = 64
D_PLE = 256
W_BRANCH = D_MODEL // 2
N_BRANCH_COLS = 6 * W_BRANCH
CONV_A_WIDTH = 31
GMLP_BLOCK = 2 * CHUNK
N_HEADS_B = 8
HEAD_DIM_B = W_BRANCH // N_HEADS_B
POOL_WINDOWS = (2, 4, 8, 16)
N_GROUPS_C = len(POOL_WINDOWS)
GROUP_DIM_C = W_BRANCH // N_GROUPS_C
CONV_D_WIDTH = 3
DEEPNORM_ALPHA = (2.0 * DEPTH) ** 0.25
DEEPNORM_BETA = (8.0 * DEPTH) ** -0.25
LN_EPS = 1e-5

kernel_name = 'hybrid_conv_gmlp_pool_shortconv_deepnorm'


def layer_norm(x, g, b):
    xf = x.astype(jnp.float32)
    mu = jnp.mean(xf, axis=-1, keepdims=True)
    var = jnp.mean(jnp.square(xf - mu), axis=-1, keepdims=True)
    y = (xf - mu) * lax.rsqrt(var + LN_EPS)
    return (y * g.astype(jnp.float32) + b.astype(jnp.float32)).astype(x.dtype)


def causal_depthwise_conv(x, w):
    k, c = w.shape
    return lax.conv_general_dilated(
        x, w[:, None, :], window_strides=(1,), padding=[(k - 1, 0)],
        dimension_numbers=('NWC', 'WIO', 'NWC'), feature_group_count=c)


def even_mixer(x, w_in, b_in, conv_w, conv_b, ln_a_g, ln_a_b, ln_v_g, ln_v_b, w_s, b_s, w_out, b_out):
    bt, s, _ = x.shape
    z = jnp.einsum('bsd,de->bse', x, w_in) + b_in
    a_val, a_glu, a_gate, u, v, g_gate = jnp.split(z, 6, axis=-1)
    a = a_val * jax.nn.sigmoid(a_glu)
    a = causal_depthwise_conv(a, conv_w) + conv_b
    a = jax.nn.silu(layer_norm(a, ln_a_g, ln_a_b)) * jax.nn.silu(a_gate)
    u = jax.nn.gelu(u)
    v = layer_norm(jax.nn.gelu(v), ln_v_g, ln_v_b)
    v = v.reshape(bt, s // GMLP_BLOCK, GMLP_BLOCK, N_HEADS_B, HEAD_DIM_B)
    mask = jnp.tril(jnp.ones((GMLP_BLOCK, GMLP_BLOCK), dtype=bool))
    w_s = jnp.where(mask[None], w_s, jnp.zeros_like(w_s))
    sg = jnp.einsum('hts,bnshd->bnthd', w_s, v) + b_s.T[:, :, None]
    g = u * sg.reshape(bt, s, W_BRANCH) * jax.nn.silu(g_gate)
    y = jnp.concatenate([a, g], axis=-1)
    return jnp.einsum('bse,ed->bsd', y, w_out) + b_out


def odd_mixer(x, w_in, b_in, w_pool, pool_scale, conv_w, w_out, b_out):
    bt, s, _ = x.shape
    z = jnp.einsum('bsd,de->bse', x, w_in) + b_in
    c_val, c_gate, d_h, d_b, d_c, d_gate = jnp.split(z, 6, axis=-1)
    vg = c_val.reshape(bt, s, N_GROUPS_C, GROUP_DIM_C)
    cs = jnp.cumsum(vg.astype(jnp.float32), axis=1)
    pos = jnp.arange(1, s + 1, dtype=jnp.float32)
    means = []
    for gi, win in enumerate(POOL_WINDOWS):
        c_g = cs[:, :, gi]
        lag = jnp.pad(c_g, ((0, 0), (win, 0), (0, 0)))[:, :s]
        means.append((c_g - lag) / jnp.minimum(pos, float(win))[:, None])
    pooled = jnp.stack(means, axis=2).astype(vg.dtype) - vg
    c = jnp.einsum('bsgc,gce->bsge', pooled, w_pool).reshape(bt, s, W_BRANCH) * pool_scale
    c = c * jax.nn.silu(c_gate)
    d = d_b * causal_depthwise_conv(d_c * d_h, conv_w)
    d = d * jax.nn.silu(d_gate)
    y = jnp.concatenate([c, d], axis=-1)
    return jnp.einsum('bse,ed->bsd', y, w_out) + b_out


def setup_inputs(seed: int = 0) -> dict:
    key = jax.random.key(seed)
    ks = jax.random.split(key, 26)
    ne = (DEPTH + 1) // 2
    no = DEPTH // 2
    f32 = jnp.float32
    nrm = lambda k, shape, scale: jax.random.normal(k, shape, f32) * scale
    return {
        'x': nrm(ks[0], (BATCH, SEQ, D_MODEL), 1.0),
        'p': nrm(ks[1], (DEPTH, BATCH, SEQ, D_PLE), 1.0),
        'w_in_e': nrm(ks[2], (ne, D_MODEL, N_BRANCH_COLS), D_MODEL ** -0.5),
        'b_in_e': nrm(ks[3], (ne, N_BRANCH_COLS), 0.02),
        'conv_a_w': nrm(ks[4], (ne, CONV_A_WIDTH, W_BRANCH), CONV_A_WIDTH ** -0.5),
        'conv_a_b': nrm(ks[5], (ne, W_BRANCH), 0.02),
        'ln_a_g': 1.0 + nrm(ks[6], (ne, W_BRANCH), 0.05),
        'ln_a_b': nrm(ks[7], (ne, W_BRANCH), 0.02),
        'ln_v_g': 1.0 + nrm(ks[8], (ne, W_BRANCH), 0.05),
        'ln_v_b': nrm(ks[9], (ne, W_BRANCH), 0.02),
        'w_s': nrm(ks[10], (ne, N_HEADS_B, GMLP_BLOCK, GMLP_BLOCK), 0.5 * GMLP_BLOCK ** -0.5),
        'b_s': 1.0 + nrm(ks[11], (ne, N_HEADS_B, GMLP_BLOCK), 0.1),
        'w_out_e': nrm(ks[12], (ne, 2 * W_BRANCH, D_MODEL), DEEPNORM_BETA * (2 * W_BRANCH) ** -0.5),
        'b_out_e': nrm(ks[13], (ne, D_MODEL), 0.02),
        'w_in_o': nrm(ks[14], (no, D_MODEL, N_BRANCH_COLS), D_MODEL ** -0.5),
        'b_in_o': nrm(ks[15], (no, N_BRANCH_COLS), 0.02),
        'w_pool': nrm(ks[16], (no, N_GROUPS_C, GROUP_DIM_C, GROUP_DIM_C), GROUP_DIM_C ** -0.5),
        'pool_scale': 1.0 + nrm(ks[17], (no, W_BRANCH), 0.1),
        'conv_d_w': nrm(ks[18], (no, CONV_D_WIDTH, W_BRANCH), CONV_D_WIDTH ** -0.5),
        'w_out_o': nrm(ks[19], (no, 2 * W_BRANCH, D_MODEL), DEEPNORM_BETA * (2 * W_BRANCH) ** -0.5),
        'b_out_o': nrm(ks[20], (no, D_MODEL), 0.02),
        'ln_g': 1.0 + nrm(ks[21], (DEPTH, D_MODEL), 0.05),
        'ln_b': nrm(ks[22], (DEPTH, D_MODEL), 0.02),
        'w_ple': nrm(ks[23], (DEPTH, D_PLE, D_MODEL), D_PLE ** -0.5),
        'w_ple_gate': nrm(ks[24], (DEPTH, D_MODEL, D_MODEL), D_MODEL ** -0.5),
        'b_ple_gate': nrm(ks[25], (DEPTH, D_MODEL), 0.02),
    }


def reference(x, p, w_in_e, b_in_e, conv_a_w, conv_a_b, ln_a_g, ln_a_b, ln_v_g, ln_v_b, w_s, b_s,
              w_out_e, b_out_e, w_in_o, b_in_o, w_pool, pool_scale, conv_d_w, w_out_o, b_out_o,
              ln_g, ln_b, w_ple, w_ple_gate, b_ple_gate):
    for i in range(DEPTH):
        j = i // 2
        if i % 2 == 0:
            out = even_mixer(x, w_in_e[j], b_in_e[j], conv_a_w[j], conv_a_b[j], ln_a_g[j], ln_a_b[j],
                             ln_v_g[j], ln_v_b[j], w_s[j], b_s[j], w_out_e[j], b_out_e[j])
        else:
            out = odd_mixer(x, w_in_o[j], b_in_o[j], w_pool[j], pool_scale[j], conv_d_w[j],
                            w_out_o[j], b_out_o[j])
        h = layer_norm(DEEPNORM_ALPHA * x + out, ln_g[i], ln_b[i])
        gate = jax.nn.sigmoid(jnp.einsum('bsd,de->bse', h, w_ple_gate[i]) + b_ple_gate[i])
        x = h + gate * jnp.einsum('bsk,kd->bsd', p[i], w_ple[i])
    return x
```

```cpp
#include <hip/hip_runtime.h>
#include <hip/hip_cooperative_groups.h>
#include <cstdio>
namespace cg = cooperative_groups;
namespace pg8 {
#define PG8_LAS __attribute__((address_space(3)))
typedef unsigned short bf16_t;
typedef short bf16x8 __attribute__((ext_vector_type(8)));
typedef float f32x4 __attribute__((ext_vector_type(4)));
typedef unsigned u32x4 __attribute__((ext_vector_type(4)));
constexpr int BM = 256, BK = 64, HALF = 128, HTB = HALF * BK * 2  , STAGE_BYTES = 8 * HTB, NXCD = 8, WGM = 8;

__host__ __device__ __forceinline__ int lds_byte(int r, int c) { const int st = (r >> 4) * 2 + (c >> 5), rr = r & 15, cc = c & 31, ob = rr * 64 + cc * 2; return st * 1024 + (ob ^ (((ob >> 9) & 1) << 5)); }
__host__ __device__ __forceinline__ void stage_rc(int b, int& R, int& C) { const int st = b / 1024, sb = b % 1024, swz = sb ^ (((sb >> 9) & 1) << 5); R = (st >> 1) * 16 + swz / 64; C = (st & 1) * 32 + (swz % 64) / 2; }
__host__ __device__ __forceinline__ int perm32(int rho) { const int n = rho >> 4, i = rho & 15; return 8 * (i >> 2) + 4 * n + (i & 3); }

struct Unit { int pm, pn; };
struct Gemm { const bf16_t* A; const bf16_t* Bt; int M, N, K; };

struct StaticOrder {
    int nM, nN, nwg, G, c;
    __host__ __device__ void init(int M, int N, int G_, int c_) { nM = M / BM; nN = N / BM; nwg = nM * nN; G = G_; c = c_; }
    __host__ __device__ bool next(int i, Unit& u) const {
        const long L = (long)i * G + c; if (L >= nwg) return false;
        int wgid = (int)L; { const int q = nwg / NXCD, r = nwg % NXCD, xcd = wgid % NXCD, off = wgid / NXCD; wgid = (xcd < r ? xcd * (q + 1) : r * (q + 1) + (xcd - r) * q) + off; }
        const int nig = WGM * nN, gid = wgid / nig, fm = gid * WGM, gsz = (nM - fm) < WGM ? (nM - fm) : WGM;
        u.pm = fm + ((wgid % nig) % gsz); u.pn = (wgid % nig) / gsz; return true;
    }
    __device__ __forceinline__ void a_ready(const Unit&) const {}
    __device__ __forceinline__ void done(const Unit&) const {}
};
__device__ __forceinline__ unsigned cvt_pk_bf16(float lo, float hi) { unsigned r; asm volatile("v_cvt_pk_bf16_f32 %0, %1, %2" : "=v"(r) : "v"(lo), "v"(hi)); return r; }
typedef float f32x2 __attribute__((ext_vector_type(2)));
__device__ __forceinline__ f32x2 gelu_pk(f32x2 v) {
    const f32x2 av = __builtin_elementwise_abs(v), d = av * 0.2316418882f + 1.0f;
    f32x2 t; t.x = __builtin_amdgcn_rcpf(d.x); t.y = __builtin_amdgcn_rcpf(d.y);
    f32x2 q = t * 0.5307027145f + (-0.7265760135f); q = q * t + 0.7107068705f; q = q * t + (-0.142248368f); q = q * t + 0.127414796f; q = q * t;
    const f32x2 s = (v * v) * (-0.72134752044f);
    f32x2 e; e.x = __builtin_amdgcn_exp2f(s.x); e.y = __builtin_amdgcn_exp2f(s.y);
    const f32x2 m = v * (q * e), r = v - m;
    f32x2 o; o.x = v.x < 0.f ? m.x : r.x; o.y = v.y < 0.f ? m.y : r.y; return o;
}

struct EpiF32 {
    static constexpr bool PERM = false, AFTER_DRAIN = false;
    float* C; int ldc; const float* bias;
    __device__ __forceinline__ void operator()(const f32x4 (&acc)[2][2][4][2], const Unit& u, int wr, int wc, int fr, int fq) const {
        const int row0 = u.pm * BM + wr * 64 + fr, col0 = u.pn * BM + wc * 32 + 4 * fq;
        f32x4 bv[2][2];
#pragma unroll
        for (int bj = 0; bj < 2; ++bj)
#pragma unroll
            for (int n = 0; n < 2; ++n) bv[bj][n] = bias ? *(const f32x4*)(bias + col0 + bj * HALF + n * 16) : (f32x4){0.f, 0.f, 0.f, 0.f};
#pragma unroll
        for (int ai = 0; ai < 2; ++ai)
#pragma unroll
            for (int m = 0; m < 4; ++m) { float* rowp = C + (size_t)(row0 + ai * HALF + m * 16) * ldc + col0;
#pragma unroll
                for (int bj = 0; bj < 2; ++bj)
#pragma unroll
                    for (int n = 0; n < 2; ++n) *(f32x4*)(rowp + bj * HALF + n * 16) = acc[ai][bj][m][n] + bv[bj][n]; }
    }
};
template <int ACT  > struct EpiBf16 {
    static constexpr bool PERM = true, AFTER_DRAIN = false;
    bf16_t* O; int ldc; const float* bias; int split_cols; size_t split_stride;
    __device__ __forceinline__ void operator()(const f32x4 (&acc)[2][2][4][2], const Unit& u, int wr, int wc, int fr, int fq) const {
        const int row0 = u.pm * BM + wr * 64 + fr; int colt = u.pn * BM; bf16_t* base = O;
        if (split_cols) { const int t = colt / split_cols; base += (size_t)t * split_stride; colt -= t * split_cols; }
        const int col0 = colt + wc * 32 + 8 * fq, bcol0 = u.pn * BM + wc * 32 + 8 * fq;
        f32x4 bv[2][2];
#pragma unroll
        for (int bj = 0; bj < 2; ++bj)
#pragma unroll
            for (int n = 0; n < 2; ++n) bv[bj][n] = bias ? *(const f32x4*)(bias + bcol0 + bj * HALF + 4 * n) : (f32x4){0.f, 0.f, 0.f, 0.f};
#pragma unroll
        for (int ai = 0; ai < 2; ++ai)
#pragma unroll
            for (int m = 0; m < 4; ++m) { bf16_t* rowp = base + (size_t)(row0 + ai * HALF + m * 16) * ldc + col0;
#pragma unroll
                for (int bj = 0; bj < 2; ++bj) { f32x4 v0 = acc[ai][bj][m][0] + bv[bj][0], v1 = acc[ai][bj][m][1] + bv[bj][1];
                    if (ACT == 1) { f32x2 a = gelu_pk((f32x2){v0[0], v0[1]}), b = gelu_pk((f32x2){v0[2], v0[3]}), c = gelu_pk((f32x2){v1[0], v1[1]}), d = gelu_pk((f32x2){v1[2], v1[3]});
                        v0 = (f32x4){a.x, a.y, b.x, b.y}; v1 = (f32x4){c.x, c.y, d.x, d.y}; }
                    if (ACT == 2) {
#pragma unroll
                        for (int j = 0; j < 4; ++j) { v0[j] = 0.5f * v0[j] * (1.0f + erff(v0[j] * 0.70710678f)); v1[j] = 0.5f * v1[j] * (1.0f + erff(v1[j] * 0.70710678f)); } }
                    u32x4 w; w.x = cvt_pk_bf16(v0[0], v0[1]); w.y = cvt_pk_bf16(v0[2], v0[3]); w.z = cvt_pk_bf16(v1[0], v1[1]); w.w = cvt_pk_bf16(v1[2], v1[3]);
                    *(u32x4*)(rowp + bj * HALF) = w; } }
    }
};
template <class Epi, class Sched, bool STAMP = false>
__device__ __forceinline__ void gemm_phase(PG8_LAS unsigned char* lds, const Gemm g, const Sched& S, const Epi& E, unsigned long long* stamps) {
    int tid_ = threadIdx.x; asm volatile("" : "+v"(tid_));
    const int tid = tid_, wid = __builtin_amdgcn_readfirstlane(tid >> 6), lane = tid & 63, wr = wid >> 2, wc = wid & 3, fr = lane & 15, fq = lane >> 4;
    const int K = g.K, nt = K / BK;
    int ts_lo = 0, ts_hi = 0, nts = 0; const unsigned long long rt_entry = STAMP ? (unsigned long long)wall_clock64() : 0ull;
#define PG8_STAMP() do { if (STAMP && wid == 0 && nts < 64) { const unsigned long long _c = (unsigned long long)clock64(); \
        ts_lo = (lane == nts) ? (int)(unsigned)_c : ts_lo; ts_hi = (lane == nts) ? (int)(unsigned)(_c >> 32) : ts_hi; ++nts; } } while (0)
    PG8_STAMP();
    unsigned voffA[2], voffB[2];
#pragma unroll
    for (int i = 0; i < 2; ++i) { int R, C; stage_rc(tid * 16 + i * 8192, R, C); const int Rb = Epi::PERM ? ((R & ~31) + perm32(R & 31)) : R;
        voffA[i] = (unsigned)(R * K + C) * 2u; voffB[i] = (unsigned)(Rb * K + C) * 2u; }
    const size_t kstep = (size_t)(BK * 2);
    const size_t hstep = (size_t)HALF * K * 2;
    const size_t tstep = 2 * hstep;
    const unsigned ldsw = (unsigned)wid * 1024u;
    const int aoff = lds_byte(wr * 64 + fr, fq * 8), boff = lds_byte(wc * 32 + fr, fq * 8);
#define PG8_SA(b, h) (((b) * 2 + (h)) * HTB)
#define PG8_SB(b, h) ((4 + (b) * 2 + (h)) * HTB)
#define PG8_STAGE(bufoff, gbase, voff) do { _Pragma("unroll") for (int _i = 0; _i < 2; ++_i) \
        __builtin_amdgcn_global_load_lds((const unsigned*)((const char*)(gbase) + (voff)[_i]), (PG8_LAS unsigned*)(lds + (bufoff) + ldsw + _i * 8192), 16, 0, 0); } while (0)
#define PG8_LDA(dst, b, h) do { _Pragma("unroll") for (int m = 0; m < 4; ++m) _Pragma("unroll") for (int k = 0; k < 2; ++k) dst[m][k] = *(const PG8_LAS bf16x8*)(lds + PG8_SA(b, h) + aoff + m * 2048 + k * 1024); } while (0)
#define PG8_LDB(dst, b, h) do { _Pragma("unroll") for (int n = 0; n < 2; ++n) _Pragma("unroll") for (int k = 0; k < 2; ++k) dst[n][k] = *(const PG8_LAS bf16x8*)(lds + PG8_SB(b, h) + boff + n * 2048 + k * 1024); } while (0)
#define PG8_MMA(ai, bj, At, Bt) do { __builtin_amdgcn_s_setprio(1); _Pragma("unroll") for (int m = 0; m < 4; ++m) _Pragma("unroll") for (int n = 0; n < 2; ++n) _Pragma("unroll") for (int k = 0; k < 2; ++k) \
        acc[ai][bj][m][n] = __builtin_amdgcn_mfma_f32_16x16x32_bf16(Bt[n][k], At[m][k], acc[ai][bj][m][n], 0, 0, 0); __builtin_amdgcn_s_setprio(0); } while (0)
#define PG8_WAIT_V(n) asm volatile("s_waitcnt vmcnt(" #n ")" ::: "memory")
#define PG8_WAIT_L(n) asm volatile("s_waitcnt lgkmcnt(" #n ")" ::: "memory")
#define PG8_BAR __builtin_amdgcn_s_barrier()
#define PG8_SCHED __builtin_amdgcn_sched_barrier(0)
    Unit cur, nxt; int ui = 0;
    if (!S.next(0, cur)) return;
    f32x4 acc[2][2][4][2];
#pragma unroll
    for (int a = 0; a < 2; ++a)
#pragma unroll
        for (int b = 0; b < 2; ++b)
#pragma unroll
            for (int m = 0; m < 4; ++m)
#pragma unroll
                for (int n = 0; n < 2; ++n) acc[a][b][m][n] = (f32x4){0.f, 0.f, 0.f, 0.f};
    bf16x8 At[4][2], B0[2][2], B1[2][2];
    const char* cA = (const char*)g.A + (size_t)cur.pm * tstep; const char* cB = (const char*)g.Bt + (size_t)cur.pn * tstep;
    S.a_ready(cur);
    PG8_STAGE(PG8_SB(0, 0), cB, voffB); PG8_STAGE(PG8_SA(0, 0), cA, voffA); PG8_STAGE(PG8_SB(0, 1), cB + hstep, voffB); PG8_STAGE(PG8_SA(0, 1), cA + hstep, voffA);
    if (wr == 1) PG8_BAR;
    PG8_WAIT_V(4); PG8_BAR;
    PG8_STAGE(PG8_SB(1, 0), cB + kstep, voffB); PG8_STAGE(PG8_SA(1, 0), cA + kstep, voffA); PG8_STAGE(PG8_SB(1, 1), cB + hstep + kstep, voffB);
    PG8_WAIT_V(6); PG8_BAR;
    PG8_STAMP();
    for (;;) {
        const bool has_next = S.next(ui + 1, nxt);
        const char* nA = has_next ? (const char*)g.A + (size_t)nxt.pm * tstep : cA; const char* nB = has_next ? (const char*)g.Bt + (size_t)nxt.pn * tstep : cB;
        for (int t = 0; t < nt; t += 2) {
            const bool last = (t == nt - 2);
            const char* a1 = cA + (size_t)(t + 1) * kstep;
            const char* a2 = last ? nA : cA + (size_t)(t + 2) * kstep; const char* b2 = last ? nB : cB + (size_t)(t + 2) * kstep;
            const char* a3 = a2 + kstep; const char* b3 = b2 + kstep;
            if (last && has_next) S.a_ready(nxt);
            PG8_LDB(B0, 0, 0); PG8_SCHED; PG8_LDA(At, 0, 0); PG8_STAGE(PG8_SA(1, 1), a1 + hstep, voffA);
            PG8_WAIT_L(8); PG8_BAR; PG8_WAIT_L(0); PG8_MMA(0, 0, At, B0); PG8_BAR; PG8_SCHED;
            PG8_LDB(B1, 0, 1); PG8_STAGE(PG8_SB(0, 0), b2, voffB);
            PG8_BAR; PG8_WAIT_L(0); PG8_MMA(0, 1, At, B1); PG8_BAR;
            PG8_LDA(At, 0, 1); PG8_STAGE(PG8_SA(0, 0), a2, voffA);
            PG8_BAR; PG8_WAIT_L(0); PG8_MMA(1, 0, At, B0); PG8_BAR; PG8_SCHED;
            PG8_STAGE(PG8_SB(0, 1), b2 + hstep, voffB);
            PG8_WAIT_V(6); PG8_BAR; PG8_MMA(1, 1, At, B1); PG8_BAR;
            PG8_LDB(B0, 1, 0); PG8_SCHED; PG8_LDA(At, 1, 0); PG8_STAGE(PG8_SA(0, 1), a2 + hstep, voffA);
            PG8_WAIT_L(8); PG8_BAR; PG8_WAIT_L(0); PG8_MMA(0, 0, At, B0); PG8_BAR; PG8_SCHED;
            PG8_LDB(B1, 1, 1); PG8_STAGE(PG8_SB(1, 0), b3, voffB);
            PG8_BAR; PG8_WAIT_L(0); PG8_MMA(0, 1, At, B1); PG8_BAR;
            PG8_LDA(At, 1, 1); PG8_STAGE(PG8_SA(1, 0), a3, voffA);
            PG8_BAR; PG8_WAIT_L(0); PG8_MMA(1, 0, At, B0); PG8_BAR; PG8_SCHED;
            PG8_STAGE(PG8_SB(1, 1), b3 + hstep, voffB);
            PG8_WAIT_V(6); PG8_BAR; PG8_MMA(1, 1, At, B1); PG8_BAR;
        }
        PG8_STAMP();
        if constexpr (!Epi::AFTER_DRAIN) { E(acc, cur, wr, wc, fr, fq); S.done(cur); }
        PG8_STAMP();
        if (!has_next) break;
#pragma unroll
        for (int a = 0; a < 2; ++a)
#pragma unroll
            for (int b = 0; b < 2; ++b)
#pragma unroll
                for (int m = 0; m < 4; ++m)
#pragma unroll
                    for (int n = 0; n < 2; ++n) acc[a][b][m][n] = (f32x4){0.f, 0.f, 0.f, 0.f};
        cur = nxt; cA = nA; cB = nB; ++ui;
    }
    PG8_WAIT_V(0);
    if (wr == 0) PG8_BAR;
    PG8_BAR;
    if constexpr (Epi::AFTER_DRAIN) { E.fused(acc, cur, wr, wc, fr, fq, lds, wid, lane); S.done(cur); }
    PG8_STAMP();
    if (STAMP && wid == 0) { stamps[lane] = lane < nts ? (((unsigned long long)(unsigned)ts_hi << 32) | (unsigned)ts_lo) : 0ull;
        if (lane == 62) stamps[62] = rt_entry; if (lane == 63) stamps[63] = (unsigned long long)wall_clock64(); }
#undef PG8_STAMP
#undef PG8_SA
#undef PG8_SB
#undef PG8_STAGE
#undef PG8_LDA
#undef PG8_LDB
#undef PG8_MMA
#undef PG8_WAIT_V
#undef PG8_WAIT_L
#undef PG8_BAR
#undef PG8_SCHED
}
}

namespace mk {
using pg8::bf16_t; using pg8::bf16x8; using pg8::f32x4; using pg8::u32x4;
typedef unsigned u32x2 __attribute__((ext_vector_type(2)));
typedef short bf16x4 __attribute__((ext_vector_type(4)));
#define MK_LAS __attribute__((address_space(3)))
constexpr int M = 65536, D = 1024, NB = 3072, DP = 256, SEQ = 4096, WB = 512, DEPTH = 4;
constexpr float LN_EPS = 1e-5f;
constexpr float ALPHA = 1.681792830507429f;
constexpr int NTHREADS = 512, NWAVES = 8;
constexpr int LDS_BYTES = 147456;
constexpr int LDS_RED = 139264;
constexpr int VT_STRIDE = 132;
constexpr size_t WS_WIN = 0;
constexpr size_t WS_WOUT = WS_WIN + (size_t)4 * NB * D * 2;
constexpr size_t WS_WGATE = WS_WOUT + (size_t)4 * D * D * 2;
constexpr size_t WS_WPLE = WS_WGATE + (size_t)4 * D * D * 2;
constexpr size_t WS_WS = WS_WPLE + (size_t)4 * D * DP * 2;
constexpr size_t WS_WP = WS_WS + (size_t)2 * 8 * 128 * 128 * 2;
constexpr size_t WS_XB = WS_WP + (size_t)2 * 4 * 128 * 128 * 2;
constexpr size_t WS_PB = WS_XB + (size_t)M * D * 2;
constexpr size_t WS_Z = WS_PB + (size_t)4 * M * DP * 2;
constexpr size_t WS_Y = WS_Z + (size_t)M * NB * 2;
constexpr size_t WS_END = WS_Y + (size_t)M * D * 2;

struct Params { const float* in[26]; float* out; unsigned char* ws; };

__device__ __forceinline__ float bf2f(unsigned short b) { return __uint_as_float((unsigned)b << 16); }
__device__ __forceinline__ float bflo(unsigned w) { return __uint_as_float(w << 16); }
__device__ __forceinline__ float bfhi(unsigned w) { return __uint_as_float(w & 0xffff0000u); }
__device__ __forceinline__ unsigned short f2bf(float f) { unsigned u = __float_as_uint(f); u += 0x7FFFu + ((u >> 16) & 1u); return (unsigned short)(u >> 16); }
__device__ __forceinline__ unsigned pk2(float lo, float hi) { return (unsigned)f2bf(lo) | ((unsigned)f2bf(hi) << 16); }
__device__ __forceinline__ float sigmoidf_(float x) { return __builtin_amdgcn_rcpf(1.0f + __expf(-x)); }
__device__ __forceinline__ float siluf_(float x) { return x * sigmoidf_(x); }
__device__ __forceinline__ float geluf_(float x) { return x * sigmoidf_(1.5957691216057308f * (x + 0.044715f * x * x * x)); }
__device__ __forceinline__ float wave_sum(float v) {
#pragma unroll
    for (int o = 1; o < 64; o <<= 1) v += __shfl_xor(v, o);
    return v;
}

struct EpiRes {
    static constexpr bool PERM = false, AFTER_DRAIN = false;
    const float* res; float* X; const float* bias;
    __device__ __forceinline__ void operator()(const f32x4 (&acc)[2][2][4][2], const pg8::Unit& u, int wr, int wc, int fr, int fq) const {
        const int row0 = u.pm * 256 + wr * 64 + fr, col0 = u.pn * 256 + wc * 32 + 4 * fq;
        f32x4 bv[2][2];
#pragma unroll
        for (int bj = 0; bj < 2; ++bj)
#pragma unroll
            for (int n = 0; n < 2; ++n) bv[bj][n] = *(const f32x4*)(bias + col0 + bj * 128 + n * 16);
#pragma unroll
        for (int ai = 0; ai < 2; ++ai)
#pragma unroll
            for (int m = 0; m < 4; ++m) { const size_t off = (size_t)(row0 + ai * 128 + m * 16) * D + col0;
#pragma unroll
                for (int bj = 0; bj < 2; ++bj)
#pragma unroll
                    for (int n = 0; n < 2; ++n) { const f32x4 r = *(const f32x4*)(res + off + bj * 128 + n * 16);
                        *(f32x4*)(X + off + bj * 128 + n * 16) = acc[ai][bj][m][n] + bv[bj][n] + r * ALPHA; }
                asm volatile("" ::: "memory"); }
    }
};
struct EpiGate {
    static constexpr bool PERM = false, AFTER_DRAIN = false;
    float* X; const bf16_t* ple; bf16_t* xb; const float* bias;
    __device__ __forceinline__ void operator()(const f32x4 (&acc)[2][2][4][2], const pg8::Unit& u, int wr, int wc, int fr, int fq) const {
        const int row0 = u.pm * 256 + wr * 64 + fr, col0 = u.pn * 256 + wc * 32 + 4 * fq;
        f32x4 bv[2][2];
#pragma unroll
        for (int bj = 0; bj < 2; ++bj)
#pragma unroll
            for (int n = 0; n < 2; ++n) bv[bj][n] = *(const f32x4*)(bias + col0 + bj * 128 + n * 16);
#pragma unroll
        for (int ai = 0; ai < 2; ++ai)
#pragma unroll
            for (int m = 0; m < 4; ++m) { const size_t off = (size_t)(row0 + ai * 128 + m * 16) * D + col0;
#pragma unroll
                for (int bj = 0; bj < 2; ++bj)
#pragma unroll
                    for (int n = 0; n < 2; ++n) { const size_t o = off + bj * 128 + n * 16;
                        const f32x4 h = *(const f32x4*)(X + o); const u32x2 pw = *(const u32x2*)(ple + o);
                        const f32x4 v = acc[ai][bj][m][n] + bv[bj][n];
                        f32x4 xn; xn[0] = h[0] + sigmoidf_(v[0]) * bflo(pw.x); xn[1] = h[1] + sigmoidf_(v[1]) * bfhi(pw.x);
                        xn[2] = h[2] + sigmoidf_(v[2]) * bflo(pw.y); xn[3] = h[3] + sigmoidf_(v[3]) * bfhi(pw.y);
                        *(f32x4*)(X + o) = xn; u32x2 w; w.x = pg8::cvt_pk_bf16(xn[0], xn[1]); w.y = pg8::cvt_pk_bf16(xn[2], xn[3]); *(u32x2*)(xb + o) = w; }
                asm volatile("" ::: "memory"); }
    }
};

__device__ __forceinline__ void p0_transpose_item(const float* W, int K, int N, bf16_t* WT, MK_LAS float* scr, int item, int lane) {
    const int nblk = N / 32, kb = item / nblk, nb = item % nblk, k0 = 64 * kb, n0 = 32 * nb;
#pragma unroll 8
    for (int i = 0; i < 32; ++i) { const int kk = 2 * i + (lane >> 5); scr[kk * 33 + (lane & 31)] = W[(size_t)(k0 + kk) * N + n0 + (lane & 31)]; }
    asm volatile("s_waitcnt lgkmcnt(0)" ::: "memory");
    const int c = lane & 7;
#pragma unroll
    for (int j = 0; j < 4; ++j) { const int n = (lane >> 3) + 8 * j; const MK_LAS float* s = scr + (8 * c) * 33 + n;
        u32x4 o; o.x = pk2(s[0 * 33], s[1 * 33]); o.y = pk2(s[2 * 33], s[3 * 33]); o.z = pk2(s[4 * 33], s[5 * 33]); o.w = pk2(s[6 * 33], s[7 * 33]);
        *(u32x4*)(WT + (size_t)(n0 + n) * K + k0 + 8 * c) = o; }
    asm volatile("s_waitcnt lgkmcnt(0)" ::: "memory");
}
__device__ __forceinline__ void cvt_rows(const float* src, bf16_t* dst, size_t n8, size_t i0, size_t stride) {
    for (size_t i = i0; i < n8; i += stride) { const f32x4 a = *(const f32x4*)(src + i * 8), b = *(const f32x4*)(src + i * 8 + 4);
        u32x4 o; o.x = pk2(a[0], a[1]); o.y = pk2(a[2], a[3]); o.z = pk2(b[0], b[1]); o.w = pk2(b[2], b[3]); *(u32x4*)(dst + i * 8) = o; }
}
__device__ __forceinline__ void p0_prologue(const Params& P, MK_LAS unsigned char* lds) {
    int tid_ = threadIdx.x; asm volatile("" : "+v"(tid_));
    const int tid = tid_, lane = tid & 63, wave = tid >> 6;
    MK_LAS float* scr = (MK_LAS float*)(lds + wave * 16384);
    const int gw = blockIdx.x * NWAVES + wave, NGW = gridDim.x * NWAVES;
    unsigned char* ws = P.ws;
    constexpr int I_IN = (D / 64) * (NB / 32), I_SQ = (D / 64) * (D / 32), I_PLE = (DP / 64) * (D / 32), I_POOL = (128 / 64) * (128 / 32);
    constexpr int PER_L = I_IN + 2 * I_SQ + I_PLE, NITEMS = 4 * PER_L + 8 * I_POOL;
    for (int it = gw; it < NITEMS; it += NGW) {
        if (it < 4 * PER_L) {
            const int l = it / PER_L, j = l >> 1; int r = it % PER_L;
            if (r < I_IN) { const float* W = ((l & 1) ? P.in[14] : P.in[2]) + (size_t)j * D * NB; p0_transpose_item(W, D, NB, (bf16_t*)(ws + WS_WIN) + (size_t)l * NB * D, scr, r, lane); continue; } r -= I_IN;
            if (r < I_SQ) { const float* W = ((l & 1) ? P.in[19] : P.in[12]) + (size_t)j * D * D; p0_transpose_item(W, D, D, (bf16_t*)(ws + WS_WOUT) + (size_t)l * D * D, scr, r, lane); continue; } r -= I_SQ;
            if (r < I_SQ) { p0_transpose_item(P.in[24] + (size_t)l * D * D, D, D, (bf16_t*)(ws + WS_WGATE) + (size_t)l * D * D, scr, r, lane); continue; } r -= I_SQ;
            p0_transpose_item(P.in[23] + (size_t)l * DP * D, DP, D, (bf16_t*)(ws + WS_WPLE) + (size_t)l * D * DP, scr, r, lane);
        } else {
            const int r = it - 4 * PER_L, mtx = r / I_POOL;
            p0_transpose_item(P.in[16] + (size_t)mtx * 128 * 128, 128, 128, (bf16_t*)(ws + WS_WP) + (size_t)mtx * 128 * 128, scr, r % I_POOL, lane);
        }
    }
    const size_t gt = (size_t)blockIdx.x * NTHREADS + tid, GT = (size_t)gridDim.x * NTHREADS;
    for (size_t i = gt; i < (size_t)2 * 8 * 128 * 128; i += GT) { const int s = (int)(i & 127), t = (int)((i >> 7) & 127); ((bf16_t*)(ws + WS_WS))[i] = (s <= t) ? f2bf(P.in[10][i]) : (bf16_t)0; }
    cvt_rows(P.in[0], (bf16_t*)(ws + WS_XB), (size_t)M * D / 8, gt, GT);
    cvt_rows(P.in[1], (bf16_t*)(ws + WS_PB), (size_t)4 * M * DP / 8, gt, GT);
}

__device__ __forceinline__ void p4_layernorm(float* X, bf16_t* hb, const float* g, const float* b) {
    int tid_ = threadIdx.x; asm volatile("" : "+v"(tid_));
    const int tid = tid_, lane = tid & 63, wave = tid >> 6;
    const int gw = blockIdx.x * NWAVES + wave, NGW = gridDim.x * NWAVES;
    f32x4 gv[4], bv[4];
#pragma unroll
    for (int j = 0; j < 4; ++j) { gv[j] = *(const f32x4*)(g + 4 * lane + 256 * j); bv[j] = *(const f32x4*)(b + 4 * lane + 256 * j); }
    for (int m = gw; m < M; m += NGW) {
        f32x4* xr = (f32x4*)(X + (size_t)m * D) + lane;
        f32x4 v[4]; float s = 0.f;
#pragma unroll
        for (int j = 0; j < 4; ++j) { v[j] = xr[64 * j]; s += (v[j][0] + v[j][1]) + (v[j][2] + v[j][3]); }
        const float mean = wave_sum(s) * (1.f / D); float s2 = 0.f;
#pragma unroll
        for (int j = 0; j < 4; ++j) { v[j] = v[j] - mean; s2 += (v[j][0] * v[j][0] + v[j][1] * v[j][1]) + (v[j][2] * v[j][2] + v[j][3] * v[j][3]); }
        const float rstd = 1.f / sqrtf(wave_sum(s2) * (1.f / D) + LN_EPS);
        u32x2* o8 = (u32x2*)(hb + (size_t)m * D) + lane;
#pragma unroll
        for (int j = 0; j < 4; ++j) { const f32x4 h = v[j] * rstd * gv[j] + bv[j]; xr[64 * j] = h; u32x2 w; w.x = pg8::cvt_pk_bf16(h[0], h[1]); w.y = pg8::cvt_pk_bf16(h[2], h[3]); o8[64 * j] = w; }
    }
}

__device__ __forceinline__ void even_a_branch(const bf16_t* z, bf16_t* y, const float* cw, const float* cb, const float* lg, const float* lb, int run, MK_LAS unsigned char* lds) {
    unsigned tid_ = threadIdx.x; asm volatile("" : "+v"(tid_));
    const unsigned tid = tid_, lane = tid & 63u, wave = tid >> 6, c = tid;
    MK_LAS float* red = (MK_LAS float*)(lds + LDS_RED);
    MK_LAS float* stat = (MK_LAS float*)(lds + LDS_RED + 4096);
    float wk[31];
#pragma unroll
    for (int k = 0; k < 31; ++k) wk[k] = (cw + k * WB)[c];
    const float cbv = cb[c], gch = lg[c], bch = lb[c];
    const int row0 = run * 256, pos0 = row0 & (SEQ - 1);
    const unsigned tok = __builtin_bitreverse32(lane) >> 27;
    float win[38];
#pragma unroll
    for (int i = 0; i < 30; ++i) { float v = 0.f;
        if (pos0 - 30 + i >= 0) { const bf16_t* zr = z + (size_t)(row0 - 30 + i) * NB; v = bf2f(zr[c]) * sigmoidf_(bf2f(zr[c + 512u])); }
        win[8 + i] = v; }
    for (int st = 0; st < 8; ++st) {
        const bf16_t* zst = z + (size_t)(row0 + st * 32) * NB;
        bf16_t* yst = y + (size_t)(row0 + st * 32) * D;
        float outv[32];
#pragma unroll
        for (int ch = 0; ch < 4; ++ch) {
#pragma unroll
            for (int i = 0; i < 30; ++i) win[i] = win[i + 8];
#pragma unroll
            for (int i = 0; i < 8; ++i) { const bf16_t* zr = zst + (size_t)(ch * 8 + i) * NB; win[30 + i] = bf2f(zr[c]) * sigmoidf_(bf2f(zr[c + 512u])); }
            asm volatile("" ::: "memory");
#pragma unroll
            for (int i = 0; i < 8; ++i) { float s = cbv;
#pragma unroll
                for (int k = 0; k < 31; ++k) s += wk[k] * win[i + k];
                outv[ch * 8 + i] = s; }
        }
        float tot[2];
#pragma unroll
        for (int pass = 0; pass < 2; ++pass) {
            float v[16];
            { const bool up = lane & 1u;
#pragma unroll
              for (int i = 0; i < 16; ++i) { float a = outv[i], bb = outv[i + 16]; if (pass) { a *= a; bb *= bb; } const float keep = up ? bb : a, send = up ? a : bb; v[i] = keep + __shfl_xor(send, 1); } }
#pragma unroll
            for (int s = 1; s <= 4; ++s) { const int half = 16 >> s; const bool up = (lane >> s) & 1u;
#pragma unroll
                for (int i = 0; i < half; ++i) { const float a = v[i], bb = v[i + half]; const float keep = up ? bb : a, send = up ? a : bb; v[i] = keep + __shfl_xor(send, 1 << s); } }
            tot[pass] = v[0] + __shfl_xor(v[0], 32);
        }
        if (lane < 32u) { red[(wave * 32u + tok) * 2u + 0u] = tot[0]; red[(wave * 32u + tok) * 2u + 1u] = tot[1]; }
        __syncthreads();
        if (tid < 32u) { float s1 = 0.f, s2 = 0.f;
#pragma unroll
            for (unsigned w = 0; w < 8; ++w) { s1 += red[(w * 32u + tid) * 2u]; s2 += red[(w * 32u + tid) * 2u + 1u]; }
            const float mean = s1 * (1.f / WB), var = s2 * (1.f / WB) - mean * mean;
            stat[tid * 2u] = mean; stat[tid * 2u + 1u] = 1.f / sqrtf(fmaxf(var, 0.f) + LN_EPS); }
        __syncthreads();
#pragma unroll
        for (int t = 0; t < 32; ++t) {
            const float mean = stat[t * 2], rstd = stat[t * 2 + 1];
            float o = (outv[t] - mean) * rstd * gch + bch; o = siluf_(o);
            const float gate = bf2f((zst + (size_t)t * NB)[c + 1024u]);
            (yst + (size_t)t * D)[c] = f2bf(o * siluf_(gate));
            if ((t & 7) == 7) asm volatile("" ::: "memory");
        }
    }
}
__device__ __forceinline__ void even_b_block(const bf16_t* z, bf16_t* y, const float* lvg, const float* lvb, const bf16_t* WsM  , const float* bs  , int blk, MK_LAS unsigned char* lds) {
    int tid_ = threadIdx.x; asm volatile("" : "+v"(tid_));
    const int tid = tid_, lane = tid & 63, wave = tid >> 6;
    MK_LAS unsigned short* Vt = (MK_LAS unsigned short*)lds;
    const int brow0 = blk * 128;
    float g8[8], b8[8];
#pragma unroll
    for (int i = 0; i < 8; ++i) { g8[i] = lvg[lane + 64 * i]; b8[i] = lvb[lane + 64 * i]; }
#pragma unroll 2
    for (int tt = 0; tt < 16; ++tt) {
        const int t = wave * 16 + tt; const bf16_t* zr = z + (size_t)(brow0 + t) * NB + 2048 + lane;
        float v[8]; float s = 0.f, s2 = 0.f;
#pragma unroll
        for (int i = 0; i < 8; ++i) { v[i] = geluf_(bf2f(zr[64 * i])); s += v[i]; s2 += v[i] * v[i]; }
        s = wave_sum(s); s2 = wave_sum(s2);
        const float mean = s * (1.f / WB), var = s2 * (1.f / WB) - mean * mean, rstd = 1.f / sqrtf(fmaxf(var, 0.f) + LN_EPS);
#pragma unroll
        for (int i = 0; i < 8; ++i) Vt[(lane + 64 * i) * VT_STRIDE + t] = f2bf((v[i] - mean) * rstd * g8[i] + b8[i]);
    }
    __syncthreads();
    const int h = wave, n = lane & 15, q = lane >> 4;
    for (int nh = 0; nh < 2; ++nh) {
        f32x4 acc[4][4];
#pragma unroll
        for (int mt = 0; mt < 4; ++mt)
#pragma unroll
            for (int nt = 0; nt < 4; ++nt) acc[mt][nt] = (f32x4){0.f, 0.f, 0.f, 0.f};
#pragma unroll
        for (int ks = 0; ks < 4; ++ks) {
            if (2 * ks <= nh * 4 + 3) {
                bf16x8 a[4];
#pragma unroll
                for (int mt = 0; mt < 4; ++mt) { const MK_LAS unsigned short* p = Vt + (h * 64 + 16 * mt + n) * VT_STRIDE + 32 * ks + 8 * q;
                    const bf16x4 lo = *(const MK_LAS bf16x4*)p, hi = *(const MK_LAS bf16x4*)(p + 4);
                    a[mt] = (bf16x8){lo[0], lo[1], lo[2], lo[3], hi[0], hi[1], hi[2], hi[3]}; }
#pragma unroll
                for (int nt = 0; nt < 4; ++nt) {
                    const int ntg = nh * 4 + nt;
                    if (2 * ks <= ntg) {
                        const bf16x8 b = *(const bf16x8*)(WsM + ((size_t)h * 128 + 16 * ntg + n) * 128 + 32 * ks + 8 * q);
#pragma unroll
                        for (int mt = 0; mt < 4; ++mt) acc[mt][nt] = __builtin_amdgcn_mfma_f32_16x16x32_bf16(a[mt], b, acc[mt][nt], 0, 0, 0);
                    }
                }
            }
        }
#pragma unroll
        for (int nt = 0; nt < 4; ++nt) {
            const int t = 16 * (nh * 4 + nt) + n; const size_t row = (size_t)(brow0 + t); const float bsv = bs[h * 128 + t];
#pragma unroll
            for (int mt = 0; mt < 4; ++mt) {
                const int ch = h * 64 + 16 * mt + 4 * q;
                const u32x2 uw = *(const u32x2*)(z + row * NB + 1536 + ch), gw = *(const u32x2*)(z + row * NB + 2560 + ch);
                const float o0 = geluf_(bflo(uw.x)) * (acc[mt][nt][0] + bsv) * siluf_(bflo(gw.x));
                const float o1 = geluf_(bfhi(uw.x)) * (acc[mt][nt][1] + bsv) * siluf_(bfhi(gw.x));
                const float o2 = geluf_(bflo(uw.y)) * (acc[mt][nt][2] + bsv) * siluf_(bflo(gw.y));
                const float o3 = geluf_(bfhi(uw.y)) * (acc[mt][nt][3] + bsv) * siluf_(bfhi(gw.y));
                u32x2 w; w.x = pk2(o0, o1); w.y = pk2(o2, o3); *(u32x2*)(y + row * D + 512 + ch) = w;
            }
        }
    }
    __syncthreads();
}

__device__ __forceinline__ void odd_mixer(const bf16_t* z, bf16_t* y, const bf16_t* WpT  , const float* pscale, const float* cdw  ) {
    int tid_ = threadIdx.x; asm volatile("" : "+v"(tid_));
    const int tid = tid_, lane = tid & 63, wave = tid >> 6;
    const int gw = blockIdx.x * NWAVES + wave, NGW = gridDim.x * NWAVES;
    const int n = lane & 15, q = lane >> 4;
    constexpr int NTASK = (M / 16) * 4;
    for (int it = 0; it * NGW + gw < NTASK; ++it) {
        const int task = it * NGW + gw, tile = task >> 2, g = ((task & 3) + it) & 3, win = 2 << g;
        const int row = tile * 16 + n, pos = row & (SEQ - 1);
        const int cnt = (pos + 1 < win) ? pos + 1 : win; const float inv = 1.0f / (float)cnt;
        bf16x8 b[4];
#pragma unroll
        for (int ks = 0; ks < 4; ++ks) {
            const bf16_t* p = z + (size_t)row * NB + g * 128 + 32 * ks + 8 * q;
            const u32x4 cur = *(const u32x4*)p;
            float sum[8] = {bflo(cur.x), bfhi(cur.x), bflo(cur.y), bfhi(cur.y), bflo(cur.z), bfhi(cur.z), bflo(cur.w), bfhi(cur.w)};
            float self[8];
#pragma unroll
            for (int e = 0; e < 8; ++e) self[e] = sum[e];
            for (int i = 1; i < cnt; ++i) { const u32x4 w = *(const u32x4*)(p - (size_t)i * NB);
                sum[0] += bflo(w.x); sum[1] += bfhi(w.x); sum[2] += bflo(w.y); sum[3] += bfhi(w.y); sum[4] += bflo(w.z); sum[5] += bfhi(w.z); sum[6] += bflo(w.w); sum[7] += bfhi(w.w); }
            u32x4 o; o.x = pk2(sum[0] * inv - self[0], sum[1] * inv - self[1]); o.y = pk2(sum[2] * inv - self[2], sum[3] * inv - self[3]);
            o.z = pk2(sum[4] * inv - self[4], sum[5] * inv - self[5]); o.w = pk2(sum[6] * inv - self[6], sum[7] * inv - self[7]);
            b[ks] = __builtin_bit_cast(bf16x8, o);
        }
        f32x4 acc[8];
#pragma unroll
        for (int mt = 0; mt < 8; ++mt) acc[mt] = (f32x4){0.f, 0.f, 0.f, 0.f};
#pragma unroll
        for (int ks = 0; ks < 4; ++ks)
#pragma unroll
            for (int mt = 0; mt < 8; ++mt) { const bf16x8 a = *(const bf16x8*)(WpT + ((size_t)g * 128 + 16 * mt + n) * 128 + 32 * ks + 8 * q);
                acc[mt] = __builtin_amdgcn_mfma_f32_16x16x32_bf16(a, b[ks], acc[mt], 0, 0, 0); }
#pragma unroll
        for (int mt = 0; mt < 8; ++mt) {
            const int ch = g * 128 + 16 * mt + 4 * q;
            const f32x4 ps = *(const f32x4*)(pscale + ch); const u32x2 gwd = *(const u32x2*)(z + (size_t)row * NB + 512 + ch);
            u32x2 w; w.x = pk2(acc[mt][0] * ps[0] * siluf_(bflo(gwd.x)), acc[mt][1] * ps[1] * siluf_(bfhi(gwd.x)));
            w.y = pk2(acc[mt][2] * ps[2] * siluf_(bflo(gwd.y)), acc[mt][3] * ps[3] * siluf_(bfhi(gwd.y)));
            *(u32x2*)(y + (size_t)row * D + ch) = w;
        }
    }
    const size_t gt = (size_t)blockIdx.x * NTHREADS + tid, GT = (size_t)gridDim.x * NTHREADS;
    for (size_t item = gt; item < (size_t)M * 64; item += GT) {
        const size_t row = item >> 6; const int c8 = (int)(item & 63) * 8, pos = (int)(row & (SEQ - 1));
        const bf16_t* zr = z + row * NB + c8;
        float conv[8];
#pragma unroll
        for (int e = 0; e < 8; ++e) conv[e] = 0.f;
#pragma unroll
        for (int k = 0; k < 3; ++k) {
            const int back = 2 - k;
            if (pos - back >= 0) {
                const u32x4 hh = *(const u32x4*)(zr - (size_t)back * NB + 1024), cc = *(const u32x4*)(zr - (size_t)back * NB + 2048);
                const f32x4 w0 = *(const f32x4*)(cdw + k * WB + c8), w1 = *(const f32x4*)(cdw + k * WB + c8 + 4);
                conv[0] += w0[0] * bflo(hh.x) * bflo(cc.x); conv[1] += w0[1] * bfhi(hh.x) * bfhi(cc.x); conv[2] += w0[2] * bflo(hh.y) * bflo(cc.y); conv[3] += w0[3] * bfhi(hh.y) * bfhi(cc.y);
                conv[4] += w1[0] * bflo(hh.z) * bflo(cc.z); conv[5] += w1[1] * bfhi(hh.z) * bfhi(cc.z); conv[6] += w1[2] * bflo(hh.w) * bflo(cc.w); conv[7] += w1[3] * bfhi(hh.w) * bfhi(cc.w);
            }
        }
        const u32x4 db = *(const u32x4*)(zr + 1536), dg = *(const u32x4*)(zr + 2560);
        u32x4 o;
        o.x = pk2(bflo(db.x) * conv[0] * siluf_(bflo(dg.x)), bfhi(db.x) * conv[1] * siluf_(bfhi(dg.x)));
        o.y = pk2(bflo(db.y) * conv[2] * siluf_(bflo(dg.y)), bfhi(db.y) * conv[3] * siluf_(bfhi(dg.y)));
        o.z = pk2(bflo(db.z) * conv[4] * siluf_(bflo(dg.z)), bfhi(db.z) * conv[5] * siluf_(bfhi(dg.z)));
        o.w = pk2(bflo(db.w) * conv[6] * siluf_(bflo(dg.w)), bfhi(db.w) * conv[7] * siluf_(bfhi(dg.w)));
        *(u32x4*)(y + row * D + 512 + c8) = o;
    }
}

__global__ void __launch_bounds__(512) fwd_megakernel(Params P, int ph_lo, int ph_hi) {
    extern __shared__ __attribute__((aligned(16))) unsigned char lds_raw[];
    MK_LAS unsigned char* lds = (MK_LAS unsigned char*)lds_raw;
    cg::grid_group grid = cg::this_grid();
    int ph = 0;
#define MK_IN() (ph_lo <= ph && ph < ph_hi)
#define MK_SEAM() do { if (ph_lo <= ph && ph + 1 < ph_hi) grid.sync(); ++ph; } while (0)
    if (MK_IN()) p0_prologue(P, lds);
    MK_SEAM();
#pragma clang loop unroll(disable)
    for (int l0 = 0; l0 < DEPTH; ++l0) {
#define MK_LAUNDER() int l = l0; asm volatile("" : "+s"(l)); const int j = l >> 1; const bool odd = l & 1; unsigned char* ws = P.ws; asm volatile("" : "+s"(ws)); bf16_t* xb = (bf16_t*)(ws + WS_XB); bf16_t* z = (bf16_t*)(ws + WS_Z); bf16_t* yb = (bf16_t*)(ws + WS_Y); bf16_t* ple = (bf16_t*)(ws + WS_Z); float* X = P.out; asm volatile("" : "+s"(X));
        if (MK_IN()) { MK_LAUNDER()
            pg8::Gemm g{xb, (const bf16_t*)(ws + WS_WIN) + (size_t)l * NB * D, M, NB, D}; pg8::StaticOrder S; S.init(M, NB, (int)gridDim.x, (int)blockIdx.x);
            pg8::EpiBf16<0> E{z, NB, (odd ? P.in[15] : P.in[3]) + (size_t)j * NB, 0, 0};
            pg8::gemm_phase<pg8::EpiBf16<0>, pg8::StaticOrder, false>(lds, g, S, E, nullptr);
        }
        MK_SEAM();
        if (MK_IN()) { MK_LAUNDER()
            if (!odd) {
                for (int run = blockIdx.x; run < M / 256; run += gridDim.x) {
                    even_a_branch(z, yb, P.in[4] + (size_t)j * 31 * WB, P.in[5] + j * WB, P.in[6] + j * WB, P.in[7] + j * WB, run, lds);
                    __syncthreads();
                    for (int bb = 0; bb < 2; ++bb)
                        even_b_block(z, yb, P.in[8] + j * WB, P.in[9] + j * WB, (const bf16_t*)(ws + WS_WS) + (size_t)j * 8 * 128 * 128, P.in[11] + j * 8 * 128, run * 2 + bb, lds);
                }
            } else {
                odd_mixer(z, yb, (const bf16_t*)(ws + WS_WP) + (size_t)j * 4 * 128 * 128, P.in[17] + j * WB, P.in[18] + (size_t)j * 3 * WB);
            }
        }
        MK_SEAM();
        if (MK_IN()) { MK_LAUNDER()
            pg8::Gemm g{yb, (const bf16_t*)(ws + WS_WOUT) + (size_t)l * D * D, M, D, D}; pg8::StaticOrder S; S.init(M, D, (int)gridDim.x, (int)blockIdx.x);
            EpiRes E{l == 0 ? P.in[0] : (const float*)X, X, (odd ? P.in[20] : P.in[13]) + (size_t)j * D};
            pg8::gemm_phase<EpiRes, pg8::StaticOrder, false>(lds, g, S, E, nullptr);
        }
        MK_SEAM();
        if (MK_IN()) { MK_LAUNDER()
            p4_layernorm(X, yb, P.in[21] + (size_t)l * D, P.in[22] + (size_t)l * D);
            __syncthreads();
            pg8::Gemm g{(const bf16_t*)(ws + WS_PB) + (size_t)l * M * DP, (const bf16_t*)(ws + WS_WPLE) + (size_t)l * D * DP, M, D, DP}; pg8::StaticOrder S; S.init(M, D, (int)gridDim.x, (int)blockIdx.x);
            pg8::EpiBf16<0> E{ple, D, nullptr, 0, 0};
            pg8::gemm_phase<pg8::EpiBf16<0>, pg8::StaticOrder, false>(lds, g, S, E, nullptr);
        }
        MK_SEAM();
        if (MK_IN()) { MK_LAUNDER()
            pg8::Gemm g{yb, (const bf16_t*)(ws + WS_WGATE) + (size_t)l * D * D, M, D, D}; pg8::StaticOrder S; S.init(M, D, (int)gridDim.x, (int)blockIdx.x);
            EpiGate E{X, ple, xb, P.in[25] + (size_t)l * D};
            pg8::gemm_phase<EpiGate, pg8::StaticOrder, false>(lds, g, S, E, nullptr);
        }
        MK_SEAM();
    }
#undef MK_IN
#undef MK_LAUNDER
#undef MK_SEAM
}
}

extern "C" void kernel_launch(void* const* d_in, const int* in_sizes, int n_in, void* d_out, int out_size, void* d_ws, size_t ws_size, hipStream_t stream) {
    static int ready = 0;
    if (!ready) {
        if (n_in != 26 || out_size != mk::M * mk::D || ws_size < mk::WS_END) { fprintf(stderr, "kernel_launch: unexpected shapes (n_in %d out %d ws %zu need %zu)\n", n_in, out_size, ws_size, (size_t)mk::WS_END); }
        if (hipFuncSetAttribute((const void*)mk::fwd_megakernel, hipFuncAttributeMaxDynamicSharedMemorySize, mk::LDS_BYTES) != hipSuccess) fprintf(stderr, "kernel_launch: hipFuncSetAttribute failed\n");
        ready = 1;
    }
    mk::Params P{};
    for (int i = 0; i < 26; ++i) P.in[i] = (const float*)d_in[i];
    P.out = (float*)d_out; P.ws = (unsigned char*)d_ws;
    int lo = 0, hi = 1 + 5 * mk::DEPTH;
    void* args[] = {&P, &lo, &hi};
    hipError_t e = hipLaunchCooperativeKernel((const void*)mk::fwd_megakernel, dim3(256), dim3(mk::NTHREADS), args, mk::LDS_BYTES, stream);
    if (e != hipSuccess) fprintf(stderr, "cooperative launch failed: %s\n", hipGetErrorString(e));
}
```

```cpp
#include <hip/hip_runtime.h>
#include <hip/hip_cooperative_groups.h>
#include <cstdio>
namespace cg = cooperative_groups;
#ifndef MK_WGM
#define MK_WGM 8
#endif

#define XB_TMO      128
#define XB_XCNT(j)  (256  + 64 * (j))
#define XB_XSUB(j)  (1280 + 64 * (j))
#define XB_XGEN(j)  (2304 + 64 * (j))
#define XB_TOP      3328
#define XB_TOPGEN   3392
#define XCD_BAR_WORDS 3456
#define XB_SPIN_CAP (1u << 18)
#define LAS __attribute__((address_space(3)))

__device__ __forceinline__ unsigned xb_ld(unsigned* p)              { return __hip_atomic_load(p, __ATOMIC_RELAXED, __HIP_MEMORY_SCOPE_AGENT); }
__device__ __forceinline__ unsigned xb_add(unsigned* p, unsigned v) { return __hip_atomic_fetch_add(p, v, __ATOMIC_RELAXED, __HIP_MEMORY_SCOPE_AGENT); }
__device__ __forceinline__ unsigned xb_xcc_id() { return (unsigned)__builtin_amdgcn_s_getreg((3 << 11) | 20) & 0xFu; }
#define XB_SPIN(cond, bar) do { unsigned _sp = 0; while (cond) { __builtin_amdgcn_s_sleep(1); \
    if ((++_sp & 255u) == 0u) { if (xb_ld(&(bar)[XB_TMO])) break; if (_sp > XB_SPIN_CAP) { atomicAdd(&(bar)[XB_TMO], 1u); break; } } } } while (0)

struct XcdBarrier {
    unsigned* bar; unsigned x;
    volatile LAS unsigned* st;
};

__device__ __forceinline__ XcdBarrier xcd_barrier_post(unsigned* bar, volatile LAS unsigned* st) {
    XcdBarrier b; b.bar = bar; b.x = xb_xcc_id(); b.st = st;
    if (threadIdx.x == 0) (void)xb_add(&bar[XB_XCNT(b.x)], 1u);
    return b;
}
__device__ __forceinline__ void xcd_barrier_complete(unsigned* bar, unsigned x, unsigned& nloc, unsigned& nx) {
    const unsigned G = gridDim.x * gridDim.y * gridDim.z;
    unsigned sum, cnt, mine, sp = 0u;
    for (;;) {
        sum = 0u; cnt = 0u; mine = 0u;
#pragma unroll
        for (unsigned j = 0; j < 16; ++j) { const unsigned c = xb_ld(&bar[XB_XCNT(j)]); sum += c; cnt += (c > 0u) ? 1u : 0u; mine = (j == x) ? c : mine; }
        if (sum == G) break;
        __builtin_amdgcn_s_sleep(1);
        if ((++sp & 255u) == 0u) { if (xb_ld(&bar[XB_TMO])) break; if (sp > XB_SPIN_CAP) { atomicAdd(&bar[XB_TMO], 1u); break; } }
    }
    nloc = mine > 0u ? mine : 1u; nx = cnt > 0u ? cnt : 1u;
}

__device__ __forceinline__ void xcd_barrier(const XcdBarrier& b) {
    asm volatile("s_waitcnt vmcnt(0)" ::: "memory");
    __syncthreads();
    if (threadIdx.x == 0) {
        unsigned* bar = b.bar;
        __builtin_amdgcn_s_waitcnt(0);
        unsigned nloc = b.st[0], nx = b.st[1];
        if (nloc == 0u) { xcd_barrier_complete(bar, b.x, nloc, nx); b.st[0] = nloc; b.st[1] = nx; }
        const unsigned old = xb_add(&bar[XB_XSUB(b.x)], 1u);
        const unsigned gen = old / nloc;
        if (old + 1u == (gen + 1u) * nloc) {
            __builtin_amdgcn_fence(__ATOMIC_RELEASE, "agent");
            asm volatile("s_waitcnt vmcnt(0)" ::: "memory");
            const unsigned og = xb_add(&bar[XB_TOP], 1u);
            const unsigned tg = og / nx;
            if (og + 1u == (tg + 1u) * nx) xb_add(&bar[XB_TOPGEN], 1u);
            else XB_SPIN(xb_ld(&bar[XB_TOPGEN]) == tg, bar);
            __builtin_amdgcn_fence(__ATOMIC_ACQUIRE, "agent");
            xb_add(&bar[XB_XGEN(b.x)], 1u);
            asm volatile("s_waitcnt vmcnt(0)" ::: "memory");
        } else {
            XB_SPIN(xb_ld(&bar[XB_XGEN(b.x)]) == gen, bar);
            __builtin_amdgcn_fence(__ATOMIC_ACQUIRE, "agent");
            asm volatile("s_waitcnt vmcnt(0)" ::: "memory");
        }
    }
    __syncthreads();
}
namespace pg8 {
#define PG8_LAS __attribute__((address_space(3)))
typedef unsigned short bf16_t;
typedef short bf16x8 __attribute__((ext_vector_type(8)));
typedef float f32x4 __attribute__((ext_vector_type(4)));
typedef unsigned u32x4 __attribute__((ext_vector_type(4)));
constexpr int BM = 256, BK = 64, HALF = 128, HTB = HALF * BK * 2  , STAGE_BYTES = 8 * HTB, NXCD = 8, WGM = MK_WGM;

__host__ __device__ __forceinline__ int lds_byte(int r, int c) { const int st = (r >> 4) * 2 + (c >> 5), rr = r & 15, cc = c & 31, ob = rr * 64 + cc * 2; return st * 1024 + (ob ^ (((ob >> 9) & 1) << 5)); }
__host__ __device__ __forceinline__ void stage_rc(int b, int& R, int& C) { const int st = b / 1024, sb = b % 1024, swz = sb ^ (((sb >> 9) & 1) << 5); R = (st >> 1) * 16 + swz / 64; C = (st & 1) * 32 + (swz % 64) / 2; }
__host__ __device__ __forceinline__ int perm32(int rho) { const int n = rho >> 4, i = rho & 15; return 8 * (i >> 2) + 4 * n + (i & 3); }

struct Unit { int pm, pn; };
struct Gemm { const bf16_t* A; const bf16_t* Bt; int M, N, K; };

struct StaticOrder {
    int nM, nN, nwg, G, c;
    __host__ __device__ void init(int M, int N, int G_, int c_) { nM = M / BM; nN = N / BM; nwg = nM * nN; G = G_; c = c_; }
    __host__ __device__ bool next(int i, Unit& u) const {
        const long L = (long)i * G + c; if (L >= nwg) return false;
        int wgid = (int)L; { const int q = nwg / NXCD, r = nwg % NXCD, xcd = wgid % NXCD, off = wgid / NXCD; wgid = (xcd < r ? xcd * (q + 1) : r * (q + 1) + (xcd - r) * q) + off; }
        const int nig = WGM * nN, gid = wgid / nig, fm = gid * WGM, gsz = (nM - fm) < WGM ? (nM - fm) : WGM;
        u.pm = fm + ((wgid % nig) % gsz); u.pn = (wgid % nig) / gsz; return true;
    }
    __device__ __forceinline__ void a_ready(const Unit&) const {}
    __device__ __forceinline__ void done(const Unit&) const {}
};
__device__ __forceinline__ unsigned cvt_pk_bf16(float lo, float hi) { unsigned r; asm volatile("v_cvt_pk_bf16_f32 %0, %1, %2" : "=v"(r) : "v"(lo), "v"(hi)); return r; }
typedef float f32x2 __attribute__((ext_vector_type(2)));
__device__ __forceinline__ f32x2 gelu_pk(f32x2 v) {
    const f32x2 av = __builtin_elementwise_abs(v), d = av * 0.2316418882f + 1.0f;
    f32x2 t; t.x = __builtin_amdgcn_rcpf(d.x); t.y = __builtin_amdgcn_rcpf(d.y);
    f32x2 q = t * 0.5307027145f + (-0.7265760135f); q = q * t + 0.7107068705f; q = q * t + (-0.142248368f); q = q * t + 0.127414796f; q = q * t;
    const f32x2 s = (v * v) * (-0.72134752044f);
    f32x2 e; e.x = __builtin_amdgcn_exp2f(s.x); e.y = __builtin_amdgcn_exp2f(s.y);
    const f32x2 m = v * (q * e), r = v - m;
    f32x2 o; o.x = v.x < 0.f ? m.x : r.x; o.y = v.y < 0.f ? m.y : r.y; return o;
}

struct EpiF32 {
    static constexpr bool PERM = false, AFTER_DRAIN = false;
    float* C; int ldc; const float* bias;
    __device__ __forceinline__ void operator()(const f32x4 (&acc)[2][2][4][2], const Unit& u, int wr, int wc, int fr, int fq) const {
        const int row0 = u.pm * BM + wr * 64 + fr, col0 = u.pn * BM + wc * 32 + 4 * fq;
        f32x4 bv[2][2];
#pragma unroll
        for (int bj = 0; bj < 2; ++bj)
#pragma unroll
            for (int n = 0; n < 2; ++n) bv[bj][n] = bias ? *(const f32x4*)(bias + col0 + bj * HALF + n * 16) : (f32x4){0.f, 0.f, 0.f, 0.f};
#pragma unroll
        for (int ai = 0; ai < 2; ++ai)
#pragma unroll
            for (int m = 0; m < 4; ++m) { float* rowp = C + (size_t)(row0 + ai * HALF + m * 16) * ldc + col0;
#pragma unroll
                for (int bj = 0; bj < 2; ++bj)
#pragma unroll
                    for (int n = 0; n < 2; ++n) *(f32x4*)(rowp + bj * HALF + n * 16) = acc[ai][bj][m][n] + bv[bj][n]; }
    }
};
template <int ACT  > struct EpiBf16 {
    static constexpr bool PERM = true, AFTER_DRAIN = false;
    bf16_t* O; int ldc; const float* bias; int split_cols; size_t split_stride;
    __device__ __forceinline__ void operator()(const f32x4 (&acc)[2][2][4][2], const Unit& u, int wr, int wc, int fr, int fq) const {
        const int row0 = u.pm * BM + wr * 64 + fr; int colt = u.pn * BM; bf16_t* base = O;
        if (split_cols) { const int t = colt / split_cols; base += (size_t)t * split_stride; colt -= t * split_cols; }
        const int col0 = colt + wc * 32 + 8 * fq, bcol0 = u.pn * BM + wc * 32 + 8 * fq;
        f32x4 bv[2][2];
#pragma unroll
        for (int bj = 0; bj < 2; ++bj)
#pragma unroll
            for (int n = 0; n < 2; ++n) bv[bj][n] = bias ? *(const f32x4*)(bias + bcol0 + bj * HALF + 4 * n) : (f32x4){0.f, 0.f, 0.f, 0.f};
#pragma unroll
        for (int ai = 0; ai < 2; ++ai)
#pragma unroll
            for (int m = 0; m < 4; ++m) { bf16_t* rowp = base + (size_t)(row0 + ai * HALF + m * 16) * ldc + col0;
#pragma unroll
                for (int bj = 0; bj < 2; ++bj) { f32x4 v0 = acc[ai][bj][m][0] + bv[bj][0], v1 = acc[ai][bj][m][1] + bv[bj][1];
                    if (ACT == 1) { f32x2 a = gelu_pk((f32x2){v0[0], v0[1]}), b = gelu_pk((f32x2){v0[2], v0[3]}), c = gelu_pk((f32x2){v1[0], v1[1]}), d = gelu_pk((f32x2){v1[2], v1[3]});
                        v0 = (f32x4){a.x, a.y, b.x, b.y}; v1 = (f32x4){c.x, c.y, d.x, d.y}; }
                    if (ACT == 2) {
#pragma unroll
                        for (int j = 0; j < 4; ++j) { v0[j] = 0.5f * v0[j] * (1.0f + erff(v0[j] * 0.70710678f)); v1[j] = 0.5f * v1[j] * (1.0f + erff(v1[j] * 0.70710678f)); } }
                    u32x4 w; w.x = cvt_pk_bf16(v0[0], v0[1]); w.y = cvt_pk_bf16(v0[2], v0[3]); w.z = cvt_pk_bf16(v1[0], v1[1]); w.w = cvt_pk_bf16(v1[2], v1[3]);
                    *(u32x4*)(rowp + bj * HALF) = w; } }
    }
};
template <class Epi, class Sched, bool ALIGN_EPI = false, bool SP2 = false>
__device__ __forceinline__ void gemm_phase(PG8_LAS unsigned char* lds, const Gemm g, const Sched& S, const Epi& E) {
    int tid_ = threadIdx.x; asm volatile("" : "+v"(tid_));
    const int tid = tid_, wid = __builtin_amdgcn_readfirstlane(tid >> 6), lane = tid & 63, wr = wid >> 2, wc = wid & 3, fr = lane & 15, fq = lane >> 4;
    const int K = g.K, nt = K / BK;
    unsigned voffA[2], voffB[2];
#pragma unroll
    for (int i = 0; i < 2; ++i) { int R, C; stage_rc(tid * 16 + i * 8192, R, C); const int Rb = Epi::PERM ? ((R & ~31) + perm32(R & 31)) : R;
        voffA[i] = (unsigned)(R * K + C) * 2u; voffB[i] = (unsigned)(Rb * K + C) * 2u; }
    const size_t kstep = (size_t)(BK * 2);
    const size_t hstep = (size_t)HALF * K * 2;
    const size_t tstep = 2 * hstep;
    const unsigned ldsw = (unsigned)wid * 1024u;
    const int aoff = lds_byte(wr * 64 + fr, fq * 8), boff = lds_byte(wc * 32 + fr, fq * 8);
#define PG8_SA(b, h) (((b) * 2 + (h)) * HTB)
#define PG8_SB(b, h) ((4 + (b) * 2 + (h)) * HTB)
#define PG8_STAGE(bufoff, gbase, voff) do { _Pragma("unroll") for (int _i = 0; _i < 2; ++_i) \
        __builtin_amdgcn_global_load_lds((const unsigned*)((const char*)(gbase) + (voff)[_i]), (PG8_LAS unsigned*)(lds + (bufoff) + ldsw + _i * 8192), 16, 0, 0); } while (0)
#define PG8_LDA(dst, b, h) do { _Pragma("unroll") for (int m = 0; m < 4; ++m) _Pragma("unroll") for (int k = 0; k < 2; ++k) dst[m][k] = *(const PG8_LAS bf16x8*)(lds + PG8_SA(b, h) + aoff + m * 2048 + k * 1024); } while (0)
#define PG8_LDB(dst, b, h) do { _Pragma("unroll") for (int n = 0; n < 2; ++n) _Pragma("unroll") for (int k = 0; k < 2; ++k) dst[n][k] = *(const PG8_LAS bf16x8*)(lds + PG8_SB(b, h) + boff + n * 2048 + k * 1024); } while (0)
#define PG8_MMA(ai, bj, At, Bt) do { __builtin_amdgcn_s_setprio(1); _Pragma("unroll") for (int m = 0; m < 4; ++m) _Pragma("unroll") for (int n = 0; n < 2; ++n) _Pragma("unroll") for (int k = 0; k < 2; ++k) \
        acc[ai][bj][m][n] = __builtin_amdgcn_mfma_f32_16x16x32_bf16(Bt[n][k], At[m][k], acc[ai][bj][m][n], 0, 0, 0); __builtin_amdgcn_s_setprio(0); } while (0)
#define PG8_WAIT_V(n) asm volatile("s_waitcnt vmcnt(" #n ")" ::: "memory")
#define PG8_WAIT_L(n) asm volatile("s_waitcnt lgkmcnt(" #n ")" ::: "memory")
#define PG8_BAR __builtin_amdgcn_s_barrier()
#define PG8_SCHED __builtin_amdgcn_sched_barrier(0)
    Unit cur, nxt; int ui = 0;
    if (!S.next(0, cur)) return;
    f32x4 acc[2][2][4][2];
#pragma unroll
    for (int a = 0; a < 2; ++a)
#pragma unroll
        for (int b = 0; b < 2; ++b)
#pragma unroll
            for (int m = 0; m < 4; ++m)
#pragma unroll
                for (int n = 0; n < 2; ++n) acc[a][b][m][n] = (f32x4){0.f, 0.f, 0.f, 0.f};
    bf16x8 At[4][2], B0[2][2], B1[2][2];
    const char* cA = (const char*)g.A + (size_t)cur.pm * tstep; const char* cB = (const char*)g.Bt + (size_t)cur.pn * tstep;
    S.a_ready(cur);
    if constexpr (SP2) {
        PG8_STAGE(PG8_SB(0, 0), cB, voffB); PG8_STAGE(PG8_SB(0, 1), cB + hstep, voffB); PG8_STAGE(PG8_SA(0, 0), cA, voffA); PG8_STAGE(PG8_SA(0, 1), cA + hstep, voffA);
        if (wr == 1) PG8_BAR;
        PG8_WAIT_V(2); PG8_BAR;
        PG8_STAGE(PG8_SB(1, 0), cB + kstep, voffB); PG8_STAGE(PG8_SA(1, 0), cA + kstep, voffA); PG8_STAGE(PG8_SB(1, 1), cB + hstep + kstep, voffB);
        PG8_WAIT_V(6); PG8_BAR;
    } else {
        PG8_STAGE(PG8_SB(0, 0), cB, voffB); PG8_STAGE(PG8_SA(0, 0), cA, voffA); PG8_STAGE(PG8_SB(0, 1), cB + hstep, voffB); PG8_STAGE(PG8_SA(0, 1), cA + hstep, voffA);
        if (wr == 1) PG8_BAR;
        PG8_WAIT_V(4); PG8_BAR;
        PG8_STAGE(PG8_SB(1, 0), cB + kstep, voffB); PG8_STAGE(PG8_SA(1, 0), cA + kstep, voffA); PG8_STAGE(PG8_SB(1, 1), cB + hstep + kstep, voffB);
        PG8_WAIT_V(6); PG8_BAR;
    }
    for (;;) {
        const bool has_next = S.next(ui + 1, nxt);
        const char* nA = has_next ? (const char*)g.A + (size_t)nxt.pm * tstep : cA; const char* nB = has_next ? (const char*)g.Bt + (size_t)nxt.pn * tstep : cB;
        for (int t = 0; t < nt; t += 2) {
            const bool last = (t == nt - 2);
            const char* a1 = cA + (size_t)(t + 1) * kstep;
            const char* a2 = last ? nA : cA + (size_t)(t + 2) * kstep; const char* b2 = last ? nB : cB + (size_t)(t + 2) * kstep;
            const char* a3 = a2 + kstep; const char* b3 = b2 + kstep;
            if (last && has_next) S.a_ready(nxt);
            if constexpr (SP2) {
            PG8_LDB(B0, 0, 0); PG8_LDB(B1, 0, 1); PG8_SCHED; PG8_LDA(At, 0, 0); PG8_STAGE(PG8_SA(1, 1), a1 + hstep, voffA);
            PG8_WAIT_V(8); PG8_WAIT_L(0); PG8_BAR; PG8_MMA(0, 0, At, B0); PG8_MMA(0, 1, At, B1); PG8_BAR; PG8_SCHED;
            PG8_LDA(At, 0, 1); PG8_STAGE(PG8_SB(0, 0), b2, voffB); PG8_STAGE(PG8_SB(0, 1), b2 + hstep, voffB); PG8_STAGE(PG8_SA(0, 0), a2, voffA);
            PG8_WAIT_V(8); PG8_WAIT_L(0); PG8_BAR; PG8_MMA(1, 0, At, B0); PG8_MMA(1, 1, At, B1); PG8_BAR; PG8_SCHED;
            PG8_LDB(B0, 1, 0); PG8_LDB(B1, 1, 1); PG8_SCHED; PG8_LDA(At, 1, 0); PG8_STAGE(PG8_SA(0, 1), a2 + hstep, voffA);
            PG8_WAIT_V(8); PG8_WAIT_L(0); PG8_BAR; PG8_MMA(0, 0, At, B0); PG8_MMA(0, 1, At, B1); PG8_BAR; PG8_SCHED;
            PG8_LDA(At, 1, 1); PG8_STAGE(PG8_SB(1, 0), b3, voffB); PG8_STAGE(PG8_SB(1, 1), b3 + hstep, voffB); PG8_STAGE(PG8_SA(1, 0), a3, voffA);
            PG8_WAIT_V(8); PG8_WAIT_L(0); PG8_BAR; PG8_MMA(1, 0, At, B0); PG8_MMA(1, 1, At, B1); PG8_BAR; PG8_SCHED;
            } else {
            PG8_LDB(B0, 0, 0); PG8_SCHED; PG8_LDA(At, 0, 0); PG8_STAGE(PG8_SA(1, 1), a1 + hstep, voffA);
            PG8_WAIT_L(8); PG8_BAR; PG8_WAIT_L(0); PG8_MMA(0, 0, At, B0); PG8_BAR; PG8_SCHED;
            PG8_LDB(B1, 0, 1); PG8_STAGE(PG8_SB(0, 0), b2, voffB);
            PG8_BAR; PG8_WAIT_L(0); PG8_MMA(0, 1, At, B1); PG8_BAR;
            PG8_LDA(At, 0, 1); PG8_STAGE(PG8_SA(0, 0), a2, voffA);
            PG8_BAR; PG8_WAIT_L(0); PG8_MMA(1, 0, At, B0); PG8_BAR; PG8_SCHED;
            PG8_STAGE(PG8_SB(0, 1), b2 + hstep, voffB);
            PG8_WAIT_V(6); PG8_BAR; PG8_MMA(1, 1, At, B1); PG8_BAR;
            PG8_LDB(B0, 1, 0); PG8_SCHED; PG8_LDA(At, 1, 0); PG8_STAGE(PG8_SA(0, 1), a2 + hstep, voffA);
            PG8_WAIT_L(8); PG8_BAR; PG8_WAIT_L(0); PG8_MMA(0, 0, At, B0); PG8_BAR; PG8_SCHED;
            PG8_LDB(B1, 1, 1); PG8_STAGE(PG8_SB(1, 0), b3, voffB);
            PG8_BAR; PG8_WAIT_L(0); PG8_MMA(0, 1, At, B1); PG8_BAR;
            PG8_LDA(At, 1, 1); PG8_STAGE(PG8_SA(1, 0), a3, voffA);
            PG8_BAR; PG8_WAIT_L(0); PG8_MMA(1, 0, At, B0); PG8_BAR; PG8_SCHED;
            PG8_STAGE(PG8_SB(1, 1), b3 + hstep, voffB);
            PG8_WAIT_V(6); PG8_BAR; PG8_MMA(1, 1, At, B1); PG8_BAR;
            }
        }
        if constexpr (ALIGN_EPI) { if (wr == 0) PG8_BAR; }
        if constexpr (!Epi::AFTER_DRAIN) { E(acc, cur, wr, wc, fr, fq); S.done(cur); }
        if (!has_next) break;
#pragma unroll
        for (int a = 0; a < 2; ++a)
#pragma unroll
            for (int b = 0; b < 2; ++b)
#pragma unroll
                for (int m = 0; m < 4; ++m)
#pragma unroll
                    for (int n = 0; n < 2; ++n) acc[a][b][m][n] = (f32x4){0.f, 0.f, 0.f, 0.f};
        cur = nxt; cA = nA; cB = nB; ++ui;
        if constexpr (ALIGN_EPI) { if (wr == 1) PG8_BAR; }
    }
    PG8_WAIT_V(0);
    if constexpr (!ALIGN_EPI) { if (wr == 0) PG8_BAR; }
    PG8_BAR;
    if constexpr (Epi::AFTER_DRAIN) { E.fused(acc, cur, wr, wc, fr, fq, lds, wid, lane); S.done(cur); }
#undef PG8_SA
#undef PG8_SB
#undef PG8_STAGE
#undef PG8_LDA
#undef PG8_LDB
#undef PG8_MMA
#undef PG8_WAIT_V
#undef PG8_WAIT_L
#undef PG8_BAR
#undef PG8_SCHED
}
}

#ifndef REP_SYNC
#define REP_SYNC 1
#endif
#ifndef REP_P1
#define REP_P1 1
#endif
#ifndef MK_ALIGN_EPI
#define MK_ALIGN_EPI true
#endif
#ifndef MK_SP2
#define MK_SP2 true
#endif
#ifndef NT_Z
#define NT_Z 0
#endif
#ifndef STAG1
#define STAG1 0
#endif
#ifndef STAG3
#define STAG3 0
#endif
#ifndef STAG5
#define STAG5 0
#endif
#ifndef REP_K3
#define REP_K3 0
#endif
#ifndef REP_P0
#define REP_P0 1
#endif
#ifndef REP_PLE
#define REP_PLE 1
#endif
#ifndef REP_P5
#define REP_P5 1
#endif
#ifndef REP_A
#define REP_A 1
#endif
#ifndef REP_P2E
#define REP_P2E 1
#endif
#ifndef REP_P2O
#define REP_P2O 1
#endif
namespace mk {
using pg8::bf16_t; using pg8::bf16x8; using pg8::f32x4; using pg8::u32x4;
typedef unsigned u32x2 __attribute__((ext_vector_type(2)));
typedef float f32x2 __attribute__((ext_vector_type(2)));
typedef short bf16x4 __attribute__((ext_vector_type(4)));
#define MK_LAS __attribute__((address_space(3)))
constexpr int M = 65536, D = 1024, NB = 3072, DP = 256, SEQ = 4096, WB = 512, DEPTH = 4;
constexpr float LN_EPS = 1e-5f;
constexpr float ALPHA = 1.681792830507429f;
constexpr int NTHREADS = 512, NWAVES = 8;
constexpr int LDS_BYTES = 147520;
constexpr int LDS_RED = 139264;
constexpr int VT_STRIDE = 132;
constexpr size_t WS_WIN = 0;
constexpr size_t WS_WOUT = WS_WIN + (size_t)4 * NB * D * 2;
constexpr size_t WS_WGATE = WS_WOUT + (size_t)4 * D * D * 2;
constexpr size_t WS_WPLE = WS_WGATE + (size_t)4 * D * D * 2;
constexpr size_t WS_WS = WS_WPLE + (size_t)4 * D * DP * 2;
constexpr size_t WS_WP = WS_WS + (size_t)2 * 8 * 128 * 128 * 2;
constexpr size_t WS_XB = WS_WP + (size_t)2 * 4 * 128 * 128 * 2;
constexpr size_t WS_PB = WS_XB + (size_t)2 * M * D * 2;
constexpr size_t WS_Z = WS_PB + (size_t)4 * M * DP * 2;
constexpr size_t WS_Y = WS_Z + (size_t)M * NB * 2;
constexpr size_t WS_STATS = WS_Y + (size_t)M * D * 2;
constexpr size_t WS_C12 = WS_STATS + (size_t)M * 16 * 2 * 4;
constexpr size_t WS_BAR = WS_C12 + (size_t)4 * 2 * D * 4;
constexpr size_t WS_END = WS_BAR + (size_t)XCD_BAR_WORDS * 4;

struct Params { const float* in[26]; float* out; unsigned char* ws; };

__device__ __forceinline__ float bf2f(unsigned short b) { return __uint_as_float((unsigned)b << 16); }
__device__ __forceinline__ float bflo(unsigned w) { return __uint_as_float(w << 16); }
__device__ __forceinline__ float bfhi(unsigned w) { return __uint_as_float(w & 0xffff0000u); }
__device__ __forceinline__ unsigned short f2bf(float f) { unsigned u = __float_as_uint(f); u += 0x7FFFu + ((u >> 16) & 1u); return (unsigned short)(u >> 16); }
__device__ __forceinline__ unsigned pk2(float lo, float hi) { return pg8::cvt_pk_bf16(lo, hi); }
__device__ __forceinline__ float sigmoidf_(float x) { return __builtin_amdgcn_rcpf(1.0f + __expf(-x)); }
__device__ __forceinline__ float siluf_(float x) { return x * sigmoidf_(x); }
__device__ __forceinline__ float geluf_(float x) { return x * sigmoidf_(1.5957691216057308f * (x + 0.044715f * x * x * x)); }
__device__ __forceinline__ float silu2_(float a, float b) { return (a * b) * __builtin_amdgcn_rcpf((1.0f + __expf(-a)) * (1.0f + __expf(-b))); }
__device__ __forceinline__ float gelu_silu_(float u, float g) { return (u * g) * __builtin_amdgcn_rcpf((1.0f + __expf(-1.5957691216057308f * (u + 0.044715f * u * u * u))) * (1.0f + __expf(-g))); }
__device__ __forceinline__ float red_rows(float v) {
    const unsigned u = __float_as_uint(v);
    const auto r = __builtin_amdgcn_permlane32_swap(u, u, false, false);
    const float t = __uint_as_float(r[0]) + __uint_as_float(r[1]);
    const unsigned w = __float_as_uint(t);
    const auto r2 = __builtin_amdgcn_permlane16_swap(w, w, false, false);
    return __uint_as_float(r2[0]) + __uint_as_float(r2[1]);
}
__device__ __forceinline__ void red_rows2(float& s, float& s2) {
    const auto r = __builtin_amdgcn_permlane32_swap(__float_as_uint(s), __float_as_uint(s2), false, false);
    const float a = __uint_as_float(r[0]) + __uint_as_float(r[1]);
    const auto r2 = __builtin_amdgcn_permlane16_swap(__float_as_uint(a), __float_as_uint(a), false, false);
    const float b = __uint_as_float(r2[0]) + __uint_as_float(r2[1]);
    const auto r3 = __builtin_amdgcn_permlane32_swap(__float_as_uint(b), __float_as_uint(b), false, false);
    s = __uint_as_float(r3[0]); s2 = __uint_as_float(r3[1]);
}
template <int CTRL> __device__ __forceinline__ float dpp_f(float v) { return __builtin_bit_cast(float, __builtin_amdgcn_update_dpp(0, __builtin_bit_cast(int, v), CTRL, 0xf, 0xf, false)); }
__device__ __forceinline__ float wave_sum(float v) {
    v += dpp_f<0x128>(v); v += dpp_f<0x124>(v); v += dpp_f<0x122>(v); v += dpp_f<0x121>(v);
    const int vi = __builtin_bit_cast(int, v);
    const float r0 = __builtin_bit_cast(float, __builtin_amdgcn_readlane(vi, 0)), r1 = __builtin_bit_cast(float, __builtin_amdgcn_readlane(vi, 16));
    const float r2 = __builtin_bit_cast(float, __builtin_amdgcn_readlane(vi, 32)), r3 = __builtin_bit_cast(float, __builtin_amdgcn_readlane(vi, 48));
    return (r0 + r1) + (r2 + r3);
}

struct EpiNull {
    static constexpr bool PERM = true, AFTER_DRAIN = false;
    __device__ __forceinline__ void operator()(const f32x4 (&acc)[2][2][4][2], const pg8::Unit&, int, int, int, int) const {
#pragma unroll
        for (int a = 0; a < 2; ++a)
#pragma unroll
            for (int b = 0; b < 2; ++b)
#pragma unroll
                for (int m = 0; m < 4; ++m)
#pragma unroll
                    for (int n = 0; n < 2; ++n) asm volatile("" :: "v"(acc[a][b][m][n]));
    }
};
struct EpiZ {
    static constexpr bool PERM = true, AFTER_DRAIN = false;
    bf16_t* O; int ld; const MK_LAS float* lbias;
    __device__ __forceinline__ void operator()(const f32x4 (&acc)[2][2][4][2], const pg8::Unit& u, int wr, int wc, int fr, int fq) const {
        const int row0 = u.pm * 256 + wr * 64 + fr, col0 = u.pn * 256 + wc * 64 + 16 * fq;
        f32x4 bv[2][2];
#pragma unroll
        for (int bj = 0; bj < 2; ++bj)
#pragma unroll
            for (int n = 0; n < 2; ++n) bv[bj][n] = lbias ? *(const MK_LAS f32x4*)(lbias + col0 + 8 * bj + 4 * n) : (f32x4){0.f, 0.f, 0.f, 0.f};
#pragma unroll
        for (int ai = 0; ai < 2; ++ai)
#pragma unroll
            for (int m = 0; m < 4; ++m) { bf16_t* rowp = O + (size_t)(row0 + ai * 128 + m * 16) * ld + col0;
#pragma unroll
                for (int bj = 0; bj < 2; ++bj) { const f32x4 v0 = acc[ai][bj][m][0] + bv[bj][0], v1 = acc[ai][bj][m][1] + bv[bj][1];
                    u32x4 w; w.x = pg8::cvt_pk_bf16(v0[0], v0[1]); w.y = pg8::cvt_pk_bf16(v0[2], v0[3]); w.z = pg8::cvt_pk_bf16(v1[0], v1[1]); w.w = pg8::cvt_pk_bf16(v1[2], v1[3]);
                    *(u32x4*)(rowp + bj * 8) = w; } }
    }
};
struct EpiT {
    static constexpr bool PERM = true, AFTER_DRAIN = false;
    const bf16_t* xs; bf16_t* xt; const float* bias; float* stats;
    __device__ __forceinline__ void operator()(const f32x4 (&acc)[2][2][4][2], const pg8::Unit& u, int wr, int wc, int fr, int fq) const {
        const int row0 = u.pm * 256 + wr * 64 + fr, col0 = u.pn * 256 + wc * 64 + 16 * fq;
        f32x4 bv[2][2];
#pragma unroll
        for (int bj = 0; bj < 2; ++bj)
#pragma unroll
            for (int n = 0; n < 2; ++n) bv[bj][n] = *(const f32x4*)(bias + col0 + 8 * bj + 4 * n);
        u32x4 xr[4][2];
#pragma unroll
        for (int g = 0; g < 4; ++g) { const bf16_t* p = xs + (size_t)(row0 + g * 16) * D + col0; xr[g][0] = *(const u32x4*)p; xr[g][1] = *(const u32x4*)(p + 8); }
#pragma unroll
        for (int g = 0; g < 8; ++g) {
            const int ai = g >> 2, m = g & 3, row = row0 + ai * 128 + m * 16; bf16_t* p = xt + (size_t)row * D + col0;
            const u32x4 xc0 = xr[g & 3][0], xc1 = xr[g & 3][1];
            if (g < 4) { const bf16_t* pn = xs + (size_t)(row0 + 128 + g * 16) * D + col0; xr[g][0] = *(const u32x4*)pn; xr[g][1] = *(const u32x4*)(pn + 8); }
            float s = 0.f, s2 = 0.f;
#pragma unroll
            for (int bj = 0; bj < 2; ++bj) { const u32x4 x4 = bj ? xc1 : xc0;
                const f32x4 v0 = acc[ai][bj][m][0] + bv[bj][0] + (f32x4){bflo(x4.x), bfhi(x4.x), bflo(x4.y), bfhi(x4.y)} * ALPHA;
                const f32x4 v1 = acc[ai][bj][m][1] + bv[bj][1] + (f32x4){bflo(x4.z), bfhi(x4.z), bflo(x4.w), bfhi(x4.w)} * ALPHA;
                u32x4 w; w.x = pg8::cvt_pk_bf16(v0[0], v0[1]); w.y = pg8::cvt_pk_bf16(v0[2], v0[3]); w.z = pg8::cvt_pk_bf16(v1[0], v1[1]); w.w = pg8::cvt_pk_bf16(v1[2], v1[3]);
                *(u32x4*)(p + bj * 8) = w;
                const float r0 = bflo(w.x), r1 = bfhi(w.x), r2 = bflo(w.y), r3 = bfhi(w.y), r4 = bflo(w.z), r5 = bfhi(w.z), r6 = bflo(w.w), r7 = bfhi(w.w);
                s += ((r0 + r1) + (r2 + r3)) + ((r4 + r5) + (r6 + r7));
                s2 += ((r0 * r0 + r1 * r1) + (r2 * r2 + r3 * r3)) + ((r4 * r4 + r5 * r5) + (r6 * r6 + r7 * r7)); }
            s = red_rows(s); s2 = red_rows(s2);
            if (fq == 0) *(f32x2*)(stats + ((size_t)(u.pn * 4 + wc) * M + row) * 2) = (f32x2){s, s2};
        }
    }
};
struct EpiGate2 {
    static constexpr bool PERM = true, AFTER_DRAIN = false;
    const bf16_t* tb; const bf16_t* ple; bf16_t* xo; float* fo; const float* stats; const MK_LAS float* lv;
    __device__ __forceinline__ void operator()(const f32x4 (&acc)[2][2][4][2], const pg8::Unit& u, int wr, int wc, int fr, int fq) const {
        const int row0 = u.pm * 256 + wr * 64 + fr, col0 = u.pn * 256 + wc * 64 + 16 * fq;
        f32x4 sa[2], sb[2]; u32x4 tw[2][2], pw[2][2];
        { const float* sp = stats + ((size_t)(fq * 4) * M + row0) * 2; const f32x2 q0 = *(const f32x2*)sp, q1 = *(const f32x2*)(sp + (size_t)2 * M), q2 = *(const f32x2*)(sp + (size_t)4 * M), q3 = *(const f32x2*)(sp + (size_t)6 * M); sa[0] = (f32x4){q0.x, q0.y, q1.x, q1.y}; sb[0] = (f32x4){q2.x, q2.y, q3.x, q3.y};
          const size_t o = (size_t)row0 * D + col0; tw[0][0] = *(const u32x4*)(tb + o); tw[0][1] = *(const u32x4*)(tb + o + 8); pw[0][0] = *(const u32x4*)(ple + o); pw[0][1] = *(const u32x4*)(ple + o + 8); }
#pragma unroll
        for (int g = 0; g < 8; ++g) {
            const int ai = g >> 2, m = g & 3, row = row0 + ai * 128 + m * 16, cur = g & 1;
            if (g < 7) { const int g1 = g + 1, nb = g1 & 1, rown = row0 + (g1 >> 2) * 128 + (g1 & 3) * 16;
                const float* sp = stats + ((size_t)(fq * 4) * M + rown) * 2; const f32x2 q0 = *(const f32x2*)sp, q1 = *(const f32x2*)(sp + (size_t)2 * M), q2 = *(const f32x2*)(sp + (size_t)4 * M), q3 = *(const f32x2*)(sp + (size_t)6 * M); sa[nb] = (f32x4){q0.x, q0.y, q1.x, q1.y}; sb[nb] = (f32x4){q2.x, q2.y, q3.x, q3.y};
                const size_t o = (size_t)rown * D + col0; tw[nb][0] = *(const u32x4*)(tb + o); tw[nb][1] = *(const u32x4*)(tb + o + 8); pw[nb][0] = *(const u32x4*)(ple + o); pw[nb][1] = *(const u32x4*)(ple + o + 8); }
            float mu, rs;
            { const f32x4 a = sa[cur], b = sb[cur];
              float s = (a[0] + a[2]) + (b[0] + b[2]), s2 = (a[1] + a[3]) + (b[1] + b[3]);
              red_rows2(s, s2);
              mu = s * (1.f / D); const float var = s2 * (1.f / D) - mu * mu; rs = 1.f / sqrtf(fmaxf(var, 0.f) + LN_EPS); }
#pragma unroll
            for (int bj = 0; bj < 2; ++bj) {
                const int c = col0 + bj * 8; const size_t o = (size_t)row * D + c;
                const u32x4 t4 = tw[cur][bj], p4 = pw[cur][bj];
                f32x4 x[2];
#pragma unroll
                for (int n = 0; n < 2; ++n) {
                    const f32x4 gv = *(const MK_LAS f32x4*)(lv + c + 4 * n), bb = *(const MK_LAS f32x4*)(lv + 1024 + c + 4 * n), c1v = *(const MK_LAS f32x4*)(lv + 2048 + c + 4 * n), c2v = *(const MK_LAS f32x4*)(lv + 3072 + c + 4 * n);
                    const unsigned ta = n ? t4.z : t4.x, tbw = n ? t4.w : t4.y, pa = n ? p4.z : p4.x, pb2 = n ? p4.w : p4.y;
                    const f32x4 tv = (f32x4){bflo(ta), bfhi(ta), bflo(tbw), bfhi(tbw)}, pv = (f32x4){bflo(pa), bfhi(pa), bflo(pb2), bfhi(pb2)};
                    const f32x4 gp = (acc[ai][bj][m][n] - c1v * mu) * rs + c2v;
                    const f32x4 h = (tv - mu) * rs * gv + bb;
#pragma unroll
                    for (int e = 0; e < 4; ++e) x[n][e] = h[e] + sigmoidf_(gp[e]) * pv[e];
                }
                if (fo) { *(f32x4*)(fo + o) = x[0]; *(f32x4*)(fo + o + 4) = x[1]; }
                else { u32x4 w; w.x = pg8::cvt_pk_bf16(x[0][0], x[0][1]); w.y = pg8::cvt_pk_bf16(x[0][2], x[0][3]); w.z = pg8::cvt_pk_bf16(x[1][0], x[1][1]); w.w = pg8::cvt_pk_bf16(x[1][2], x[1][3]); *(u32x4*)(xo + o) = w; }
            }
        }
    }
};

__device__ __forceinline__ int phys_row(int L) { const int r = L & 255; return (L & ~255) + 128 * ((r >> 3) & 1) + 32 * (r >> 6) + 8 * ((r >> 4) & 3) + (r & 7); }
__device__ __forceinline__ void p0_transpose_item(const float* W, int K, int N, bf16_t* WT, MK_LAS float* scr, int item, int lane, const float* rowscale = nullptr, bool remap = true) {
    const int nblk = N / 32, kb = item / nblk, nb = item % nblk, k0 = 64 * kb, n0 = 32 * nb;
    float wl[32];
#pragma unroll
    for (int i = 0; i < 32; ++i) wl[i] = W[(size_t)(k0 + 2 * i + (lane >> 5)) * N + n0 + (lane & 31)];
#pragma unroll
    for (int i = 0; i < 32; ++i) { const int kk = 2 * i + (lane >> 5); float wv = wl[i]; if (rowscale) wv *= rowscale[k0 + kk]; scr[kk * 33 + (lane & 31)] = wv; }
    asm volatile("s_waitcnt lgkmcnt(0)" ::: "memory");
    const int c = lane & 7;
#pragma unroll
    for (int j = 0; j < 4; ++j) { const int n = (lane >> 3) + 8 * j; const MK_LAS float* s = scr + (8 * c) * 33 + n;
        u32x4 o; o.x = pk2(s[0 * 33], s[1 * 33]); o.y = pk2(s[2 * 33], s[3 * 33]); o.z = pk2(s[4 * 33], s[5 * 33]); o.w = pk2(s[6 * 33], s[7 * 33]);
        *(u32x4*)(WT + (size_t)(remap ? phys_row(n0 + n) : (n0 + n)) * K + k0 + 8 * c) = o; }
    asm volatile("s_waitcnt lgkmcnt(0)" ::: "memory");
}
__device__ __forceinline__ void cvt_rows(const float* src, bf16_t* dst, size_t n8, size_t i0, size_t stride) {
    for (size_t i = i0; i < n8; i += 4 * stride) {
        f32x4 a[4], b[4];
#pragma unroll
        for (int k = 0; k < 4; ++k) { const size_t ii = (i + k * stride < n8) ? i + k * stride : i; a[k] = __builtin_nontemporal_load((const f32x4*)(src + ii * 8)); b[k] = __builtin_nontemporal_load((const f32x4*)(src + ii * 8 + 4)); }
#pragma unroll
        for (int k = 0; k < 4; ++k) { if (i + k * stride < n8) { u32x4 o; o.x = pk2(a[k][0], a[k][1]); o.y = pk2(a[k][2], a[k][3]); o.z = pk2(b[k][0], b[k][1]); o.w = pk2(b[k][2], b[k][3]); *(u32x4*)(dst + (i + k * stride) * 8) = o; } }
    }
}
__device__ __forceinline__ void p0_prologue(const Params& P, MK_LAS unsigned char* lds) {
    int tid_ = threadIdx.x; asm volatile("" : "+v"(tid_));
    const int tid = tid_, lane = tid & 63, wave = tid >> 6;
    MK_LAS float* scr = (MK_LAS float*)(lds + wave * 16384);
    const int gw = blockIdx.x * NWAVES + wave, NGW = gridDim.x * NWAVES;
    unsigned char* ws = P.ws;
    constexpr int I_IN = (D / 64) * (NB / 32), I_SQ = (D / 64) * (D / 32), I_PLE = (DP / 64) * (D / 32), I_POOL = (128 / 64) * (128 / 32);
    constexpr int PER_L = I_IN + 2 * I_SQ + I_PLE, NITEMS = 4 * PER_L + 8 * I_POOL;
    for (int it = gw; it < NITEMS; it += NGW) {
        if (it < 4 * PER_L) {
            const int l = it / PER_L, j = l >> 1; int r = it % PER_L;
            if (r < I_IN) { const float* W = ((l & 1) ? P.in[14] : P.in[2]) + (size_t)j * D * NB; p0_transpose_item(W, D, NB, (bf16_t*)(ws + WS_WIN) + (size_t)l * NB * D, scr, r, lane); continue; } r -= I_IN;
            if (r < I_SQ) { const float* W = ((l & 1) ? P.in[19] : P.in[12]) + (size_t)j * D * D; p0_transpose_item(W, D, D, (bf16_t*)(ws + WS_WOUT) + (size_t)l * D * D, scr, r, lane); continue; } r -= I_SQ;
            if (r < I_SQ) { p0_transpose_item(P.in[24] + (size_t)l * D * D, D, D, (bf16_t*)(ws + WS_WGATE) + (size_t)l * D * D, scr, r, lane, P.in[21] + (size_t)l * D); continue; } r -= I_SQ;
            p0_transpose_item(P.in[23] + (size_t)l * DP * D, DP, D, (bf16_t*)(ws + WS_WPLE) + (size_t)l * D * DP, scr, r, lane);
        } else {
            const int r = it - 4 * PER_L, mtx = r / I_POOL;
            p0_transpose_item(P.in[16] + (size_t)mtx * 128 * 128, 128, 128, (bf16_t*)(ws + WS_WP) + (size_t)mtx * 128 * 128, scr, r % I_POOL, lane, nullptr, false);
        }
    }
    const size_t gt = (size_t)blockIdx.x * NTHREADS + tid, GT = (size_t)gridDim.x * NTHREADS;
    for (size_t i = gt; i < (size_t)2 * 8 * 128 * 128; i += GT) { const int s = (int)(i & 127), t = (int)((i >> 7) & 127); ((bf16_t*)(ws + WS_WS))[i] = (s <= t) ? f2bf(P.in[10][i]) : (bf16_t)0; }
    cvt_rows(P.in[0], (bf16_t*)(ws + WS_XB), (size_t)M * D / 8, gt, GT);
    cvt_rows(P.in[1], (bf16_t*)(ws + WS_PB), (size_t)4 * M * DP / 8, gt, GT);
    __syncthreads();
    for (int task = blockIdx.x; task < 4 * (D / 16); task += gridDim.x) {
        const int l = task / (D / 16), n = (task % (D / 16)) * 16 + (tid & 15), kg = tid >> 4;
        const float* Wg = P.in[24] + (size_t)l * D * D + n; const float* g = P.in[21] + (size_t)l * D; const float* b = P.in[22] + (size_t)l * D;
        float s1 = 0.f, s2 = 0.f;
#pragma unroll 8
        for (int k = kg * 32; k < kg * 32 + 32; ++k) { const float w = Wg[(size_t)k * D]; s1 += bf2f(f2bf(g[k] * w)); s2 += b[k] * w; }
        MK_LAS float* red = (MK_LAS float*)lds;
        red[tid * 2] = s1; red[tid * 2 + 1] = s2;
        __syncthreads();
        if (tid < 16) { float a1 = 0.f, a2 = 0.f;
            for (int w = 0; w < 32; ++w) { a1 += red[(w * 16 + tid) * 2]; a2 += red[(w * 16 + tid) * 2 + 1]; }
            float* c12 = (float*)(ws + WS_C12) + (size_t)l * 2 * D; c12[n] = a1; c12[D + n] = a2 + P.in[25][(size_t)l * D + n]; }
        __syncthreads();
    }
}

__device__ __forceinline__ void even_a_branch(const bf16_t* z, bf16_t* y, const float* cw, const float* cb, const float* lg, const float* lb, int run, MK_LAS unsigned char* lds) {
    unsigned tid_ = threadIdx.x; asm volatile("" : "+v"(tid_));
    const unsigned tid = tid_, lane = tid & 63u, c = tid; const int wave = __builtin_amdgcn_readfirstlane((int)(tid >> 6));
    MK_LAS float* LA = (MK_LAS float*)lds;
    MK_LAS float* LO = (MK_LAS float*)(lds + 65536);
    float wk[31];
#pragma unroll
    for (int k = 0; k < 31; ++k) wk[k] = (cw + k * WB)[c];
    const float cbv = cb[c];
    const f32x4 g0 = *(const f32x4*)(lg + 8u * lane), g1 = *(const f32x4*)(lg + 8u * lane + 4u), b0 = *(const f32x4*)(lb + 8u * lane), b1 = *(const f32x4*)(lb + 8u * lane + 4u);
    const int row0 = run * 256, pos0 = row0 & (SEQ - 1);
    float win[38];
#pragma unroll
    for (int i = 0; i < 30; ++i) { float v = 0.f;
        if (pos0 - 30 + i >= 0) { const bf16_t* zr = z + (size_t)(row0 - 30 + i) * NB; v = bf2f(zr[c]) * sigmoidf_(bf2f(zr[c + 512u])); }
        win[8 + i] = v; }
    u32x4 rv[4], rg[4];
    { const bf16_t* zw = z + (size_t)(row0 + 4 * wave) * NB;
#pragma unroll
      for (int tt = 0; tt < 4; ++tt) { rv[tt] = *(const u32x4*)(zw + (size_t)tt * NB + 8u * lane); rg[tt] = *(const u32x4*)(zw + (size_t)tt * NB + 512u + 8u * lane); } }
    for (int st = 0; st < 8; ++st) {
        const bf16_t* zst = z + (size_t)(row0 + st * 32 + 4 * wave) * NB;
#pragma unroll
        for (int tt = 0; tt < 4; ++tt) {
            const u32x4 v = rv[tt], g = rg[tt];
            f32x4 a0, a1;
            a0[0] = bflo(v.x) * sigmoidf_(bflo(g.x)); a0[1] = bfhi(v.x) * sigmoidf_(bfhi(g.x)); a0[2] = bflo(v.y) * sigmoidf_(bflo(g.y)); a0[3] = bfhi(v.y) * sigmoidf_(bfhi(g.y));
            a1[0] = bflo(v.z) * sigmoidf_(bflo(g.z)); a1[1] = bfhi(v.z) * sigmoidf_(bfhi(g.z)); a1[2] = bflo(v.w) * sigmoidf_(bflo(g.w)); a1[3] = bfhi(v.w) * sigmoidf_(bfhi(g.w));
            MK_LAS float* p = LA + (4 * wave + tt) * 512 + 8u * lane;
            *(MK_LAS f32x4*)p = a0; *(MK_LAS f32x4*)(p + 4) = a1;
        }
        __syncthreads();
        u32x4 gt[4];
#pragma unroll
        for (int tt = 0; tt < 4; ++tt) gt[tt] = *(const u32x4*)(zst + (size_t)tt * NB + 1024u + 8u * lane);
        if (st < 7) {
#pragma unroll
            for (int tt = 0; tt < 4; ++tt) { rv[tt] = *(const u32x4*)(zst + (size_t)(32 + tt) * NB + 8u * lane); rg[tt] = *(const u32x4*)(zst + (size_t)(32 + tt) * NB + 512u + 8u * lane); }
        }
#pragma unroll
        for (int ch = 0; ch < 4; ++ch) {
#pragma unroll
            for (int i = 0; i < 30; ++i) win[i] = win[i + 8];
#pragma unroll
            for (int i = 0; i < 8; ++i) win[30 + i] = LA[(ch * 8 + i) * 512 + c];
#pragma unroll
            for (int i = 0; i < 8; ++i) { float s = cbv;
#pragma unroll
                for (int k = 0; k < 31; ++k) s += wk[k] * win[i + k];
                LO[(ch * 8 + i) * 512 + c] = s; }
        }
        __syncthreads();
#pragma unroll
        for (int tt = 0; tt < 4; ++tt) {
            const MK_LAS float* p = LO + (4 * wave + tt) * 512 + 8u * lane;
            f32x4 v0 = *(const MK_LAS f32x4*)p, v1 = *(const MK_LAS f32x4*)(p + 4);
            float s = ((v0[0] + v0[1]) + (v0[2] + v0[3])) + ((v1[0] + v1[1]) + (v1[2] + v1[3]));
            float s2 = ((v0[0] * v0[0] + v0[1] * v0[1]) + (v0[2] * v0[2] + v0[3] * v0[3])) + ((v1[0] * v1[0] + v1[1] * v1[1]) + (v1[2] * v1[2] + v1[3] * v1[3]));
            s = wave_sum(s); s2 = wave_sum(s2);
            const float mean = s * (1.f / WB), var = s2 * (1.f / WB) - mean * mean, rstd = 1.f / sqrtf(fmaxf(var, 0.f) + LN_EPS);
            v0 = (v0 - mean) * rstd * g0 + b0; v1 = (v1 - mean) * rstd * g1 + b1;
            const u32x4 g = gt[tt];
            u32x4 o;
            o.x = pk2(silu2_(v0[0], bflo(g.x)), silu2_(v0[1], bfhi(g.x))); o.y = pk2(silu2_(v0[2], bflo(g.y)), silu2_(v0[3], bfhi(g.y)));
            o.z = pk2(silu2_(v1[0], bflo(g.z)), silu2_(v1[1], bfhi(g.z))); o.w = pk2(silu2_(v1[2], bflo(g.w)), silu2_(v1[3], bfhi(g.w)));
            *(u32x4*)(y + (size_t)(row0 + st * 32 + 4 * wave + tt) * D + 8u * lane) = o;
        }
    }
}
__device__ __forceinline__ void even_b_block(const bf16_t* z, bf16_t* y, const float* lvg, const float* lvb, const bf16_t* WsM  , const float* bs  , int blk, MK_LAS unsigned char* lds) {
    int tid_ = threadIdx.x; asm volatile("" : "+v"(tid_));
    const int tid = tid_, lane = tid & 63, wave = __builtin_amdgcn_readfirstlane(tid >> 6);
    const int brow0 = blk * 128;
    const f32x4 g0 = *(const f32x4*)(lvg + 8 * lane), g1 = *(const f32x4*)(lvg + 8 * lane + 4), b0 = *(const f32x4*)(lvb + 8 * lane), b1 = *(const f32x4*)(lvb + 8 * lane + 4);
    for (int grp = 0; grp < 2; ++grp) {
        const int t0 = 16 * wave + 8 * grp;
        const bf16_t* zr = z + (size_t)(brow0 + t0) * NB + 2048 + 8 * lane;
        u32x4 raw[8];
#pragma unroll
        for (int tt = 0; tt < 8; ++tt) raw[tt] = *(const u32x4*)(zr + (size_t)tt * NB);
        u32x4 outp[8];
#pragma unroll
        for (int p = 0; p < 4; ++p) {
            f32x4 va[2][2];
#pragma unroll
            for (int e = 0; e < 2; ++e) { const u32x4 r = raw[2 * p + e];
                f32x4 v0 = (f32x4){geluf_(bflo(r.x)), geluf_(bfhi(r.x)), geluf_(bflo(r.y)), geluf_(bfhi(r.y))}, v1 = (f32x4){geluf_(bflo(r.z)), geluf_(bfhi(r.z)), geluf_(bflo(r.w)), geluf_(bfhi(r.w))};
                float s = ((v0[0] + v0[1]) + (v0[2] + v0[3])) + ((v1[0] + v1[1]) + (v1[2] + v1[3]));
                float s2 = ((v0[0] * v0[0] + v0[1] * v0[1]) + (v0[2] * v0[2] + v0[3] * v0[3])) + ((v1[0] * v1[0] + v1[1] * v1[1]) + (v1[2] * v1[2] + v1[3] * v1[3]));
                s = wave_sum(s); s2 = wave_sum(s2);
                const float mean = s * (1.f / WB), var = s2 * (1.f / WB) - mean * mean, rstd = 1.f / sqrtf(fmaxf(var, 0.f) + LN_EPS);
                va[e][0] = (v0 - mean) * rstd * g0 + b0; va[e][1] = (v1 - mean) * rstd * g1 + b1; }
#pragma unroll
            for (int i = 0; i < 8; ++i) { const unsigned w = pg8::cvt_pk_bf16(va[0][i >> 2][i & 3], va[1][i >> 2][i & 3]);
                if (p == 0) outp[i].x = w; else if (p == 1) outp[i].y = w; else if (p == 2) outp[i].z = w; else outp[i].w = w; }
        }
        const int cbk = (t0 >> 3) ^ (lane & 15);
#pragma unroll
        for (int i = 0; i < 8; ++i) *(MK_LAS u32x4*)(lds + (8 * lane + i) * 256 + cbk * 16) = outp[i];
    }
    __syncthreads();
    const int h = wave, n = lane & 15, q = lane >> 4;
    for (int nh = 0; nh < 2; ++nh) {
        u32x2 uw[4][4], gw[4][4];
#pragma unroll
        for (int nt = 0; nt < 4; ++nt) { const size_t row = (size_t)(brow0 + 16 * (nh * 4 + nt) + n);
#pragma unroll
            for (int mt = 0; mt < 4; ++mt) { const int ch = h * 64 + 16 * mt + 4 * q; uw[nt][mt] = *(const u32x2*)(z + row * NB + 1536 + ch); gw[nt][mt] = *(const u32x2*)(z + row * NB + 2560 + ch); } }
        f32x4 acc[4][4];
#pragma unroll
        for (int mt = 0; mt < 4; ++mt)
#pragma unroll
            for (int nt = 0; nt < 4; ++nt) acc[mt][nt] = (f32x4){0.f, 0.f, 0.f, 0.f};
#pragma unroll
        for (int ks = 0; ks < 4; ++ks) {
            if (2 * ks <= nh * 4 + 3) {
                bf16x8 a[4];
#pragma unroll
                for (int mt = 0; mt < 4; ++mt) { const int row = h * 64 + 16 * mt + n; a[mt] = *(const MK_LAS bf16x8*)(lds + row * 256 + (((4 * ks + q) ^ ((row >> 3) & 15)) * 16)); }
#pragma unroll
                for (int nt = 0; nt < 4; ++nt) {
                    const int ntg = nh * 4 + nt;
                    if (2 * ks <= ntg) {
                        const bf16x8 b = *(const bf16x8*)(WsM + ((size_t)h * 128 + 16 * ntg + n) * 128 + 32 * ks + 8 * q);
#pragma unroll
                        for (int mt = 0; mt < 4; ++mt) acc[mt][nt] = __builtin_amdgcn_mfma_f32_16x16x32_bf16(a[mt], b, acc[mt][nt], 0, 0, 0);
                    }
                }
            }
        }
#pragma unroll
        for (int nt = 0; nt < 4; ++nt) {
            const int t = 16 * (nh * 4 + nt) + n; const size_t row = (size_t)(brow0 + t); const float bsv = bs[h * 128 + t];
#pragma unroll
            for (int mt = 0; mt < 4; ++mt) {
                const int ch = h * 64 + 16 * mt + 4 * q;
                const u32x2 u2 = uw[nt][mt], g2 = gw[nt][mt];
                const float o0 = gelu_silu_(bflo(u2.x), bflo(g2.x)) * (acc[mt][nt][0] + bsv);
                const float o1 = gelu_silu_(bfhi(u2.x), bfhi(g2.x)) * (acc[mt][nt][1] + bsv);
                const float o2 = gelu_silu_(bflo(u2.y), bflo(g2.y)) * (acc[mt][nt][2] + bsv);
                const float o3 = gelu_silu_(bfhi(u2.y), bfhi(g2.y)) * (acc[mt][nt][3] + bsv);
                u32x2 w; w.x = pk2(o0, o1); w.y = pk2(o2, o3); *(u32x2*)(y + row * D + 512 + ch) = w;
            }
        }
    }
    __syncthreads();
}

__device__ __forceinline__ MK_LAS unsigned short* c_elem(MK_LAS unsigned char* lds, int r, int c) { return (MK_LAS unsigned short*)(lds + r * 1024 + ((((c >> 3) ^ (r & 15))) * 16) + (c & 7) * 2); }
template <int G>
__device__ __forceinline__ void odd_c_pool(MK_LAS unsigned char* lds, int c_, bool seqstart) {
    int c = c_; asm volatile("" : "+v"(c));
    constexpr int WIN = 2 << G;
    float ring[WIN]; float sum = 0.f;
#pragma unroll
    for (int i = 0; i < WIN; ++i) ring[i] = 0.f;
#pragma unroll
    for (int h = 16 - WIN; h < 15; ++h) {
        const float v = seqstart ? 0.f : bf2f(*c_elem(lds, h, c));
        sum += v; ring[(h + 1) % WIN] = v; }
#pragma unroll 1
    for (int t0 = 0; t0 < 128; t0 += 16) {
#pragma unroll
        for (int i = 0; i < 16; ++i) {
            const int tt = t0 + i; MK_LAS unsigned short* p = c_elem(lds, tt + 15, c);
            const float v = bf2f(*p);
            sum += v - ring[i % WIN]; ring[i % WIN] = v;
            const float inv = (seqstart && tt < WIN) ? 1.0f / (float)(tt + 1) : 1.0f / (float)WIN;
            *p = f2bf(sum * inv - v);
        }
    }
}
template <int G>
__device__ __forceinline__ void odd_c_mma(const bf16_t* z, bf16_t* y, const float* pscale, const MK_LAS unsigned char* lds, int srow0, int half, int n_, int q_, const bf16x8 (&afr)[8][4]) {
    int n = n_, q = q_; asm volatile("" : "+v"(n), "+v"(q));
#pragma unroll 1
    for (int tl = 0; tl < 4; ++tl) {
        const int tloc = (half * 4 + tl) * 16 + n, row = srow0 + tloc, r = tloc + 15;
        u32x2 gwd[8];
#pragma unroll
        for (int mt = 0; mt < 8; ++mt) gwd[mt] = *(const u32x2*)(z + (size_t)row * NB + 512 + G * 128 + 16 * mt + 4 * q);
        f32x4 acc[8];
#pragma unroll
        for (int mt = 0; mt < 8; ++mt) acc[mt] = (f32x4){0.f, 0.f, 0.f, 0.f};
#pragma unroll
        for (int ks = 0; ks < 4; ++ks) {
            const bf16x8 bfrag = *(const MK_LAS bf16x8*)(lds + r * 1024 + (((G * 16 + 4 * ks + q) ^ (r & 15)) * 16));
#pragma unroll
            for (int mt = 0; mt < 8; ++mt) acc[mt] = __builtin_amdgcn_mfma_f32_16x16x32_bf16(afr[mt][ks], bfrag, acc[mt], 0, 0, 0);
        }
#pragma unroll
        for (int mt = 0; mt < 8; ++mt) {
            const int ch = G * 128 + 16 * mt + 4 * q;
            const f32x4 ps = *(const f32x4*)(pscale + ch);
            u32x2 w; w.x = pk2(acc[mt][0] * ps[0] * siluf_(bflo(gwd[mt].x)), acc[mt][1] * ps[1] * siluf_(bfhi(gwd[mt].x)));
            w.y = pk2(acc[mt][2] * ps[2] * siluf_(bflo(gwd[mt].y)), acc[mt][3] * ps[3] * siluf_(bfhi(gwd[mt].y)));
            *(u32x2*)(y + (size_t)row * D + ch) = w;
        }
    }
}
template <int G>
__device__ __forceinline__ void odd_c_group(const bf16_t* z, bf16_t* y, const bf16_t* WpT, const float* pscale, MK_LAS unsigned char* lds, int half, int tid, int n, int q) {
    bf16x8 afr[8][4];
#pragma unroll
    for (int mt = 0; mt < 8; ++mt)
#pragma unroll
        for (int ks = 0; ks < 4; ++ks) afr[mt][ks] = *(const bf16x8*)(WpT + ((size_t)G * 128 + 16 * mt + n) * 128 + 32 * ks + 8 * q);
    for (int run = blockIdx.x; run < M / 256; run += gridDim.x) {
        for (int sub = 0; sub < 2; ++sub) {
            const int srow0 = run * 256 + sub * 128;
            { int tl_ = tid; asm volatile("" : "+v"(tl_)); const int bk = tl_ & 63, r8 = tl_ >> 6;
#pragma unroll
              for (int hb = 0; hb < 3; ++hb) {
                  u32x4 st[6];
#pragma unroll
                  for (int i = 0; i < 6; ++i) { const int r = (hb * 6 + i) * 8 + r8; int grow = srow0 - 15 + (r < 143 ? r : 142); grow = grow < 0 ? 0 : grow; st[i] = *(const u32x4*)(z + (size_t)grow * NB + 8 * bk); }
#pragma unroll
                  for (int i = 0; i < 6; ++i) { const int r = (hb * 6 + i) * 8 + r8; if (r < 143) *(MK_LAS u32x4*)(lds + r * 1024 + ((bk ^ (r & 15)) * 16)) = st[i]; }
                  asm volatile("" ::: "memory");
              } }
            __syncthreads();
            odd_c_pool<G>(lds, tid, (srow0 & (SEQ - 1)) == 0);
            __syncthreads();
            odd_c_mma<G>(z, y, pscale, lds, srow0, half, n, q, afr);
            __syncthreads();
        }
    }
}
__device__ __forceinline__ void unpack8(const u32x4 w, float (&f)[8]) { f[0] = bflo(w.x); f[1] = bfhi(w.x); f[2] = bflo(w.y); f[3] = bfhi(w.y); f[4] = bflo(w.z); f[5] = bfhi(w.z); f[6] = bflo(w.w); f[7] = bfhi(w.w); }
__device__ __forceinline__ void odd_mixer(const bf16_t* z, bf16_t* y, const bf16_t* WpT  , const float* pscale, const float* cdw  , MK_LAS unsigned char* lds) {
    int tid_ = threadIdx.x; asm volatile("" : "+v"(tid_));
    const int tid = tid_, lane = tid & 63, wave = __builtin_amdgcn_readfirstlane(tid >> 6);
    const int n = lane & 15, q = lane >> 4;
    { const int g = wave >> 1, half = wave & 1;
      if (g == 0) odd_c_group<0>(z, y, WpT, pscale, lds, half, tid, n, q);
      else if (g == 1) odd_c_group<1>(z, y, WpT, pscale, lds, half, tid, n, q);
      else if (g == 2) odd_c_group<2>(z, y, WpT, pscale, lds, half, tid, n, q);
      else odd_c_group<3>(z, y, WpT, pscale, lds, half, tid, n, q); }
    const int c8 = lane * 8;
    f32x4 wa[3], wb[3];
#pragma unroll
    for (int k = 0; k < 3; ++k) { wa[k] = *(const f32x4*)(cdw + k * WB + c8); wb[k] = *(const f32x4*)(cdw + k * WB + c8 + 4); }
    for (int run = blockIdx.x; run < M / 256; run += gridDim.x) {
        const int r0 = run * 256 + 32 * wave, pos = r0 & (SEQ - 1);
        const bf16_t* zr = z + (size_t)r0 * NB + c8;
        float pm1[8], pm2[8];
        { const int bk = pos > 0 ? 1 : 0;
          const u32x4 h1 = *(const u32x4*)(zr - (ptrdiff_t)bk * NB + 1024), c1 = *(const u32x4*)(zr - (ptrdiff_t)bk * NB + 2048), h2 = *(const u32x4*)(zr - (ptrdiff_t)(2 * bk) * NB + 1024), c2 = *(const u32x4*)(zr - (ptrdiff_t)(2 * bk) * NB + 2048);
          float a[8], bq[8]; unpack8(h1, a); unpack8(c1, bq);
#pragma unroll
          for (int e = 0; e < 8; ++e) pm1[e] = bk ? a[e] * bq[e] : 0.f;
          unpack8(h2, a); unpack8(c2, bq);
#pragma unroll
          for (int e = 0; e < 8; ++e) pm2[e] = bk ? a[e] * bq[e] : 0.f; }
        for (int i0 = 0; i0 < 32; i0 += 4) {
            u32x4 hh[4], cc[4], db[4], dg[4];
#pragma unroll
            for (int i = 0; i < 4; ++i) { const bf16_t* p = zr + (size_t)(i0 + i) * NB; hh[i] = *(const u32x4*)(p + 1024); cc[i] = *(const u32x4*)(p + 2048); db[i] = *(const u32x4*)(p + 1536); dg[i] = *(const u32x4*)(p + 2560); }
#pragma unroll
            for (int i = 0; i < 4; ++i) {
                float a[8], bq[8], pc[8], dbf[8], dgf[8], o[8]; unpack8(hh[i], a); unpack8(cc[i], bq); unpack8(db[i], dbf); unpack8(dg[i], dgf);
#pragma unroll
                for (int e = 0; e < 8; ++e) { pc[e] = a[e] * bq[e];
                    const float w0 = e < 4 ? wa[0][e & 3] : wb[0][e & 3], w1 = e < 4 ? wa[1][e & 3] : wb[1][e & 3], w2 = e < 4 ? wa[2][e & 3] : wb[2][e & 3];
                    const float conv = w0 * pm2[e] + w1 * pm1[e] + w2 * pc[e];
                    o[e] = dbf[e] * conv * siluf_(dgf[e]); pm2[e] = pm1[e]; pm1[e] = pc[e]; }
                u32x4 ow; ow.x = pk2(o[0], o[1]); ow.y = pk2(o[2], o[3]); ow.z = pk2(o[4], o[5]); ow.w = pk2(o[6], o[7]);
                *(u32x4*)(y + (size_t)(r0 + i0 + i) * D + 512 + c8) = ow;
            }
        }
    }
}

__global__ void __launch_bounds__(512) fwd_megakernel(Params P, int ph_lo, int ph_hi) {
    extern __shared__ __attribute__((aligned(16))) unsigned char lds_raw[];
    MK_LAS unsigned char* lds = (MK_LAS unsigned char*)lds_raw;
    cg::grid_group grid = cg::this_grid();
    if (threadIdx.x == 0) { ((MK_LAS unsigned*)(lds + LDS_BYTES - 16))[0] = 0u; ((MK_LAS unsigned*)(lds + LDS_BYTES - 16))[1] = 0u; }
    __syncthreads();
    const XcdBarrier xbar = xcd_barrier_post((unsigned*)(P.ws + WS_BAR), (volatile LAS unsigned*)(lds + LDS_BYTES - 16));
    int ph = 0;
#define MK_IN() (ph_lo <= ph && ph < ph_hi)
#define MK_STAGGER(ticks) do { if ((ticks) > 0 && ((blockIdx.x >> 3) & 1)) { const unsigned long long t0_ = __builtin_amdgcn_s_memrealtime(); while (__builtin_amdgcn_s_memrealtime() - t0_ < (unsigned long long)(ticks)) __builtin_amdgcn_s_sleep(16); } } while (0)
#define MK_SEAM() do { if (ph_lo <= ph && ph + 1 < ph_hi) { for (int r_ = 0; r_ < REP_SYNC; ++r_) { if (ph_hi < 0) grid.sync(); else xcd_barrier(xbar); } } ++ph; } while (0)
    if (MK_IN()) { for (int r0_ = 0; r0_ < REP_P0; ++r0_) { p0_prologue(P, lds); __syncthreads(); } }
    MK_SEAM();
#pragma clang loop unroll(disable)
    for (int l0 = 0; l0 < DEPTH; ++l0) {
#define MK_LAUNDER() int l = l0; asm volatile("" : "+s"(l)); const int j = l >> 1; const bool odd = l & 1; unsigned char* ws = P.ws; asm volatile("" : "+s"(ws)); bf16_t* xcur = (bf16_t*)(ws + WS_XB); bf16_t* tbuf = (bf16_t*)(ws + WS_XB) + (size_t)M * D; bf16_t* z = (bf16_t*)(ws + WS_Z); bf16_t* yb = (bf16_t*)(ws + WS_Y); bf16_t* ple = (bf16_t*)(ws + WS_Z);
        if (MK_IN()) { MK_LAUNDER()
            pg8::Gemm g{xcur, (const bf16_t*)(ws + WS_WIN) + (size_t)l * NB * D, M, NB, D}; pg8::StaticOrder S; S.init(M, NB, (int)gridDim.x, (int)blockIdx.x);
            { const float* bsrc = (odd ? P.in[15] : P.in[3]) + (size_t)j * NB; MK_LAS float* lb = (MK_LAS float*)(lds + 131072);
              int ti_ = threadIdx.x; asm volatile("" : "+v"(ti_));
              for (int i = ti_; i < NB / 4; i += NTHREADS) *(MK_LAS f32x4*)(lb + 4 * i) = *(const f32x4*)(bsrc + 4 * i);
              __syncthreads(); }
            EpiZ E{z, NB, (const MK_LAS float*)(lds + 131072)};
            MK_STAGGER(STAG1);
            for (int rep = 0; rep < REP_P1; ++rep) pg8::gemm_phase<EpiZ, pg8::StaticOrder, MK_ALIGN_EPI, MK_SP2>(lds, g, S, E);
        }
        MK_SEAM();
        if (MK_IN()) { MK_LAUNDER()
            for (int rep = 0; rep < (odd ? REP_P2O : REP_P2E); ++rep)
            if (!odd) {
                for (int run = blockIdx.x; run < M / 256; run += gridDim.x) {
                    for (int ra = 0; ra < REP_A; ++ra) even_a_branch(z, yb, P.in[4] + (size_t)j * 31 * WB, P.in[5] + j * WB, P.in[6] + j * WB, P.in[7] + j * WB, run, lds);
                    __syncthreads();
                    for (int bb = 0; bb < 2; ++bb)
                        even_b_block(z, yb, P.in[8] + j * WB, P.in[9] + j * WB, (const bf16_t*)(ws + WS_WS) + (size_t)j * 8 * 128 * 128, P.in[11] + j * 8 * 128, run * 2 + bb, lds);
                }
            } else {
                odd_mixer(z, yb, (const bf16_t*)(ws + WS_WP) + (size_t)j * 4 * 128 * 128, P.in[17] + j * WB, P.in[18] + (size_t)j * 3 * WB, lds);
            }
        }
        MK_SEAM();
        if (MK_IN()) { MK_LAUNDER()
            { pg8::Gemm g{yb, (const bf16_t*)(ws + WS_WOUT) + (size_t)l * D * D, M, D, D}; pg8::StaticOrder S; S.init(M, D, (int)gridDim.x, (int)blockIdx.x);
              MK_STAGGER(STAG3);
              EpiT E{xcur, tbuf, (odd ? P.in[20] : P.in[13]) + (size_t)j * D, (float*)(ws + WS_STATS)};
#if REP_K3
              { EpiNull EN; pg8::gemm_phase<EpiNull, pg8::StaticOrder, MK_ALIGN_EPI, MK_SP2>(lds, g, S, EN); }
#endif
              pg8::gemm_phase<EpiT, pg8::StaticOrder, MK_ALIGN_EPI, MK_SP2>(lds, g, S, E); }
            { pg8::Gemm g{(const bf16_t*)(ws + WS_PB) + (size_t)l * M * DP, (const bf16_t*)(ws + WS_WPLE) + (size_t)l * D * DP, M, D, DP}; pg8::StaticOrder S; S.init(M, D, (int)gridDim.x, (int)blockIdx.x);
              EpiZ E{ple, D, nullptr};
              for (int rp_ = 0; rp_ < REP_PLE; ++rp_) pg8::gemm_phase<EpiZ, pg8::StaticOrder, MK_ALIGN_EPI, MK_SP2>(lds, g, S, E); }
        }
        MK_SEAM();
        if (MK_IN()) { MK_LAUNDER()
            pg8::Gemm g{tbuf, (const bf16_t*)(ws + WS_WGATE) + (size_t)l * D * D, M, D, D}; pg8::StaticOrder S; S.init(M, D, (int)gridDim.x, (int)blockIdx.x);
            const float* c12 = (const float*)(ws + WS_C12) + (size_t)l * 2 * D;
            { int ti_ = threadIdx.x; asm volatile("" : "+v"(ti_)); MK_LAS float* lvw = (MK_LAS float*)(lds + 131072);
              const float* lg_ = P.in[21] + (size_t)l * D; const float* lb_ = P.in[22] + (size_t)l * D;
              for (int i = ti_; i < 1024; i += NTHREADS) { const int vec = i >> 8, idx = (i & 255) * 4; const float* src = vec == 0 ? lg_ : vec == 1 ? lb_ : vec == 2 ? c12 : c12 + D;
                  *(MK_LAS f32x4*)(lvw + vec * 1024 + idx) = *(const f32x4*)(src + idx); }
              __syncthreads(); }
            MK_STAGGER(STAG5);
            EpiGate2 E{tbuf, ple, xcur, (l == DEPTH - 1) ? P.out : nullptr, (const float*)(ws + WS_STATS), (const MK_LAS float*)(lds + 131072)};
            for (int r5_ = 0; r5_ < REP_P5; ++r5_) pg8::gemm_phase<EpiGate2, pg8::StaticOrder, MK_ALIGN_EPI, MK_SP2>(lds, g, S, E);
        }
        MK_SEAM();
    }
#undef MK_IN
#undef MK_LAUNDER
#undef MK_SEAM
}
}

extern "C" void kernel_launch(void* const* d_in, const int* in_sizes, int n_in, void* d_out, int out_size, void* d_ws, size_t ws_size, hipStream_t stream) {
    static int ready = 0;
    if (!ready) {
        if (n_in != 26 || out_size != mk::M * mk::D || ws_size < mk::WS_END) { fprintf(stderr, "kernel_launch: unexpected shapes (n_in %d out %d ws %zu need %zu)\n", n_in, out_size, ws_size, (size_t)mk::WS_END); }
        if (hipFuncSetAttribute((const void*)mk::fwd_megakernel, hipFuncAttributeMaxDynamicSharedMemorySize, mk::LDS_BYTES) != hipSuccess) fprintf(stderr, "kernel_launch: hipFuncSetAttribute failed\n");
        ready = 1;
    }
    (void)hipMemsetAsync((unsigned char*)d_ws + mk::WS_BAR, 0, (size_t)XCD_BAR_WORDS * 4, stream);
    mk::Params P{};
    for (int i = 0; i < 26; ++i) P.in[i] = (const float*)d_in[i];
    P.out = (float*)d_out; P.ws = (unsigned char*)d_ws;
    int lo = 0, hi = 1 + 4 * mk::DEPTH;
    void* args[] = {&P, &lo, &hi};
    hipError_t e = hipLaunchCooperativeKernel((const void*)mk::fwd_megakernel, dim3(256), dim3(mk::NTHREADS), args, mk::LDS_BYTES, stream);
    if (e != hipSuccess) fprintf(stderr, "cooperative launch failed: %s\n", hipGetErrorString(e));
}
```

```cpp
#include <hip/hip_runtime.h>
#include <hip/hip_cooperative_groups.h>
#include <cstdio>
namespace cg = cooperative_groups;
#ifndef MK_WGM
#define MK_WGM 8
#endif

#define XB_TMO      128
#define XB_XCNT(j)  (256  + 64 * (j))
#define XB_XSUB(j)  (1280 + 64 * (j))
#define XB_XGEN(j)  (2304 + 64 * (j))
#define XB_TOP      3328
#define XB_TOPGEN   3392
#define XCD_BAR_WORDS 3456
#define XB_SPIN_CAP (1u << 18)
#define LAS __attribute__((address_space(3)))

__device__ __forceinline__ unsigned xb_ld(unsigned* p)              { return __hip_atomic_load(p, __ATOMIC_RELAXED, __HIP_MEMORY_SCOPE_AGENT); }
__device__ __forceinline__ unsigned xb_add(unsigned* p, unsigned v) { return __hip_atomic_fetch_add(p, v, __ATOMIC_RELAXED, __HIP_MEMORY_SCOPE_AGENT); }
__device__ __forceinline__ unsigned xb_xcc_id() { return (unsigned)__builtin_amdgcn_s_getreg((3 << 11) | 20) & 0xFu; }
#define XB_SPIN(cond, bar) do { unsigned _sp = 0; while (cond) { __builtin_amdgcn_s_sleep(1); \
    if ((++_sp & 255u) == 0u) { if (xb_ld(&(bar)[XB_TMO])) break; if (_sp > XB_SPIN_CAP) { atomicAdd(&(bar)[XB_TMO], 1u); break; } } } } while (0)

struct XcdBarrier {
    unsigned* bar; unsigned x;
    volatile LAS unsigned* st;
};

__device__ __forceinline__ XcdBarrier xcd_barrier_post(unsigned* bar, volatile LAS unsigned* st) {
    XcdBarrier b; b.bar = bar; b.x = xb_xcc_id(); b.st = st;
    if (threadIdx.x == 0) (void)xb_add(&bar[XB_XCNT(b.x)], 1u);
    return b;
}
__device__ __forceinline__ void xcd_barrier_complete(unsigned* bar, unsigned x, unsigned& nloc, unsigned& nx) {
    const unsigned G = gridDim.x * gridDim.y * gridDim.z;
    unsigned sum, cnt, mine, sp = 0u;
    for (;;) {
        sum = 0u; cnt = 0u; mine = 0u;
#pragma unroll
        for (unsigned j = 0; j < 16; ++j) { const unsigned c = xb_ld(&bar[XB_XCNT(j)]); sum += c; cnt += (c > 0u) ? 1u : 0u; mine = (j == x) ? c : mine; }
        if (sum == G) break;
        __builtin_amdgcn_s_sleep(1);
        if ((++sp & 255u) == 0u) { if (xb_ld(&bar[XB_TMO])) break; if (sp > XB_SPIN_CAP) { atomicAdd(&bar[XB_TMO], 1u); break; } }
    }
    nloc = mine > 0u ? mine : 1u; nx = cnt > 0u ? cnt : 1u;
}

__device__ __forceinline__ void xcd_barrier(const XcdBarrier& b) {
    asm volatile("s_waitcnt vmcnt(0)" ::: "memory");
    __syncthreads();
    if (threadIdx.x == 0) {
        unsigned* bar = b.bar;
        __builtin_amdgcn_s_waitcnt(0);
        unsigned nloc = b.st[0], nx = b.st[1];
        if (nloc == 0u) { xcd_barrier_complete(bar, b.x, nloc, nx); b.st[0] = nloc; b.st[1] = nx; }
        const unsigned old = xb_add(&bar[XB_XSUB(b.x)], 1u);
        const unsigned gen = old / nloc;
        if (old + 1u == (gen + 1u) * nloc) {
            __builtin_amdgcn_fence(__ATOMIC_RELEASE, "agent");
            asm volatile("s_waitcnt vmcnt(0)" ::: "memory");
            const unsigned og = xb_add(&bar[XB_TOP], 1u);
            const unsigned tg = og / nx;
            if (og + 1u == (tg + 1u) * nx) xb_add(&bar[XB_TOPGEN], 1u);
            else XB_SPIN(xb_ld(&bar[XB_TOPGEN]) == tg, bar);
            __builtin_amdgcn_fence(__ATOMIC_ACQUIRE, "agent");
            xb_add(&bar[XB_XGEN(b.x)], 1u);
            asm volatile("s_waitcnt vmcnt(0)" ::: "memory");
        } else {
            XB_SPIN(xb_ld(&bar[XB_XGEN(b.x)]) == gen, bar);
            __builtin_amdgcn_fence(__ATOMIC_ACQUIRE, "agent");
            asm volatile("s_waitcnt vmcnt(0)" ::: "memory");
        }
    }
    __syncthreads();
}
namespace pg8 {
#define PG8_LAS __attribute__((address_space(3)))
typedef unsigned short bf16_t;
typedef short bf16x8 __attribute__((ext_vector_type(8)));
typedef float f32x4 __attribute__((ext_vector_type(4)));
typedef unsigned u32x4 __attribute__((ext_vector_type(4)));
constexpr int BM = 256, BK = 64, HALF = 128, HTB = HALF * BK * 2  , STAGE_BYTES = 8 * HTB, NXCD = 8, WGM = MK_WGM;

__host__ __device__ __forceinline__ int lds_byte(int r, int c) { const int st = (r >> 4) * 2 + (c >> 5), rr = r & 15, cc = c & 31, ob = rr * 64 + cc * 2; return st * 1024 + (ob ^ (((ob >> 9) & 1) << 5)); }
__host__ __device__ __forceinline__ void stage_rc(int b, int& R, int& C) { const int st = b / 1024, sb = b % 1024, swz = sb ^ (((sb >> 9) & 1) << 5); R = (st >> 1) * 16 + swz / 64; C = (st & 1) * 32 + (swz % 64) / 2; }
__host__ __device__ __forceinline__ int perm32(int rho) { const int n = rho >> 4, i = rho & 15; return 8 * (i >> 2) + 4 * n + (i & 3); }

struct Unit { int pm, pn; };
struct Gemm { const bf16_t* A; const bf16_t* Bt; int M, N, K; };

struct StaticOrder {
    int nM, nN, nwg, G, c;
    __host__ __device__ void init(int M, int N, int G_, int c_) { nM = M / BM; nN = N / BM; nwg = nM * nN; G = G_; c = c_; }
    __host__ __device__ bool next(int i, Unit& u) const {
        const long L = (long)i * G + c; if (L >= nwg) return false;
        int wgid = (int)L; { const int q = nwg / NXCD, r = nwg % NXCD, xcd = wgid % NXCD, off = wgid / NXCD; wgid = (xcd < r ? xcd * (q + 1) : r * (q + 1) + (xcd - r) * q) + off; }
        const int nig = WGM * nN, gid = wgid / nig, fm = gid * WGM, gsz = (nM - fm) < WGM ? (nM - fm) : WGM;
        u.pm = fm + ((wgid % nig) % gsz); u.pn = (wgid % nig) / gsz; return true;
    }
    __device__ __forceinline__ void a_ready(const Unit&) const {}
    __device__ __forceinline__ void done(const Unit&) const {}
};
__device__ __forceinline__ unsigned cvt_pk_bf16(float lo, float hi) { unsigned r; asm volatile("v_cvt_pk_bf16_f32 %0, %1, %2" : "=v"(r) : "v"(lo), "v"(hi)); return r; }
typedef float f32x2 __attribute__((ext_vector_type(2)));
__device__ __forceinline__ f32x2 gelu_pk(f32x2 v) {
    const f32x2 av = __builtin_elementwise_abs(v), d = av * 0.2316418882f + 1.0f;
    f32x2 t; t.x = __builtin_amdgcn_rcpf(d.x); t.y = __builtin_amdgcn_rcpf(d.y);
    f32x2 q = t * 0.5307027145f + (-0.7265760135f); q = q * t + 0.7107068705f; q = q * t + (-0.142248368f); q = q * t + 0.127414796f; q = q * t;
    const f32x2 s = (v * v) * (-0.72134752044f);
    f32x2 e; e.x = __builtin_amdgcn_exp2f(s.x); e.y = __builtin_amdgcn_exp2f(s.y);
    const f32x2 m = v * (q * e), r = v - m;
    f32x2 o; o.x = v.x < 0.f ? m.x : r.x; o.y = v.y < 0.f ? m.y : r.y; return o;
}

struct EpiF32 {
    static constexpr bool PERM = false, AFTER_DRAIN = false;
    float* C; int ldc; const float* bias;
    __device__ __forceinline__ void operator()(const f32x4 (&acc)[2][2][4][2], const Unit& u, int wr, int wc, int fr, int fq) const {
        const int row0 = u.pm * BM + wr * 64 + fr, col0 = u.pn * BM + wc * 32 + 4 * fq;
        f32x4 bv[2][2];
#pragma unroll
        for (int bj = 0; bj < 2; ++bj)
#pragma unroll
            for (int n = 0; n < 2; ++n) bv[bj][n] = bias ? *(const f32x4*)(bias + col0 + bj * HALF + n * 16) : (f32x4){0.f, 0.f, 0.f, 0.f};
#pragma unroll
        for (int ai = 0; ai < 2; ++ai)
#pragma unroll
            for (int m = 0; m < 4; ++m) { float* rowp = C + (size_t)(row0 + ai * HALF + m * 16) * ldc + col0;
#pragma unroll
                for (int bj = 0; bj < 2; ++bj)
#pragma unroll
                    for (int n = 0; n < 2; ++n) *(f32x4*)(rowp + bj * HALF + n * 16) = acc[ai][bj][m][n] + bv[bj][n]; }
    }
};
template <int ACT  > struct EpiBf16 {
    static constexpr bool PERM = true, AFTER_DRAIN = false;
    bf16_t* O; int ldc; const float* bias; int split_cols; size_t split_stride;
    __device__ __forceinline__ void operator()(const f32x4 (&acc)[2][2][4][2], const Unit& u, int wr, int wc, int fr, int fq) const {
        const int row0 = u.pm * BM + wr * 64 + fr; int colt = u.pn * BM; bf16_t* base = O;
        if (split_cols) { const int t = colt / split_cols; base += (size_t)t * split_stride; colt -= t * split_cols; }
        const int col0 = colt + wc * 32 + 8 * fq, bcol0 = u.pn * BM + wc * 32 + 8 * fq;
        f32x4 bv[2][2];
#pragma unroll
        for (int bj = 0; bj < 2; ++bj)
#pragma unroll
            for (int n = 0; n < 2; ++n) bv[bj][n] = bias ? *(const f32x4*)(bias + bcol0 + bj * HALF + 4 * n) : (f32x4){0.f, 0.f, 0.f, 0.f};
#pragma unroll
        for (int ai = 0; ai < 2; ++ai)
#pragma unroll
            for (int m = 0; m < 4; ++m) { bf16_t* rowp = base + (size_t)(row0 + ai * HALF + m * 16) * ldc + col0;
#pragma unroll
                for (int bj = 0; bj < 2; ++bj) { f32x4 v0 = acc[ai][bj][m][0] + bv[bj][0], v1 = acc[ai][bj][m][1] + bv[bj][1];
                    if (ACT == 1) { f32x2 a = gelu_pk((f32x2){v0[0], v0[1]}), b = gelu_pk((f32x2){v0[2], v0[3]}), c = gelu_pk((f32x2){v1[0], v1[1]}), d = gelu_pk((f32x2){v1[2], v1[3]});
                        v0 = (f32x4){a.x, a.y, b.x, b.y}; v1 = (f32x4){c.x, c.y, d.x, d.y}; }
                    if (ACT == 2) {
#pragma unroll
                        for (int j = 0; j < 4; ++j) { v0[j] = 0.5f * v0[j] * (1.0f + erff(v0[j] * 0.70710678f)); v1[j] = 0.5f * v1[j] * (1.0f + erff(v1[j] * 0.70710678f)); } }
                    u32x4 w; w.x = cvt_pk_bf16(v0[0], v0[1]); w.y = cvt_pk_bf16(v0[2], v0[3]); w.z = cvt_pk_bf16(v1[0], v1[1]); w.w = cvt_pk_bf16(v1[2], v1[3]);
                    *(u32x4*)(rowp + bj * HALF) = w; } }
    }
};
template <class Epi, class Sched, bool ALIGN_EPI = false, bool SP2 = false>
__device__ __forceinline__ void gemm_phase(PG8_LAS unsigned char* lds, const Gemm g, const Sched& S, const Epi& E) {
    int tid_ = threadIdx.x; asm volatile("" : "+v"(tid_));
    const int tid = tid_, wid = __builtin_amdgcn_readfirstlane(tid >> 6), lane = tid & 63, wr = wid >> 2, wc = wid & 3, fr = lane & 15, fq = lane >> 4;
    const int K = g.K, nt = K / BK;
    unsigned voffA[2], voffB[2];
#pragma unroll
    for (int i = 0; i < 2; ++i) { int R, C; stage_rc(tid * 16 + i * 8192, R, C); const int Rb = Epi::PERM ? ((R & ~31) + perm32(R & 31)) : R;
        voffA[i] = (unsigned)(R * K + C) * 2u; voffB[i] = (unsigned)(Rb * K + C) * 2u; }
    const size_t kstep = (size_t)(BK * 2);
    const size_t hstep = (size_t)HALF * K * 2;
    const size_t tstep = 2 * hstep;
    const unsigned ldsw = (unsigned)wid * 1024u;
    const int aoff = lds_byte(wr * 64 + fr, fq * 8), boff = lds_byte(wc * 32 + fr, fq * 8);
#define PG8_SA(b, h) (((b) * 2 + (h)) * HTB)
#define PG8_SB(b, h) ((4 + (b) * 2 + (h)) * HTB)
#define PG8_STAGE(bufoff, gbase, voff) do { _Pragma("unroll") for (int _i = 0; _i < 2; ++_i) \
        __builtin_amdgcn_global_load_lds((const unsigned*)((const char*)(gbase) + (voff)[_i]), (PG8_LAS unsigned*)(lds + (bufoff) + ldsw + _i * 8192), 16, 0, 0); } while (0)
#define PG8_LDA(dst, b, h) do { _Pragma("unroll") for (int m = 0; m < 4; ++m) _Pragma("unroll") for (int k = 0; k < 2; ++k) dst[m][k] = *(const PG8_LAS bf16x8*)(lds + PG8_SA(b, h) + aoff + m * 2048 + k * 1024); } while (0)
#define PG8_LDB(dst, b, h) do { _Pragma("unroll") for (int n = 0; n < 2; ++n) _Pragma("unroll") for (int k = 0; k < 2; ++k) dst[n][k] = *(const PG8_LAS bf16x8*)(lds + PG8_SB(b, h) + boff + n * 2048 + k * 1024); } while (0)
#define PG8_MMA(ai, bj, At, Bt) do { __builtin_amdgcn_s_setprio(1); _Pragma("unroll") for (int m = 0; m < 4; ++m) _Pragma("unroll") for (int n = 0; n < 2; ++n) _Pragma("unroll") for (int k = 0; k < 2; ++k) \
        acc[ai][bj][m][n] = __builtin_amdgcn_mfma_f32_16x16x32_bf16(Bt[n][k], At[m][k], acc[ai][bj][m][n], 0, 0, 0); __builtin_amdgcn_s_setprio(0); } while (0)
#define PG8_WAIT_V(n) asm volatile("s_waitcnt vmcnt(" #n ")" ::: "memory")
#define PG8_WAIT_L(n) asm volatile("s_waitcnt lgkmcnt(" #n ")" ::: "memory")
#define PG8_BAR __builtin_amdgcn_s_barrier()
#define PG8_SCHED __builtin_amdgcn_sched_barrier(0)
    Unit cur, nxt; int ui = 0;
    if (!S.next(0, cur)) return;
    f32x4 acc[2][2][4][2];
#pragma unroll
    for (int a = 0; a < 2; ++a)
#pragma unroll
        for (int b = 0; b < 2; ++b)
#pragma unroll
            for (int m = 0; m < 4; ++m)
#pragma unroll
                for (int n = 0; n < 2; ++n) acc[a][b][m][n] = (f32x4){0.f, 0.f, 0.f, 0.f};
    bf16x8 At[4][2], B0[2][2], B1[2][2];
    const char* cA = (const char*)g.A + (size_t)cur.pm * tstep; const char* cB = (const char*)g.Bt + (size_t)cur.pn * tstep;
    S.a_ready(cur);
    if constexpr (SP2) {
        PG8_STAGE(PG8_SB(0, 0), cB, voffB); PG8_STAGE(PG8_SB(0, 1), cB + hstep, voffB); PG8_STAGE(PG8_SA(0, 0), cA, voffA); PG8_STAGE(PG8_SA(0, 1), cA + hstep, voffA);
        if (wr == 1) PG8_BAR;
        PG8_WAIT_V(2); PG8_BAR;
        PG8_STAGE(PG8_SB(1, 0), cB + kstep, voffB); PG8_STAGE(PG8_SA(1, 0), cA + kstep, voffA); PG8_STAGE(PG8_SB(1, 1), cB + hstep + kstep, voffB);
        PG8_WAIT_V(6); PG8_BAR;
    } else {
        PG8_STAGE(PG8_SB(0, 0), cB, voffB); PG8_STAGE(PG8_SA(0, 0), cA, voffA); PG8_STAGE(PG8_SB(0, 1), cB + hstep, voffB); PG8_STAGE(PG8_SA(0, 1), cA + hstep, voffA);
        if (wr == 1) PG8_BAR;
        PG8_WAIT_V(4); PG8_BAR;
        PG8_STAGE(PG8_SB(1, 0), cB + kstep, voffB); PG8_STAGE(PG8_SA(1, 0), cA + kstep, voffA); PG8_STAGE(PG8_SB(1, 1), cB + hstep + kstep, voffB);
        PG8_WAIT_V(6); PG8_BAR;
    }
    for (;;) {
        const bool has_next = S.next(ui + 1, nxt);
        const char* nA = has_next ? (const char*)g.A + (size_t)nxt.pm * tstep : cA; const char* nB = has_next ? (const char*)g.Bt + (size_t)nxt.pn * tstep : cB;
        for (int t = 0; t < nt; t += 2) {
            const bool last = (t == nt - 2);
            const char* a1 = cA + (size_t)(t + 1) * kstep;
            const char* a2 = last ? nA : cA + (size_t)(t + 2) * kstep; const char* b2 = last ? nB : cB + (size_t)(t + 2) * kstep;
            const char* a3 = a2 + kstep; const char* b3 = b2 + kstep;
            if (last && has_next) S.a_ready(nxt);
            if constexpr (SP2) {
            PG8_LDB(B0, 0, 0); PG8_LDB(B1, 0, 1); PG8_SCHED; PG8_LDA(At, 0, 0); PG8_STAGE(PG8_SA(1, 1), a1 + hstep, voffA);
            PG8_WAIT_V(8); PG8_WAIT_L(0); PG8_BAR; PG8_MMA(0, 0, At, B0); PG8_MMA(0, 1, At, B1); PG8_BAR; PG8_SCHED;
            PG8_LDA(At, 0, 1); PG8_STAGE(PG8_SB(0, 0), b2, voffB); PG8_STAGE(PG8_SB(0, 1), b2 + hstep, voffB); PG8_STAGE(PG8_SA(0, 0), a2, voffA);
            PG8_WAIT_V(8); PG8_WAIT_L(0); PG8_BAR; PG8_MMA(1, 0, At, B0); PG8_MMA(1, 1, At, B1); PG8_BAR; PG8_SCHED;
            PG8_LDB(B0, 1, 0); PG8_LDB(B1, 1, 1); PG8_SCHED; PG8_LDA(At, 1, 0); PG8_STAGE(PG8_SA(0, 1), a2 + hstep, voffA);
            PG8_WAIT_V(8); PG8_WAIT_L(0); PG8_BAR; PG8_MMA(0, 0, At, B0); PG8_MMA(0, 1, At, B1); PG8_BAR; PG8_SCHED;
            PG8_LDA(At, 1, 1); PG8_STAGE(PG8_SB(1, 0), b3, voffB); PG8_STAGE(PG8_SB(1, 1), b3 + hstep, voffB); PG8_STAGE(PG8_SA(1, 0), a3, voffA);
            PG8_WAIT_V(8); PG8_WAIT_L(0); PG8_BAR; PG8_MMA(1, 0, At, B0); PG8_MMA(1, 1, At, B1); PG8_BAR; PG8_SCHED;
            } else {
            PG8_LDB(B0, 0, 0); PG8_SCHED; PG8_LDA(At, 0, 0); PG8_STAGE(PG8_SA(1, 1), a1 + hstep, voffA);
            PG8_WAIT_L(8); PG8_BAR; PG8_WAIT_L(0); PG8_MMA(0, 0, At, B0); PG8_BAR; PG8_SCHED;
            PG8_LDB(B1, 0, 1); PG8_STAGE(PG8_SB(0, 0), b2, voffB);
            PG8_BAR; PG8_WAIT_L(0); PG8_MMA(0, 1, At, B1); PG8_BAR;
            PG8_LDA(At, 0, 1); PG8_STAGE(PG8_SA(0, 0), a2, voffA);
            PG8_BAR; PG8_WAIT_L(0); PG8_MMA(1, 0, At, B0); PG8_BAR; PG8_SCHED;
            PG8_STAGE(PG8_SB(0, 1), b2 + hstep, voffB);
            PG8_WAIT_V(6); PG8_BAR; PG8_MMA(1, 1, At, B1); PG8_BAR;
            PG8_LDB(B0, 1, 0); PG8_SCHED; PG8_LDA(At, 1, 0); PG8_STAGE(PG8_SA(0, 1), a2 + hstep, voffA);
            PG8_WAIT_L(8); PG8_BAR; PG8_WAIT_L(0); PG8_MMA(0, 0, At, B0); PG8_BAR; PG8_SCHED;
            PG8_LDB(B1, 1, 1); PG8_STAGE(PG8_SB(1, 0), b3, voffB);
            PG8_BAR; PG8_WAIT_L(0); PG8_MMA(0, 1, At, B1); PG8_BAR;
            PG8_LDA(At, 1, 1); PG8_STAGE(PG8_SA(1, 0), a3, voffA);
            PG8_BAR; PG8_WAIT_L(0); PG8_MMA(1, 0, At, B0); PG8_BAR; PG8_SCHED;
            PG8_STAGE(PG8_SB(1, 1), b3 + hstep, voffB);
            PG8_WAIT_V(6); PG8_BAR; PG8_MMA(1, 1, At, B1); PG8_BAR;
            }
        }
        if constexpr (ALIGN_EPI) { if (wr == 0) PG8_BAR; }
        if constexpr (!Epi::AFTER_DRAIN) { E(acc, cur, wr, wc, fr, fq); S.done(cur); }
        if (!has_next) break;
#pragma unroll
        for (int a = 0; a < 2; ++a)
#pragma unroll
            for (int b = 0; b < 2; ++b)
#pragma unroll
                for (int m = 0; m < 4; ++m)
#pragma unroll
                    for (int n = 0; n < 2; ++n) acc[a][b][m][n] = (f32x4){0.f, 0.f, 0.f, 0.f};
        cur = nxt; cA = nA; cB = nB; ++ui;
        if constexpr (ALIGN_EPI) { if (wr == 1) PG8_BAR; }
    }
    PG8_WAIT_V(0);
    if constexpr (!ALIGN_EPI) { if (wr == 0) PG8_BAR; }
    PG8_BAR;
    if constexpr (Epi::AFTER_DRAIN) { E.fused(acc, cur, wr, wc, fr, fq, lds, wid, lane); S.done(cur); }
#undef PG8_SA
#undef PG8_SB
#undef PG8_STAGE
#undef PG8_LDA
#undef PG8_LDB
#undef PG8_MMA
#undef PG8_WAIT_V
#undef PG8_WAIT_L
#undef PG8_BAR
#undef PG8_SCHED
}
}

#ifndef REP_SYNC
#define REP_SYNC 1
#endif
#ifndef REP_P1
#define REP_P1 1
#endif
#ifndef MK_ALIGN_EPI
#define MK_ALIGN_EPI true
#endif
#ifndef MK_SP2
#define MK_SP2 true
#endif
#ifndef NT_Z
#define NT_Z 0
#endif
#ifndef STAG1
#define STAG1 0
#endif
#ifndef STAG3
#define STAG3 0
#endif
#ifndef STAG5
#define STAG5 0
#endif
#ifndef REP_K3
#define REP_K3 0
#endif
#ifndef REP_P0
#define REP_P0 1
#endif
#ifndef REP_PLE
#define REP_PLE 1
#endif
#ifndef REP_P5
#define REP_P5 1
#endif
#ifndef REP_A
#define REP_A 1
#endif
#ifndef REP_P2E
#define REP_P2E 1
#endif
#ifndef REP_P2O
#define REP_P2O 1
#endif
namespace mk {
using pg8::bf16_t; using pg8::bf16x8; using pg8::f32x4; using pg8::u32x4;
typedef unsigned u32x2 __attribute__((ext_vector_type(2)));
typedef float f32x2 __attribute__((ext_vector_type(2)));
typedef short bf16x4 __attribute__((ext_vector_type(4)));
#define MK_LAS __attribute__((address_space(3)))
constexpr int M = 65536, D = 1024, NB = 3072, DP = 256, SEQ = 4096, WB = 512, DEPTH = 4;
constexpr float LN_EPS = 1e-5f;
constexpr float ALPHA = 1.681792830507429f;
constexpr int NTHREADS = 512, NWAVES = 8;
constexpr int LDS_BYTES = 147520;
constexpr int LDS_RED = 139264;
constexpr int VT_STRIDE = 132;
constexpr size_t WS_WIN = 0;
constexpr size_t WS_WOUT = WS_WIN + (size_t)4 * NB * D * 2;
constexpr size_t WS_WGATE = WS_WOUT + (size_t)4 * D * D * 2;
constexpr size_t WS_WPLE = WS_WGATE + (size_t)4 * D * D * 2;
constexpr size_t WS_WS = WS_WPLE + (size_t)4 * D * DP * 2;
constexpr size_t WS_WP = WS_WS + (size_t)2 * 8 * 128 * 128 * 2;
constexpr size_t WS_XB = WS_WP + (size_t)2 * 4 * 128 * 128 * 2;
constexpr size_t WS_PB = WS_XB + (size_t)2 * M * D * 2;
constexpr size_t WS_Z = WS_PB + (size_t)4 * M * DP * 2;
constexpr size_t WS_Y = WS_Z + (size_t)M * NB * 2;
constexpr size_t WS_STATS = WS_Y + (size_t)M * D * 2;
constexpr size_t WS_C12 = WS_STATS + (size_t)M * 16 * 2 * 4;
constexpr size_t WS_BAR = WS_C12 + (size_t)4 * 2 * D * 4;
constexpr size_t WS_END = WS_BAR + (size_t)XCD_BAR_WORDS * 4;

struct Params { const float* in[26]; float* out; unsigned char* ws; };

__device__ __forceinline__ float bf2f(unsigned short b) { return __uint_as_float((unsigned)b << 16); }
__device__ __forceinline__ float bflo(unsigned w) { return __uint_as_float(w << 16); }
__device__ __forceinline__ float bfhi(unsigned w) { return __uint_as_float(w & 0xffff0000u); }
__device__ __forceinline__ unsigned short f2bf(float f) { unsigned u = __float_as_uint(f); u += 0x7FFFu + ((u >> 16) & 1u); return (unsigned short)(u >> 16); }
__device__ __forceinline__ unsigned pk2(float lo, float hi) { return pg8::cvt_pk_bf16(lo, hi); }
__device__ __forceinline__ float sigmoidf_(float x) { return __builtin_amdgcn_rcpf(1.0f + __expf(-x)); }
__device__ __forceinline__ float siluf_(float x) { return x * sigmoidf_(x); }
__device__ __forceinline__ float geluf_(float x) { return x * sigmoidf_(1.5957691216057308f * (x + 0.044715f * x * x * x)); }
__device__ __forceinline__ float silu2_(float a, float b) { return (a * b) * __builtin_amdgcn_rcpf((1.0f + __expf(-a)) * (1.0f + __expf(-b))); }
__device__ __forceinline__ float gelu_silu_(float u, float g) { return (u * g) * __builtin_amdgcn_rcpf((1.0f + __expf(-1.5957691216057308f * (u + 0.044715f * u * u * u))) * (1.0f + __expf(-g))); }
template <int CTRL> __device__ __forceinline__ float dpp_f(float v) { return __builtin_bit_cast(float, __builtin_amdgcn_update_dpp(0, __builtin_bit_cast(int, v), CTRL, 0xf, 0xf, false)); }
__device__ __forceinline__ float wave_sum(float v) {
    v += dpp_f<0x128>(v); v += dpp_f<0x124>(v); v += dpp_f<0x122>(v); v += dpp_f<0x121>(v);
    const int vi = __builtin_bit_cast(int, v);
    const float r0 = __builtin_bit_cast(float, __builtin_amdgcn_readlane(vi, 0)), r1 = __builtin_bit_cast(float, __builtin_amdgcn_readlane(vi, 16));
    const float r2 = __builtin_bit_cast(float, __builtin_amdgcn_readlane(vi, 32)), r3 = __builtin_bit_cast(float, __builtin_amdgcn_readlane(vi, 48));
    return (r0 + r1) + (r2 + r3);
}

struct EpiNull {
    static constexpr bool PERM = true, AFTER_DRAIN = false;
    __device__ __forceinline__ void operator()(const f32x4 (&acc)[2][2][4][2], const pg8::Unit&, int, int, int, int) const {
#pragma unroll
        for (int a = 0; a < 2; ++a)
#pragma unroll
            for (int b = 0; b < 2; ++b)
#pragma unroll
                for (int m = 0; m < 4; ++m)
#pragma unroll
                    for (int n = 0; n < 2; ++n) asm volatile("" :: "v"(acc[a][b][m][n]));
    }
};
struct EpiZ {
    static constexpr bool PERM = true, AFTER_DRAIN = false;
    bf16_t* O; int ld; const MK_LAS float* lbias; int oddmode;
    __device__ __forceinline__ void operator()(const f32x4 (&acc)[2][2][4][2], const pg8::Unit& u, int wr, int wc, int fr, int fq) const {
        const int row0 = u.pm * 256 + wr * 64 + fr, col0 = u.pn * 256 + wc * 64 + 16 * fq;
        f32x4 bv[2][2];
#pragma unroll
        for (int bj = 0; bj < 2; ++bj)
#pragma unroll
            for (int n = 0; n < 2; ++n) bv[bj][n] = lbias ? *(const MK_LAS f32x4*)(lbias + col0 + 8 * bj + 4 * n) : (f32x4){0.f, 0.f, 0.f, 0.f};
        if (oddmode && u.pn >= 8) {
            const int scol = 1024 + ((col0 - 2048) >> 1);
#pragma unroll
            for (int ai = 0; ai < 2; ++ai)
#pragma unroll
                for (int m = 0; m < 4; ++m) { bf16_t* rowp = O + (size_t)(row0 + ai * 128 + m * 16) * ld + scol;
                    const f32x4 v0 = (acc[ai][0][m][0] + bv[0][0]) * (acc[ai][1][m][0] + bv[1][0]), v1 = (acc[ai][0][m][1] + bv[0][1]) * (acc[ai][1][m][1] + bv[1][1]);
                    u32x4 w; w.x = pg8::cvt_pk_bf16(v0[0], v0[1]); w.y = pg8::cvt_pk_bf16(v0[2], v0[3]); w.z = pg8::cvt_pk_bf16(v1[0], v1[1]); w.w = pg8::cvt_pk_bf16(v1[2], v1[3]);
                    *(u32x4*)rowp = w; }
            return;
        }
        const int scol = col0 + (oddmode ? (u.pn >= 6 ? 1024 : (u.pn >= 4 ? 512 : 0)) : 0);
#pragma unroll
        for (int ai = 0; ai < 2; ++ai)
#pragma unroll
            for (int m = 0; m < 4; ++m) { bf16_t* rowp = O + (size_t)(row0 + ai * 128 + m * 16) * ld + scol;
#pragma unroll
                for (int bj = 0; bj < 2; ++bj) { const f32x4 v0 = acc[ai][bj][m][0] + bv[bj][0], v1 = acc[ai][bj][m][1] + bv[bj][1];
                    u32x4 w; w.x = pg8::cvt_pk_bf16(v0[0], v0[1]); w.y = pg8::cvt_pk_bf16(v0[2], v0[3]); w.z = pg8::cvt_pk_bf16(v1[0], v1[1]); w.w = pg8::cvt_pk_bf16(v1[2], v1[3]);
                    *(u32x4*)(rowp + bj * 8) = w; } }
    }
};
struct EpiT {
    static constexpr bool PERM = true, AFTER_DRAIN = false;
    const bf16_t* xs; bf16_t* xt; const float* bias; float* stats;
    __device__ __forceinline__ void operator()(const f32x4 (&acc)[2][2][4][2], const pg8::Unit& u, int wr, int wc, int fr, int fq) const {
        const int row0 = u.pm * 256 + wr * 64 + fr, col0 = u.pn * 256 + wc * 64 + 16 * fq;
        f32x4 bv[2][2];
#pragma unroll
        for (int bj = 0; bj < 2; ++bj)
#pragma unroll
            for (int n = 0; n < 2; ++n) bv[bj][n] = *(const f32x4*)(bias + col0 + 8 * bj + 4 * n);
        u32x4 xr[4][2];
#pragma unroll
        for (int g = 0; g < 4; ++g) { const bf16_t* p = xs + (size_t)(row0 + g * 16) * D + col0; xr[g][0] = *(const u32x4*)p; xr[g][1] = *(const u32x4*)(p + 8); }
#pragma unroll
        for (int g = 0; g < 8; ++g) {
            const int ai = g >> 2, m = g & 3, row = row0 + ai * 128 + m * 16; bf16_t* p = xt + (size_t)row * D + col0;
            const u32x4 xc0 = xr[g & 3][0], xc1 = xr[g & 3][1];
            if (g < 4) { const bf16_t* pn = xs + (size_t)(row0 + 128 + g * 16) * D + col0; xr[g][0] = *(const u32x4*)pn; xr[g][1] = *(const u32x4*)(pn + 8); }
            float s = 0.f, s2 = 0.f;
#pragma unroll
            for (int bj = 0; bj < 2; ++bj) { const u32x4 x4 = bj ? xc1 : xc0;
                const f32x4 v0 = acc[ai][bj][m][0] + bv[bj][0] + (f32x4){bflo(x4.x), bfhi(x4.x), bflo(x4.y), bfhi(x4.y)} * ALPHA;
                const f32x4 v1 = acc[ai][bj][m][1] + bv[bj][1] + (f32x4){bflo(x4.z), bfhi(x4.z), bflo(x4.w), bfhi(x4.w)} * ALPHA;
                u32x4 w; w.x = pg8::cvt_pk_bf16(v0[0], v0[1]); w.y = pg8::cvt_pk_bf16(v0[2], v0[3]); w.z = pg8::cvt_pk_bf16(v1[0], v1[1]); w.w = pg8::cvt_pk_bf16(v1[2], v1[3]);
                *(u32x4*)(p + bj * 8) = w;
                const float r0 = bflo(w.x), r1 = bfhi(w.x), r2 = bflo(w.y), r3 = bfhi(w.y), r4 = bflo(w.z), r5 = bfhi(w.z), r6 = bflo(w.w), r7 = bfhi(w.w);
                s += ((r0 + r1) + (r2 + r3)) + ((r4 + r5) + (r6 + r7));
                s2 += ((r0 * r0 + r1 * r1) + (r2 * r2 + r3 * r3)) + ((r4 * r4 + r5 * r5) + (r6 * r6 + r7 * r7)); }
            s += __shfl_xor(s, 16); s += __shfl_xor(s, 32); s2 += __shfl_xor(s2, 16); s2 += __shfl_xor(s2, 32);
            if (fq == 0) *(f32x2*)(stats + ((size_t)(u.pn * 4 + wc) * M + row) * 2) = (f32x2){s, s2};
        }
    }
};
struct EpiGate2 {
    static constexpr bool PERM = true, AFTER_DRAIN = false;
    const bf16_t* tb; const bf16_t* ple; bf16_t* xo; float* fo; const float* stats; const MK_LAS float* lv;
    __device__ __forceinline__ void operator()(const f32x4 (&acc)[2][2][4][2], const pg8::Unit& u, int wr, int wc, int fr, int fq) const {
        const int row0 = u.pm * 256 + wr * 64 + fr, col0 = u.pn * 256 + wc * 64 + 16 * fq;
        f32x4 sa[2], sb[2]; u32x4 tw[2][2], pw[2][2];
        { const float* sp = stats + ((size_t)(fq * 4) * M + row0) * 2; const f32x2 q0 = *(const f32x2*)sp, q1 = *(const f32x2*)(sp + (size_t)2 * M), q2 = *(const f32x2*)(sp + (size_t)4 * M), q3 = *(const f32x2*)(sp + (size_t)6 * M); sa[0] = (f32x4){q0.x, q0.y, q1.x, q1.y}; sb[0] = (f32x4){q2.x, q2.y, q3.x, q3.y};
          const size_t o = (size_t)row0 * D + col0; tw[0][0] = *(const u32x4*)(tb + o); tw[0][1] = *(const u32x4*)(tb + o + 8); pw[0][0] = *(const u32x4*)(ple + o); pw[0][1] = *(const u32x4*)(ple + o + 8); }
#pragma unroll
        for (int g = 0; g < 8; ++g) {
            const int ai = g >> 2, m = g & 3, row = row0 + ai * 128 + m * 16, cur = g & 1;
            if (g < 7) { const int g1 = g + 1, nb = g1 & 1, rown = row0 + (g1 >> 2) * 128 + (g1 & 3) * 16;
                const float* sp = stats + ((size_t)(fq * 4) * M + rown) * 2; const f32x2 q0 = *(const f32x2*)sp, q1 = *(const f32x2*)(sp + (size_t)2 * M), q2 = *(const f32x2*)(sp + (size_t)4 * M), q3 = *(const f32x2*)(sp + (size_t)6 * M); sa[nb] = (f32x4){q0.x, q0.y, q1.x, q1.y}; sb[nb] = (f32x4){q2.x, q2.y, q3.x, q3.y};
                const size_t o = (size_t)rown * D + col0; tw[nb][0] = *(const u32x4*)(tb + o); tw[nb][1] = *(const u32x4*)(tb + o + 8); pw[nb][0] = *(const u32x4*)(ple + o); pw[nb][1] = *(const u32x4*)(ple + o + 8); }
            float mu, rs;
            { const f32x4 a = sa[cur], b = sb[cur];
              float s = (a[0] + a[2]) + (b[0] + b[2]), s2 = (a[1] + a[3]) + (b[1] + b[3]);
              s += __shfl_xor(s, 16); s += __shfl_xor(s, 32); s2 += __shfl_xor(s2, 16); s2 += __shfl_xor(s2, 32);
              mu = s * (1.f / D); const float var = s2 * (1.f / D) - mu * mu; rs = 1.f / sqrtf(fmaxf(var, 0.f) + LN_EPS); }
#pragma unroll
            for (int bj = 0; bj < 2; ++bj) {
                const int c = col0 + bj * 8; const size_t o = (size_t)row * D + c;
                const u32x4 t4 = tw[cur][bj], p4 = pw[cur][bj];
                f32x4 x[2];
#pragma unroll
                for (int n = 0; n < 2; ++n) {
                    const f32x4 gv = *(const MK_LAS f32x4*)(lv + c + 4 * n), bb = *(const MK_LAS f32x4*)(lv + 1024 + c + 4 * n), c1v = *(const MK_LAS f32x4*)(lv + 2048 + c + 4 * n), c2v = *(const MK_LAS f32x4*)(lv + 3072 + c + 4 * n);
                    const unsigned ta = n ? t4.z : t4.x, tbw = n ? t4.w : t4.y, pa = n ? p4.z : p4.x, pb2 = n ? p4.w : p4.y;
                    const f32x4 tv = (f32x4){bflo(ta), bfhi(ta), bflo(tbw), bfhi(tbw)}, pv = (f32x4){bflo(pa), bfhi(pa), bflo(pb2), bfhi(pb2)};
                    const f32x4 gp = (acc[ai][bj][m][n] - c1v * mu) * rs + c2v;
                    const f32x4 h = (tv - mu) * rs * gv + bb;
#pragma unroll
                    for (int e = 0; e < 4; ++e) x[n][e] = h[e] + sigmoidf_(gp[e]) * pv[e];
                }
                if (fo) { *(f32x4*)(fo + o) = x[0]; *(f32x4*)(fo + o + 4) = x[1]; }
                else { u32x4 w; w.x = pg8::cvt_pk_bf16(x[0][0], x[0][1]); w.y = pg8::cvt_pk_bf16(x[0][2], x[0][3]); w.z = pg8::cvt_pk_bf16(x[1][0], x[1][1]); w.w = pg8::cvt_pk_bf16(x[1][2], x[1][3]); *(u32x4*)(xo + o) = w; }
            }
        }
    }
};

__device__ __forceinline__ int orig_col_odd(int L) {
    if (L < 1024) return L;
    if (L < 1536) return L + 512;
    if (L < 2048) return L + 1024;
    const int g = (L - 2048) >> 4, e = L & 15;
    return e < 8 ? 1024 + 8 * g + e : 2048 + 8 * g + (e - 8);
}
__device__ __forceinline__ int phys_row(int L) { const int r = L & 255; return (L & ~255) + 128 * ((r >> 3) & 1) + 32 * (r >> 6) + 8 * ((r >> 4) & 3) + (r & 7); }
__device__ __forceinline__ void p0_transpose_item(const float* W, int K, int N, bf16_t* WT, MK_LAS float* scr, int item, int lane, const float* rowscale = nullptr, bool remap = true, bool oddmap = false) {
    const int nblk = N / 32, kb = item / nblk, nb = item % nblk, k0 = 64 * kb, n0 = 32 * nb;
    const int scol = oddmap ? orig_col_odd(n0 + (lane & 31)) : n0 + (lane & 31);
    float wl[32];
#pragma unroll
    for (int i = 0; i < 32; ++i) wl[i] = W[(size_t)(k0 + 2 * i + (lane >> 5)) * N + scol];
#pragma unroll
    for (int i = 0; i < 32; ++i) { const int kk = 2 * i + (lane >> 5); float wv = wl[i]; if (rowscale) wv *= rowscale[k0 + kk]; scr[kk * 33 + (lane & 31)] = wv; }
    asm volatile("s_waitcnt lgkmcnt(0)" ::: "memory");
    const int c = lane & 7;
#pragma unroll
    for (int j = 0; j < 4; ++j) { const int n = (lane >> 3) + 8 * j; const MK_LAS float* s = scr + (8 * c) * 33 + n;
        u32x4 o; o.x = pk2(s[0 * 33], s[1 * 33]); o.y = pk2(s[2 * 33], s[3 * 33]); o.z = pk2(s[4 * 33], s[5 * 33]); o.w = pk2(s[6 * 33], s[7 * 33]);
        *(u32x4*)(WT + (size_t)(remap ? phys_row(n0 + n) : (n0 + n)) * K + k0 + 8 * c) = o; }
    asm volatile("s_waitcnt lgkmcnt(0)" ::: "memory");
}
__device__ __forceinline__ void cvt_rows(const float* src, bf16_t* dst, size_t n8, size_t i0, size_t stride) {
    for (size_t i = i0; i < n8; i += 4 * stride) {
        f32x4 a[4], b[4];
#pragma unroll
        for (int k = 0; k < 4; ++k) { const size_t ii = (i + k * stride < n8) ? i + k * stride : i; a[k] = __builtin_nontemporal_load((const f32x4*)(src + ii * 8)); b[k] = __builtin_nontemporal_load((const f32x4*)(src + ii * 8 + 4)); }
#pragma unroll
        for (int k = 0; k < 4; ++k) { if (i + k * stride < n8) { u32x4 o; o.x = pk2(a[k][0], a[k][1]); o.y = pk2(a[k][2], a[k][3]); o.z = pk2(b[k][0], b[k][1]); o.w = pk2(b[k][2], b[k][3]); *(u32x4*)(dst + (i + k * stride) * 8) = o; } }
    }
}
__device__ __forceinline__ void p0_prologue(const Params& P, MK_LAS unsigned char* lds) {
    int tid_ = threadIdx.x; asm volatile("" : "+v"(tid_));
    const int tid = tid_, lane = tid & 63, wave = tid >> 6;
    MK_LAS float* scr = (MK_LAS float*)(lds + wave * 16384);
    const int gw = blockIdx.x * NWAVES + wave, NGW = gridDim.x * NWAVES;
    unsigned char* ws = P.ws;
    constexpr int I_IN = (D / 64) * (NB / 32), I_SQ = (D / 64) * (D / 32), I_PLE = (DP / 64) * (D / 32), I_POOL = (128 / 64) * (128 / 32);
    constexpr int PER_L = I_IN + 2 * I_SQ + I_PLE, NITEMS = 4 * PER_L + 8 * I_POOL;
    for (int it = gw; it < NITEMS; it += NGW) {
        if (it < 4 * PER_L) {
            const int l = it / PER_L, j = l >> 1; int r = it % PER_L;
            if (r < I_IN) { const float* W = ((l & 1) ? P.in[14] : P.in[2]) + (size_t)j * D * NB; p0_transpose_item(W, D, NB, (bf16_t*)(ws + WS_WIN) + (size_t)l * NB * D, scr, r, lane, nullptr, true, (l & 1) != 0); continue; } r -= I_IN;
            if (r < I_SQ) { const float* W = ((l & 1) ? P.in[19] : P.in[12]) + (size_t)j * D * D; p0_transpose_item(W, D, D, (bf16_t*)(ws + WS_WOUT) + (size_t)l * D * D, scr, r, lane); continue; } r -= I_SQ;
            if (r < I_SQ) { p0_transpose_item(P.in[24] + (size_t)l * D * D, D, D, (bf16_t*)(ws + WS_WGATE) + (size_t)l * D * D, scr, r, lane, P.in[21] + (size_t)l * D); continue; } r -= I_SQ;
            p0_transpose_item(P.in[23] + (size_t)l * DP * D, DP, D, (bf16_t*)(ws + WS_WPLE) + (size_t)l * D * DP, scr, r, lane);
        } else {
            const int r = it - 4 * PER_L, mtx = r / I_POOL;
            p0_transpose_item(P.in[16] + (size_t)mtx * 128 * 128, 128, 128, (bf16_t*)(ws + WS_WP) + (size_t)mtx * 128 * 128, scr, r % I_POOL, lane, nullptr, false);
        }
    }
    const size_t gt = (size_t)blockIdx.x * NTHREADS + tid, GT = (size_t)gridDim.x * NTHREADS;
    for (size_t i = gt; i < (size_t)2 * 8 * 128 * 128; i += GT) { const int s = (int)(i & 127), t = (int)((i >> 7) & 127); ((bf16_t*)(ws + WS_WS))[i] = (s <= t) ? f2bf(P.in[10][i]) : (bf16_t)0; }
    cvt_rows(P.in[0], (bf16_t*)(ws + WS_XB), (size_t)M * D / 8, gt, GT);
    cvt_rows(P.in[1], (bf16_t*)(ws + WS_PB), (size_t)4 * M * DP / 8, gt, GT);
    __syncthreads();
    for (int task = blockIdx.x; task < 4 * (D / 16); task += gridDim.x) {
        const int l = task / (D / 16), n = (task % (D / 16)) * 16 + (tid & 15), kg = tid >> 4;
        const float* Wg = P.in[24] + (size_t)l * D * D + n; const float* g = P.in[21] + (size_t)l * D; const float* b = P.in[22] + (size_t)l * D;
        float s1 = 0.f, s2 = 0.f;
#pragma unroll 8
        for (int k = kg * 32; k < kg * 32 + 32; ++k) { const float w = Wg[(size_t)k * D]; s1 += bf2f(f2bf(g[k] * w)); s2 += b[k] * w; }
        MK_LAS float* red = (MK_LAS float*)lds;
        red[tid * 2] = s1; red[tid * 2 + 1] = s2;
        __syncthreads();
        if (tid < 16) { float a1 = 0.f, a2 = 0.f;
            for (int w = 0; w < 32; ++w) { a1 += red[(w * 16 + tid) * 2]; a2 += red[(w * 16 + tid) * 2 + 1]; }
            float* c12 = (float*)(ws + WS_C12) + (size_t)l * 2 * D; c12[n] = a1; c12[D + n] = a2 + P.in[25][(size_t)l * D + n]; }
        __syncthreads();
    }
}

__device__ __forceinline__ void even_a_branch(const bf16_t* z, bf16_t* y, const float* cw, const float* cb, const float* lg, const float* lb, int run, MK_LAS unsigned char* lds) {
    unsigned tid_ = threadIdx.x; asm volatile("" : "+v"(tid_));
    const unsigned tid = tid_, lane = tid & 63u, c = tid; const int wave = __builtin_amdgcn_readfirstlane((int)(tid >> 6));
    MK_LAS float* LA = (MK_LAS float*)lds;
    MK_LAS float* LO = (MK_LAS float*)(lds + 65536);
    float wk[31];
#pragma unroll
    for (int k = 0; k < 31; ++k) wk[k] = (cw + k * WB)[c];
    const float cbv = cb[c];
    const f32x4 g0 = *(const f32x4*)(lg + 8u * lane), g1 = *(const f32x4*)(lg + 8u * lane + 4u), b0 = *(const f32x4*)(lb + 8u * lane), b1 = *(const f32x4*)(lb + 8u * lane + 4u);
    const int row0 = run * 256, pos0 = row0 & (SEQ - 1);
    float win[38];
#pragma unroll
    for (int i = 0; i < 30; ++i) { float v = 0.f;
        if (pos0 - 30 + i >= 0) { const bf16_t* zr = z + (size_t)(row0 - 30 + i) * NB; v = bf2f(zr[c]) * sigmoidf_(bf2f(zr[c + 512u])); }
        win[8 + i] = v; }
    u32x4 rv[4], rg[4];
    { const bf16_t* zw = z + (size_t)(row0 + 4 * wave) * NB;
#pragma unroll
      for (int tt = 0; tt < 4; ++tt) { rv[tt] = *(const u32x4*)(zw + (size_t)tt * NB + 8u * lane); rg[tt] = *(const u32x4*)(zw + (size_t)tt * NB + 512u + 8u * lane); } }
    for (int st = 0; st < 8; ++st) {
        const bf16_t* zst = z + (size_t)(row0 + st * 32 + 4 * wave) * NB;
#pragma unroll
        for (int tt = 0; tt < 4; ++tt) {
            const u32x4 v = rv[tt], g = rg[tt];
            f32x4 a0, a1;
            a0[0] = bflo(v.x) * sigmoidf_(bflo(g.x)); a0[1] = bfhi(v.x) * sigmoidf_(bfhi(g.x)); a0[2] = bflo(v.y) * sigmoidf_(bflo(g.y)); a0[3] = bfhi(v.y) * sigmoidf_(bfhi(g.y));
            a1[0] = bflo(v.z) * sigmoidf_(bflo(g.z)); a1[1] = bfhi(v.z) * sigmoidf_(bfhi(g.z)); a1[2] = bflo(v.w) * sigmoidf_(bflo(g.w)); a1[3] = bfhi(v.w) * sigmoidf_(bfhi(g.w));
            MK_LAS float* p = LA + (4 * wave + tt) * 512 + 8u * lane;
            *(MK_LAS f32x4*)p = a0; *(MK_LAS f32x4*)(p + 4) = a1;
        }
        __syncthreads();
        u32x4 gt[4];
#pragma unroll
        for (int tt = 0; tt < 4; ++tt) gt[tt] = *(const u32x4*)(zst + (size_t)tt * NB + 1024u + 8u * lane);
        if (st < 7) {
#pragma unroll
            for (int tt = 0; tt < 4; ++tt) { rv[tt] = *(const u32x4*)(zst + (size_t)(32 + tt) * NB + 8u * lane); rg[tt] = *(const u32x4*)(zst + (size_t)(32 + tt) * NB + 512u + 8u * lane); }
        }
#pragma unroll
        for (int ch = 0; ch < 4; ++ch) {
#pragma unroll
            for (int i = 0; i < 30; ++i) win[i] = win[i + 8];
#pragma unroll
            for (int i = 0; i < 8; ++i) win[30 + i] = LA[(ch * 8 + i) * 512 + c];
#pragma unroll
            for (int i = 0; i < 8; ++i) { float s = cbv;
#pragma unroll
                for (int k = 0; k < 31; ++k) s += wk[k] * win[i + k];
                LO[(ch * 8 + i) * 512 + c] = s; }
        }
        __syncthreads();
#pragma unroll
        for (int tt = 0; tt < 4; ++tt) {
            const MK_LAS float* p = LO + (4 * wave + tt) * 512 + 8u * lane;
            f32x4 v0 = *(const MK_LAS f32x4*)p, v1 = *(const MK_LAS f32x4*)(p + 4);
            float s = ((v0[0] + v0[1]) + (v0[2] + v0[3])) + ((v1[0] + v1[1]) + (v1[2] + v1[3]));
            float s2 = ((v0[0] * v0[0] + v0[1] * v0[1]) + (v0[2] * v0[2] + v0[3] * v0[3])) + ((v1[0] * v1[0] + v1[1] * v1[1]) + (v1[2] * v1[2] + v1[3] * v1[3]));
            s = wave_sum(s); s2 = wave_sum(s2);
            const float mean = s * (1.f / WB), var = s2 * (1.f / WB) - mean * mean, rstd = 1.f / sqrtf(fmaxf(var, 0.f) + LN_EPS);
            v0 = (v0 - mean) * rstd * g0 + b0; v1 = (v1 - mean) * rstd * g1 + b1;
            const u32x4 g = gt[tt];
            u32x4 o;
            o.x = pk2(silu2_(v0[0], bflo(g.x)), silu2_(v0[1], bfhi(g.x))); o.y = pk2(silu2_(v0[2], bflo(g.y)), silu2_(v0[3], bfhi(g.y)));
            o.z = pk2(silu2_(v1[0], bflo(g.z)), silu2_(v1[1], bfhi(g.z))); o.w = pk2(silu2_(v1[2], bflo(g.w)), silu2_(v1[3], bfhi(g.w)));
            *(u32x4*)(y + (size_t)(row0 + st * 32 + 4 * wave + tt) * D + 8u * lane) = o;
        }
    }
}
__device__ __forceinline__ void even_b_block(const bf16_t* z, bf16_t* y, const float* lvg, const float* lvb, const bf16_t* WsM  , const float* bs  , int blk, MK_LAS unsigned char* lds) {
    int tid_ = threadIdx.x; asm volatile("" : "+v"(tid_));
    const int tid = tid_, lane = tid & 63, wave = __builtin_amdgcn_readfirstlane(tid >> 6);
    const int brow0 = blk * 128;
    const f32x4 g0 = *(const f32x4*)(lvg + 8 * lane), g1 = *(const f32x4*)(lvg + 8 * lane + 4), b0 = *(const f32x4*)(lvb + 8 * lane), b1 = *(const f32x4*)(lvb + 8 * lane + 4);
    for (int grp = 0; grp < 2; ++grp) {
        const int t0 = 16 * wave + 8 * grp;
        const bf16_t* zr = z + (size_t)(brow0 + t0) * NB + 2048 + 8 * lane;
        u32x4 raw[8];
#pragma unroll
        for (int tt = 0; tt < 8; ++tt) raw[tt] = *(const u32x4*)(zr + (size_t)tt * NB);
        u32x4 outp[8];
#pragma unroll
        for (int p = 0; p < 4; ++p) {
            f32x4 va[2][2];
#pragma unroll
            for (int e = 0; e < 2; ++e) { const u32x4 r = raw[2 * p + e];
                f32x4 v0 = (f32x4){geluf_(bflo(r.x)), geluf_(bfhi(r.x)), geluf_(bflo(r.y)), geluf_(bfhi(r.y))}, v1 = (f32x4){geluf_(bflo(r.z)), geluf_(bfhi(r.z)), geluf_(bflo(r.w)), geluf_(bfhi(r.w))};
                float s = ((v0[0] + v0[1]) + (v0[2] + v0[3])) + ((v1[0] + v1[1]) + (v1[2] + v1[3]));
                float s2 = ((v0[0] * v0[0] + v0[1] * v0[1]) + (v0[2] * v0[2] + v0[3] * v0[3])) + ((v1[0] * v1[0] + v1[1] * v1[1]) + (v1[2] * v1[2] + v1[3] * v1[3]));
                s = wave_sum(s); s2 = wave_sum(s2);
                const float mean = s * (1.f / WB), var = s2 * (1.f / WB) - mean * mean, rstd = 1.f / sqrtf(fmaxf(var, 0.f) + LN_EPS);
                va[e][0] = (v0 - mean) * rstd * g0 + b0; va[e][1] = (v1 - mean) * rstd * g1 + b1; }
#pragma unroll
            for (int i = 0; i < 8; ++i) { const unsigned w = pg8::cvt_pk_bf16(va[0][i >> 2][i & 3], va[1][i >> 2][i & 3]);
                if (p == 0) outp[i].x = w; else if (p == 1) outp[i].y = w; else if (p == 2) outp[i].z = w; else outp[i].w = w; }
        }
        const int cbk = (t0 >> 3) ^ (lane & 15);
#pragma unroll
        for (int i = 0; i < 8; ++i) *(MK_LAS u32x4*)(lds + (8 * lane + i) * 256 + cbk * 16) = outp[i];
    }
    __syncthreads();
    const int h = wave, n = lane & 15, q = lane >> 4;
    for (int nh = 0; nh < 2; ++nh) {
        u32x2 uw[4][4], gw[4][4];
#pragma unroll
        for (int nt = 0; nt < 4; ++nt) { const size_t row = (size_t)(brow0 + 16 * (nh * 4 + nt) + n);
#pragma unroll
            for (int mt = 0; mt < 4; ++mt) { const int ch = h * 64 + 16 * mt + 4 * q; uw[nt][mt] = *(const u32x2*)(z + row * NB + 1536 + ch); gw[nt][mt] = *(const u32x2*)(z + row * NB + 2560 + ch); } }
        f32x4 acc[4][4];
#pragma unroll
        for (int mt = 0; mt < 4; ++mt)
#pragma unroll
            for (int nt = 0; nt < 4; ++nt) acc[mt][nt] = (f32x4){0.f, 0.f, 0.f, 0.f};
#pragma unroll
        for (int ks = 0; ks < 4; ++ks) {
            if (2 * ks <= nh * 4 + 3) {
                bf16x8 a[4];
#pragma unroll
                for (int mt = 0; mt < 4; ++mt) { const int row = h * 64 + 16 * mt + n; a[mt] = *(const MK_LAS bf16x8*)(lds + row * 256 + (((4 * ks + q) ^ ((row >> 3) & 15)) * 16)); }
#pragma unroll
                for (int nt = 0; nt < 4; ++nt) {
                    const int ntg = nh * 4 + nt;
                    if (2 * ks <= ntg) {
                        const bf16x8 b = *(const bf16x8*)(WsM + ((size_t)h * 128 + 16 * ntg + n) * 128 + 32 * ks + 8 * q);
#pragma unroll
                        for (int mt = 0; mt < 4; ++mt) acc[mt][nt] = __builtin_amdgcn_mfma_f32_16x16x32_bf16(a[mt], b, acc[mt][nt], 0, 0, 0);
                    }
                }
            }
        }
#pragma unroll
        for (int nt = 0; nt < 4; ++nt) {
            const int t = 16 * (nh * 4 + nt) + n; const size_t row = (size_t)(brow0 + t); const float bsv = bs[h * 128 + t];
#pragma unroll
            for (int mt = 0; mt < 4; ++mt) {
                const int ch = h * 64 + 16 * mt + 4 * q;
                const u32x2 u2 = uw[nt][mt], g2 = gw[nt][mt];
                const float o0 = gelu_silu_(bflo(u2.x), bflo(g2.x)) * (acc[mt][nt][0] + bsv);
                const float o1 = gelu_silu_(bfhi(u2.x), bfhi(g2.x)) * (acc[mt][nt][1] + bsv);
                const float o2 = gelu_silu_(bflo(u2.y), bflo(g2.y)) * (acc[mt][nt][2] + bsv);
                const float o3 = gelu_silu_(bfhi(u2.y), bfhi(g2.y)) * (acc[mt][nt][3] + bsv);
                u32x2 w; w.x = pk2(o0, o1); w.y = pk2(o2, o3); *(u32x2*)(y + row * D + 512 + ch) = w;
            }
        }
    }
    __syncthreads();
}

__device__ __forceinline__ MK_LAS unsigned short* c_elem(MK_LAS unsigned char* lds, int r, int c) { return (MK_LAS unsigned short*)(lds + r * 1024 + ((((c >> 3) ^ (r & 15))) * 16) + (c & 7) * 2); }
template <int G>
__device__ __forceinline__ void odd_c_pool(MK_LAS unsigned char* lds, int c_, bool seqstart) {
    int c = c_; asm volatile("" : "+v"(c));
    constexpr int WIN = 2 << G;
    float ring[WIN]; float sum = 0.f;
#pragma unroll
    for (int i = 0; i < WIN; ++i) ring[i] = 0.f;
#pragma unroll
    for (int h = 16 - WIN; h < 15; ++h) {
        const float v = seqstart ? 0.f : bf2f(*c_elem(lds, h, c));
        sum += v; ring[(h + 1) % WIN] = v; }
#pragma unroll 1
    for (int t0 = 0; t0 < 128; t0 += 16) {
#pragma unroll
        for (int i = 0; i < 16; ++i) {
            const int tt = t0 + i; MK_LAS unsigned short* p = c_elem(lds, tt + 15, c);
            const float v = bf2f(*p);
            sum += v - ring[i % WIN]; ring[i % WIN] = v;
            const float inv = (seqstart && tt < WIN) ? 1.0f / (float)(tt + 1) : 1.0f / (float)WIN;
            *p = f2bf(sum * inv - v);
        }
    }
}
template <int G>
__device__ __forceinline__ void odd_c_mma(const bf16_t* z, bf16_t* y, const float* pscale, const MK_LAS unsigned char* lds, int srow0, int half, int n_, int q_, const bf16x8 (&afr)[8][4]) {
    int n = n_, q = q_; asm volatile("" : "+v"(n), "+v"(q));
#pragma unroll 1
    for (int tl = 0; tl < 4; ++tl) {
        const int tloc = (half * 4 + tl) * 16 + n, row = srow0 + tloc, r = tloc + 15;
        u32x2 gwd[8];
#pragma unroll
        for (int mt = 0; mt < 8; ++mt) gwd[mt] = *(const u32x2*)(z + (size_t)row * NB + 512 + G * 128 + 16 * mt + 4 * q);
        f32x4 acc[8];
#pragma unroll
        for (int mt = 0; mt < 8; ++mt) acc[mt] = (f32x4){0.f, 0.f, 0.f, 0.f};
#pragma unroll
        for (int ks = 0; ks < 4; ++ks) {
            const bf16x8 bfrag = *(const MK_LAS bf16x8*)(lds + r * 1024 + (((G * 16 + 4 * ks + q) ^ (r & 15)) * 16));
#pragma unroll
            for (int mt = 0; mt < 8; ++mt) acc[mt] = __builtin_amdgcn_mfma_f32_16x16x32_bf16(afr[mt][ks], bfrag, acc[mt], 0, 0, 0);
        }
#pragma unroll
        for (int mt = 0; mt < 8; ++mt) {
            const int ch = G * 128 + 16 * mt + 4 * q;
            const f32x4 ps = *(const f32x4*)(pscale + ch);
            u32x2 w; w.x = pk2(acc[mt][0] * ps[0] * siluf_(bflo(gwd[mt].x)), acc[mt][1] * ps[1] * siluf_(bfhi(gwd[mt].x)));
            w.y = pk2(acc[mt][2] * ps[2] * siluf_(bflo(gwd[mt].y)), acc[mt][3] * ps[3] * siluf_(bfhi(gwd[mt].y)));
            *(u32x2*)(y + (size_t)row * D + ch) = w;
        }
    }
}
template <int G>
__device__ __forceinline__ void odd_c_group(const bf16_t* z, bf16_t* y, const bf16_t* WpT, const float* pscale, MK_LAS unsigned char* lds, int half, int tid, int n, int q) {
    bf16x8 afr[8][4];
#pragma unroll
    for (int mt = 0; mt < 8; ++mt)
#pragma unroll
        for (int ks = 0; ks < 4; ++ks) afr[mt][ks] = *(const bf16x8*)(WpT + ((size_t)G * 128 + 16 * mt + n) * 128 + 32 * ks + 8 * q);
    for (int run = blockIdx.x; run < M / 256; run += gridDim.x) {
        for (int sub = 0; sub < 2; ++sub) {
            const int srow0 = run * 256 + sub * 128;
            { int tl_ = tid; asm volatile("" : "+v"(tl_)); const int bk = tl_ & 63, r8 = tl_ >> 6;
#pragma unroll
              for (int hb = 0; hb < 3; ++hb) {
                  u32x4 st[6];
#pragma unroll
                  for (int i = 0; i < 6; ++i) { const int r = (hb * 6 + i) * 8 + r8; int grow = srow0 - 15 + (r < 143 ? r : 142); grow = grow < 0 ? 0 : grow; st[i] = *(const u32x4*)(z + (size_t)grow * NB + 8 * bk); }
#pragma unroll
                  for (int i = 0; i < 6; ++i) { const int r = (hb * 6 + i) * 8 + r8; if (r < 143) *(MK_LAS u32x4*)(lds + r * 1024 + ((bk ^ (r & 15)) * 16)) = st[i]; }
                  asm volatile("" ::: "memory");
              } }
            __syncthreads();
            odd_c_pool<G>(lds, tid, (srow0 & (SEQ - 1)) == 0);
            __syncthreads();
            odd_c_mma<G>(z, y, pscale, lds, srow0, half, n, q, afr);
            __syncthreads();
        }
    }
}
__device__ __forceinline__ void unpack8(const u32x4 w, float (&f)[8]) { f[0] = bflo(w.x); f[1] = bfhi(w.x); f[2] = bflo(w.y); f[3] = bfhi(w.y); f[4] = bflo(w.z); f[5] = bfhi(w.z); f[6] = bflo(w.w); f[7] = bfhi(w.w); }
__device__ __forceinline__ void odd_mixer(const bf16_t* z, bf16_t* y, const bf16_t* WpT  , const float* pscale, const float* cdw  , MK_LAS unsigned char* lds) {
    int tid_ = threadIdx.x; asm volatile("" : "+v"(tid_));
    const int tid = tid_, lane = tid & 63, wave = __builtin_amdgcn_readfirstlane(tid >> 6);
    const int n = lane & 15, q = lane >> 4;
    { const int g = wave >> 1, half = wave & 1;
      if (g == 0) odd_c_group<0>(z, y, WpT, pscale, lds, half, tid, n, q);
      else if (g == 1) odd_c_group<1>(z, y, WpT, pscale, lds, half, tid, n, q);
      else if (g == 2) odd_c_group<2>(z, y, WpT, pscale, lds, half, tid, n, q);
      else odd_c_group<3>(z, y, WpT, pscale, lds, half, tid, n, q); }
    const int c8 = lane * 8;
    f32x4 wa[3], wb[3];
#pragma unroll
    for (int k = 0; k < 3; ++k) { wa[k] = *(const f32x4*)(cdw + k * WB + c8); wb[k] = *(const f32x4*)(cdw + k * WB + c8 + 4); }
    for (int run = blockIdx.x; run < M / 256; run += gridDim.x) {
        const int r0 = run * 256 + 32 * wave, pos = r0 & (SEQ - 1);
        const bf16_t* zr = z + (size_t)r0 * NB + c8;
        float pm1[8], pm2[8];
        { const int bk = pos > 0 ? 1 : 0;
          const u32x4 d1 = *(const u32x4*)(zr - (ptrdiff_t)bk * NB + 1024), d2 = *(const u32x4*)(zr - (ptrdiff_t)(2 * bk) * NB + 1024);
          float a[8]; unpack8(d1, a);
#pragma unroll
          for (int e = 0; e < 8; ++e) pm1[e] = bk ? a[e] : 0.f;
          unpack8(d2, a);
#pragma unroll
          for (int e = 0; e < 8; ++e) pm2[e] = bk ? a[e] : 0.f; }
        for (int i0 = 0; i0 < 32; i0 += 4) {
            u32x4 dd[4], db[4], dg[4];
#pragma unroll
            for (int i = 0; i < 4; ++i) { const bf16_t* p = zr + (size_t)(i0 + i) * NB; dd[i] = *(const u32x4*)(p + 1024); db[i] = *(const u32x4*)(p + 1536); dg[i] = *(const u32x4*)(p + 2560); }
#pragma unroll
            for (int i = 0; i < 4; ++i) {
                float pc[8], dbf[8], dgf[8], o[8]; unpack8(dd[i], pc); unpack8(db[i], dbf); unpack8(dg[i], dgf);
#pragma unroll
                for (int e = 0; e < 8; ++e) {
                    const float w0 = e < 4 ? wa[0][e & 3] : wb[0][e & 3], w1 = e < 4 ? wa[1][e & 3] : wb[1][e & 3], w2 = e < 4 ? wa[2][e & 3] : wb[2][e & 3];
                    const float conv = w0 * pm2[e] + w1 * pm1[e] + w2 * pc[e];
                    o[e] = dbf[e] * conv * siluf_(dgf[e]); pm2[e] = pm1[e]; pm1[e] = pc[e]; }
                u32x4 ow; ow.x = pk2(o[0], o[1]); ow.y = pk2(o[2], o[3]); ow.z = pk2(o[4], o[5]); ow.w = pk2(o[6], o[7]);
                *(u32x4*)(y + (size_t)(r0 + i0 + i) * D + 512 + c8) = ow;
            }
        }
    }
}

__global__ void __launch_bounds__(512) fwd_megakernel(Params P, int ph_lo, int ph_hi) {
    extern __shared__ __attribute__((aligned(16))) unsigned char lds_raw[];
    MK_LAS unsigned char* lds = (MK_LAS unsigned char*)lds_raw;
    cg::grid_group grid = cg::this_grid();
    if (threadIdx.x == 0) { ((MK_LAS unsigned*)(lds + LDS_BYTES - 16))[0] = 0u; ((MK_LAS unsigned*)(lds + LDS_BYTES - 16))[1] = 0u; }
    __syncthreads();
    const XcdBarrier xbar = xcd_barrier_post((unsigned*)(P.ws + WS_BAR), (volatile LAS unsigned*)(lds + LDS_BYTES - 16));
    int ph = 0;
#define MK_IN() (ph_lo <= ph && ph < ph_hi)
#define MK_STAGGER(ticks) do { if ((ticks) > 0 && ((blockIdx.x >> 3) & 1)) { const unsigned long long t0_ = __builtin_amdgcn_s_memrealtime(); while (__builtin_amdgcn_s_memrealtime() - t0_ < (unsigned long long)(ticks)) __builtin_amdgcn_s_sleep(16); } } while (0)
#define MK_SEAM() do { if (ph_lo <= ph && ph + 1 < ph_hi) { for (int r_ = 0; r_ < REP_SYNC; ++r_) { if (ph_hi < 0) grid.sync(); else xcd_barrier(xbar); } } ++ph; } while (0)
    if (MK_IN()) { for (int r0_ = 0; r0_ < REP_P0; ++r0_) { p0_prologue(P, lds); __syncthreads(); } }
    MK_SEAM();
#pragma clang loop unroll(disable)
    for (int l0 = 0; l0 < DEPTH; ++l0) {
#define MK_LAUNDER() int l = l0; asm volatile("" : "+s"(l)); const int j = l >> 1; const bool odd = l & 1; unsigned char* ws = P.ws; asm volatile("" : "+s"(ws)); bf16_t* xcur = (bf16_t*)(ws + WS_XB); bf16_t* tbuf = (bf16_t*)(ws + WS_XB) + (size_t)M * D; bf16_t* z = (bf16_t*)(ws + WS_Z); bf16_t* yb = (bf16_t*)(ws + WS_Y); bf16_t* ple = (bf16_t*)(ws + WS_Z);
        if (MK_IN()) { MK_LAUNDER()
            pg8::Gemm g{xcur, (const bf16_t*)(ws + WS_WIN) + (size_t)l * NB * D, M, NB, D}; pg8::StaticOrder S; S.init(M, NB, (int)gridDim.x, (int)blockIdx.x);
            { const float* bsrc = (odd ? P.in[15] : P.in[3]) + (size_t)j * NB; MK_LAS float* lb = (MK_LAS float*)(lds + 131072);
              int ti_ = threadIdx.x; asm volatile("" : "+v"(ti_));
              for (int i = ti_; i < NB; i += NTHREADS) lb[i] = bsrc[odd ? orig_col_odd(i) : i];
              __syncthreads(); }
            EpiZ E{z, NB, (const MK_LAS float*)(lds + 131072), odd ? 1 : 0};
            MK_STAGGER(STAG1);
            for (int rep = 0; rep < REP_P1; ++rep) pg8::gemm_phase<EpiZ, pg8::StaticOrder, MK_ALIGN_EPI, MK_SP2>(lds, g, S, E);
        }
        MK_SEAM();
        if (MK_IN()) { MK_LAUNDER()
            for (int rep = 0; rep < (odd ? REP_P2O : REP_P2E); ++rep)
            if (!odd) {
                for (int run = blockIdx.x; run < M / 256; run += gridDim.x) {
                    for (int ra = 0; ra < REP_A; ++ra) even_a_branch(z, yb, P.in[4] + (size_t)j * 31 * WB, P.in[5] + j * WB, P.in[6] + j * WB, P.in[7] + j * WB, run, lds);
                    __syncthreads();
                    for (int bb = 0; bb < 2; ++bb)
                        even_b_block(z, yb, P.in[8] + j * WB, P.in[9] + j * WB, (const bf16_t*)(ws + WS_WS) + (size_t)j * 8 * 128 * 128, P.in[11] + j * 8 * 128, run * 2 + bb, lds);
                }
            } else {
                odd_mixer(z, yb, (const bf16_t*)(ws + WS_WP) + (size_t)j * 4 * 128 * 128, P.in[17] + j * WB, P.in[18] + (size_t)j * 3 * WB, lds);
            }
        }
        MK_SEAM();
        if (MK_IN()) { MK_LAUNDER()
            { pg8::Gemm g{yb, (const bf16_t*)(ws + WS_WOUT) + (size_t)l * D * D, M, D, D}; pg8::StaticOrder S; S.init(M, D, (int)gridDim.x, (int)blockIdx.x);
              MK_STAGGER(STAG3);
              EpiT E{xcur, tbuf, (odd ? P.in[20] : P.in[13]) + (size_t)j * D, (float*)(ws + WS_STATS)};
#if REP_K3
              { EpiNull EN; pg8::gemm_phase<EpiNull, pg8::StaticOrder, MK_ALIGN_EPI, MK_SP2>(lds, g, S, EN); }
#endif
              pg8::gemm_phase<EpiT, pg8::StaticOrder, MK_ALIGN_EPI, MK_SP2>(lds, g, S, E); }
            { pg8::Gemm g{(const bf16_t*)(ws + WS_PB) + (size_t)l * M * DP, (const bf16_t*)(ws + WS_WPLE) + (size_t)l * D * DP, M, D, DP}; pg8::StaticOrder S; S.init(M, D, (int)gridDim.x, (int)blockIdx.x);
              EpiZ E{ple, D, nullptr, 0};
              for (int rp_ = 0; rp_ < REP_PLE; ++rp_) pg8::gemm_phase<EpiZ, pg8::StaticOrder, MK_ALIGN_EPI, MK_SP2>(lds, g, S, E); }
        }
        MK_SEAM();
        if (MK_IN()) { MK_LAUNDER()
            pg8::Gemm g{tbuf, (const bf16_t*)(ws + WS_WGATE) + (size_t)l * D * D, M, D, D}; pg8::StaticOrder S; S.init(M, D, (int)gridDim.x, (int)blockIdx.x);
            const float* c12 = (const float*)(ws + WS_C12) + (size_t)l * 2 * D;
            { int ti_ = threadIdx.x; asm volatile("" : "+v"(ti_)); MK_LAS float* lvw = (MK_LAS float*)(lds + 131072);
              const float* lg_ = P.in[21] + (size_t)l * D; const float* lb_ = P.in[22] + (size_t)l * D;
              for (int i = ti_; i < 1024; i += NTHREADS) { const int vec = i >> 8, idx = (i & 255) * 4; const float* src = vec == 0 ? lg_ : vec == 1 ? lb_ : vec == 2 ? c12 : c12 + D;
                  *(MK_LAS f32x4*)(lvw + vec * 1024 + idx) = *(const f32x4*)(src + idx); }
              __syncthreads(); }
            MK_STAGGER(STAG5);
            EpiGate2 E{tbuf, ple, xcur, (l == DEPTH - 1) ? P.out : nullptr, (const float*)(ws + WS_STATS), (const MK_LAS float*)(lds + 131072)};
            for (int r5_ = 0; r5_ < REP_P5; ++r5_) pg8::gemm_phase<EpiGate2, pg8::StaticOrder, MK_ALIGN_EPI, MK_SP2>(lds, g, S, E);
        }
        MK_SEAM();
    }
#undef MK_IN
#undef MK_LAUNDER
#undef MK_SEAM
}
}

extern "C" void kernel_launch(void* const* d_in, const int* in_sizes, int n_in, void* d_out, int out_size, void* d_ws, size_t ws_size, hipStream_t stream) {
    static int ready = 0;
    if (!ready) {
        if (n_in != 26 || out_size != mk::M * mk::D || ws_size < mk::WS_END) { fprintf(stderr, "kernel_launch: unexpected shapes (n_in %d out %d ws %zu need %zu)\n", n_in, out_size, ws_size, (size_t)mk::WS_END); }
        if (hipFuncSetAttribute((const void*)mk::fwd_megakernel, hipFuncAttributeMaxDynamicSharedMemorySize, mk::LDS_BYTES) != hipSuccess) fprintf(stderr, "kernel_launch: hipFuncSetAttribute failed\n");
        ready = 1;
    }
    (void)hipMemsetAsync((unsigned char*)d_ws + mk::WS_BAR, 0, (size_t)XCD_BAR_WORDS * 4, stream);
    mk::Params P{};
    for (int i = 0; i < 26; ++i) P.in[i] = (const float*)d_in[i];
    P.out = (float*)d_out; P.ws = (unsigned char*)d_ws;
    int lo = 0, hi = 1 + 4 * mk::DEPTH;
    void* args[] = {&P, &lo, &hi};
    hipError_t e = hipLaunchCooperativeKernel((const void*)mk::fwd_megakernel, dim3(256), dim3(mk::NTHREADS), args, mk::LDS_BYTES, stream);
    if (e != hipSuccess) fprintf(stderr, "cooperative launch failed: %s\n", hipGetErrorString(e));
}
```

```cpp
#include <hip/hip_runtime.h>
#include <hip/hip_cooperative_groups.h>
#include <cstdio>
namespace cg = cooperative_groups;
#ifndef MK_WGM
#define MK_WGM 8
#endif

#define XB_TMO      128
#define XB_XCNT(j)  (256  + 64 * (j))
#define XB_XSUB(j)  (1280 + 64 * (j))
#define XB_XGEN(j)  (2304 + 64 * (j))
#define XB_TOP      3328
#define XB_TOPGEN   3392
#define XCD_BAR_WORDS 3456
#define XB_SPIN_CAP (1u << 18)
#define LAS __attribute__((address_space(3)))

__device__ __forceinline__ unsigned xb_ld(unsigned* p)              { return __hip_atomic_load(p, __ATOMIC_RELAXED, __HIP_MEMORY_SCOPE_AGENT); }
__device__ __forceinline__ unsigned xb_add(unsigned* p, unsigned v) { return __hip_atomic_fetch_add(p, v, __ATOMIC_RELAXED, __HIP_MEMORY_SCOPE_AGENT); }
__device__ __forceinline__ unsigned xb_xcc_id() { return (unsigned)__builtin_amdgcn_s_getreg((3 << 11) | 20) & 0xFu; }
#define XB_SPIN(cond, bar) do { unsigned _sp = 0; while (cond) { __builtin_amdgcn_s_sleep(1); \
    if ((++_sp & 255u) == 0u) { if (xb_ld(&(bar)[XB_TMO])) break; if (_sp > XB_SPIN_CAP) { atomicAdd(&(bar)[XB_TMO], 1u); break; } } } } while (0)

struct XcdBarrier {
    unsigned* bar; unsigned x;
    volatile LAS unsigned* st;
};

__device__ __forceinline__ XcdBarrier xcd_barrier_post(unsigned* bar, volatile LAS unsigned* st) {
    XcdBarrier b; b.bar = bar; b.x = xb_xcc_id(); b.st = st;
    if (threadIdx.x == 0) (void)xb_add(&bar[XB_XCNT(b.x)], 1u);
    return b;
}
__device__ __forceinline__ void xcd_barrier_complete(unsigned* bar, unsigned x, unsigned& nloc, unsigned& nx) {
    const unsigned G = gridDim.x * gridDim.y * gridDim.z;
    unsigned sum, cnt, mine, sp = 0u;
    for (;;) {
        sum = 0u; cnt = 0u; mine = 0u;
#pragma unroll
        for (unsigned j = 0; j < 16; ++j) { const unsigned c = xb_ld(&bar[XB_XCNT(j)]); sum += c; cnt += (c > 0u) ? 1u : 0u; mine = (j == x) ? c : mine; }
        if (sum == G) break;
        __builtin_amdgcn_s_sleep(1);
        if ((++sp & 255u) == 0u) { if (xb_ld(&bar[XB_TMO])) break; if (sp > XB_SPIN_CAP) { atomicAdd(&bar[XB_TMO], 1u); break; } }
    }
    nloc = mine > 0u ? mine : 1u; nx = cnt > 0u ? cnt : 1u;
}

__device__ __forceinline__ void xcd_barrier(const XcdBarrier& b) {
    asm volatile("s_waitcnt vmcnt(0)" ::: "memory");
    __syncthreads();
    if (threadIdx.x == 0) {
        unsigned* bar = b.bar;
        __builtin_amdgcn_s_waitcnt(0);
        unsigned nloc = b.st[0], nx = b.st[1];
        if (nloc == 0u) { xcd_barrier_complete(bar, b.x, nloc, nx); b.st[0] = nloc; b.st[1] = nx; }
        const unsigned old = xb_add(&bar[XB_XSUB(b.x)], 1u);
        const unsigned gen = old / nloc;
        if (old + 1u == (gen + 1u) * nloc) {
            __builtin_amdgcn_fence(__ATOMIC_RELEASE, "agent");
            asm volatile("s_waitcnt vmcnt(0)" ::: "memory");
            const unsigned og = xb_add(&bar[XB_TOP], 1u);
            const unsigned tg = og / nx;
            if (og + 1u == (tg + 1u) * nx) xb_add(&bar[XB_TOPGEN], 1u);
            else XB_SPIN(xb_ld(&bar[XB_TOPGEN]) == tg, bar);
            __builtin_amdgcn_fence(__ATOMIC_ACQUIRE, "agent");
            xb_add(&bar[XB_XGEN(b.x)], 1u);
            asm volatile("s_waitcnt vmcnt(0)" ::: "memory");
        } else {
            XB_SPIN(xb_ld(&bar[XB_XGEN(b.x)]) == gen, bar);
            __builtin_amdgcn_fence(__ATOMIC_ACQUIRE, "agent");
            asm volatile("s_waitcnt vmcnt(0)" ::: "memory");
        }
    }
    __syncthreads();
}
namespace pg8 {
#define PG8_LAS __attribute__((address_space(3)))
typedef unsigned short bf16_t;
typedef short bf16x8 __attribute__((ext_vector_type(8)));
typedef float f32x4 __attribute__((ext_vector_type(4)));
typedef unsigned u32x4 __attribute__((ext_vector_type(4)));
constexpr int BM = 256, BK = 64, HALF = 128, HTB = HALF * BK * 2  , STAGE_BYTES = 8 * HTB, NXCD = 8, WGM = MK_WGM;

__host__ __device__ __forceinline__ int lds_byte(int r, int c) { const int st = (r >> 4) * 2 + (c >> 5), rr = r & 15, cc = c & 31, ob = rr * 64 + cc * 2; return st * 1024 + (ob ^ (((ob >> 9) & 1) << 5)); }
__host__ __device__ __forceinline__ void stage_rc(int b, int& R, int& C) { const int st = b / 1024, sb = b % 1024, swz = sb ^ (((sb >> 9) & 1) << 5); R = (st >> 1) * 16 + swz / 64; C = (st & 1) * 32 + (swz % 64) / 2; }
__host__ __device__ __forceinline__ int perm32(int rho) { const int n = rho >> 4, i = rho & 15; return 8 * (i >> 2) + 4 * n + (i & 3); }

struct Unit { int pm, pn; };
struct Gemm { const bf16_t* A; const bf16_t* Bt; int M, N, K; };

struct StaticOrder {
    int nM, nN, nwg, G, c;
    __host__ __device__ void init(int M, int N, int G_, int c_) { nM = M / BM; nN = N / BM; nwg = nM * nN; G = G_; c = c_; }
    __host__ __device__ bool next(int i, Unit& u) const {
        const long L = (long)i * G + c; if (L >= nwg) return false;
        int wgid = (int)L; { const int q = nwg / NXCD, r = nwg % NXCD, xcd = wgid % NXCD, off = wgid / NXCD; wgid = (xcd < r ? xcd * (q + 1) : r * (q + 1) + (xcd - r) * q) + off; }
        const int nig = WGM * nN, gid = wgid / nig, fm = gid * WGM, gsz = (nM - fm) < WGM ? (nM - fm) : WGM;
        u.pm = fm + ((wgid % nig) % gsz); u.pn = (wgid % nig) / gsz; return true;
    }
    __device__ __forceinline__ void a_ready(const Unit&) const {}
    __device__ __forceinline__ void done(const Unit&) const {}
};
__device__ __forceinline__ unsigned cvt_pk_bf16(float lo, float hi) { unsigned r; asm volatile("v_cvt_pk_bf16_f32 %0, %1, %2" : "=v"(r) : "v"(lo), "v"(hi)); return r; }
typedef float f32x2 __attribute__((ext_vector_type(2)));
__device__ __forceinline__ f32x2 gelu_pk(f32x2 v) {
    const f32x2 av = __builtin_elementwise_abs(v), d = av * 0.2316418882f + 1.0f;
    f32x2 t; t.x = __builtin_amdgcn_rcpf(d.x); t.y = __builtin_amdgcn_rcpf(d.y);
    f32x2 q = t * 0.5307027145f + (-0.7265760135f); q = q * t + 0.7107068705f; q = q * t + (-0.142248368f); q = q * t + 0.127414796f; q = q * t;
    const f32x2 s = (v * v) * (-0.72134752044f);
    f32x2 e; e.x = __builtin_amdgcn_exp2f(s.x); e.y = __builtin_amdgcn_exp2f(s.y);
    const f32x2 m = v * (q * e), r = v - m;
    f32x2 o; o.x = v.x < 0.f ? m.x : r.x; o.y = v.y < 0.f ? m.y : r.y; return o;
}

struct EpiF32 {
    static constexpr bool PERM = false, AFTER_DRAIN = false;
    float* C; int ldc; const float* bias;
    __device__ __forceinline__ void operator()(const f32x4 (&acc)[2][2][4][2], const Unit& u, int wr, int wc, int fr, int fq) const {
        const int row0 = u.pm * BM + wr * 64 + fr, col0 = u.pn * BM + wc * 32 + 4 * fq;
        f32x4 bv[2][2];
#pragma unroll
        for (int bj = 0; bj < 2; ++bj)
#pragma unroll
            for (int n = 0; n < 2; ++n) bv[bj][n] = bias ? *(const f32x4*)(bias + col0 + bj * HALF + n * 16) : (f32x4){0.f, 0.f, 0.f, 0.f};
#pragma unroll
        for (int ai = 0; ai < 2; ++ai)
#pragma unroll
            for (int m = 0; m < 4; ++m) { float* rowp = C + (size_t)(row0 + ai * HALF + m * 16) * ldc + col0;
#pragma unroll
                for (int bj = 0; bj < 2; ++bj)
#pragma unroll
                    for (int n = 0; n < 2; ++n) *(f32x4*)(rowp + bj * HALF + n * 16) = acc[ai][bj][m][n] + bv[bj][n]; }
    }
};
template <int ACT  > struct EpiBf16 {
    static constexpr bool PERM = true, AFTER_DRAIN = false;
    bf16_t* O; int ldc; const float* bias; int split_cols; size_t split_stride;
    __device__ __forceinline__ void operator()(const f32x4 (&acc)[2][2][4][2], const Unit& u, int wr, int wc, int fr, int fq) const {
        const int row0 = u.pm * BM + wr * 64 + fr; int colt = u.pn * BM; bf16_t* base = O;
        if (split_cols) { const int t = colt / split_cols; base += (size_t)t * split_stride; colt -= t * split_cols; }
        const int col0 = colt + wc * 32 + 8 * fq, bcol0 = u.pn * BM + wc * 32 + 8 * fq;
        f32x4 bv[2][2];
#pragma unroll
        for (int bj = 0; bj < 2; ++bj)
#pragma unroll
            for (int n = 0; n < 2; ++n) bv[bj][n] = bias ? *(const f32x4*)(bias + bcol0 + bj * HALF + 4 * n) : (f32x4){0.f, 0.f, 0.f, 0.f};
#pragma unroll
        for (int ai = 0; ai < 2; ++ai)
#pragma unroll
            for (int m = 0; m < 4; ++m) { bf16_t* rowp = base + (size_t)(row0 + ai * HALF + m * 16) * ldc + col0;
#pragma unroll
                for (int bj = 0; bj < 2; ++bj) { f32x4 v0 = acc[ai][bj][m][0] + bv[bj][0], v1 = acc[ai][bj][m][1] + bv[bj][1];
                    if (ACT == 1) { f32x2 a = gelu_pk((f32x2){v0[0], v0[1]}), b = gelu_pk((f32x2){v0[2], v0[3]}), c = gelu_pk((f32x2){v1[0], v1[1]}), d = gelu_pk((f32x2){v1[2], v1[3]});
                        v0 = (f32x4){a.x, a.y, b.x, b.y}; v1 = (f32x4){c.x, c.y, d.x, d.y}; }
                    if (ACT == 2) {
#pragma unroll
                        for (int j = 0; j < 4; ++j) { v0[j] = 0.5f * v0[j] * (1.0f + erff(v0[j] * 0.70710678f)); v1[j] = 0.5f * v1[j] * (1.0f + erff(v1[j] * 0.70710678f)); } }
                    u32x4 w; w.x = cvt_pk_bf16(v0[0], v0[1]); w.y = cvt_pk_bf16(v0[2], v0[3]); w.z = cvt_pk_bf16(v1[0], v1[1]); w.w = cvt_pk_bf16(v1[2], v1[3]);
                    *(u32x4*)(rowp + bj * HALF) = w; } }
    }
};
template <class Epi, class Sched, bool ALIGN_EPI = false, bool SP2 = false>
__device__ __forceinline__ void gemm_phase(PG8_LAS unsigned char* lds, const Gemm g, const Sched& S, const Epi& E) {
    int tid_ = threadIdx.x; asm volatile("" : "+v"(tid_));
    const int tid = tid_, wid = __builtin_amdgcn_readfirstlane(tid >> 6), lane = tid & 63, wr = wid >> 2, wc = wid & 3, fr = lane & 15, fq = lane >> 4;
    const int K = g.K, nt = K / BK;
    unsigned voffA[2], voffB[2];
#pragma unroll
    for (int i = 0; i < 2; ++i) { int R, C; stage_rc(tid * 16 + i * 8192, R, C); const int Rb = Epi::PERM ? ((R & ~31) + perm32(R & 31)) : R;
        voffA[i] = (unsigned)(R * K + C) * 2u; voffB[i] = (unsigned)(Rb * K + C) * 2u; }
    const size_t kstep = (size_t)(BK * 2);
    const size_t hstep = (size_t)HALF * K * 2;
    const size_t tstep = 2 * hstep;
    const unsigned ldsw = (unsigned)wid * 1024u;
    const int aoff = lds_byte(wr * 64 + fr, fq * 8), boff = lds_byte(wc * 32 + fr, fq * 8);
#define PG8_SA(b, h) (((b) * 2 + (h)) * HTB)
#define PG8_SB(b, h) ((4 + (b) * 2 + (h)) * HTB)
#define PG8_STAGE(bufoff, gbase, voff) do { _Pragma("unroll") for (int _i = 0; _i < 2; ++_i) \
        __builtin_amdgcn_global_load_lds((const unsigned*)((const char*)(gbase) + (voff)[_i]), (PG8_LAS unsigned*)(lds + (bufoff) + ldsw + _i * 8192), 16, 0, 0); } while (0)
#define PG8_LDA(dst, b, h) do { _Pragma("unroll") for (int m = 0; m < 4; ++m) _Pragma("unroll") for (int k = 0; k < 2; ++k) dst[m][k] = *(const PG8_LAS bf16x8*)(lds + PG8_SA(b, h) + aoff + m * 2048 + k * 1024); } while (0)
#define PG8_LDB(dst, b, h) do { _Pragma("unroll") for (int n = 0; n < 2; ++n) _Pragma("unroll") for (int k = 0; k < 2; ++k) dst[n][k] = *(const PG8_LAS bf16x8*)(lds + PG8_SB(b, h) + boff + n * 2048 + k * 1024); } while (0)
#define PG8_MMA(ai, bj, At, Bt) do { __builtin_amdgcn_s_setprio(1); _Pragma("unroll") for (int m = 0; m < 4; ++m) _Pragma("unroll") for (int n = 0; n < 2; ++n) _Pragma("unroll") for (int k = 0; k < 2; ++k) \
        acc[ai][bj][m][n] = __builtin_amdgcn_mfma_f32_16x16x32_bf16(Bt[n][k], At[m][k], acc[ai][bj][m][n], 0, 0, 0); __builtin_amdgcn_s_setprio(0); } while (0)
#define PG8_WAIT_V(n) asm volatile("s_waitcnt vmcnt(" #n ")" ::: "memory")
#define PG8_WAIT_L(n) asm volatile("s_waitcnt lgkmcnt(" #n ")" ::: "memory")
#define PG8_BAR __builtin_amdgcn_s_barrier()
#define PG8_SCHED __builtin_amdgcn_sched_barrier(0)
    Unit cur, nxt; int ui = 0;
    if (!S.next(0, cur)) return;
    f32x4 acc[2][2][4][2];
#pragma unroll
    for (int a = 0; a < 2; ++a)
#pragma unroll
        for (int b = 0; b < 2; ++b)
#pragma unroll
            for (int m = 0; m < 4; ++m)
#pragma unroll
                for (int n = 0; n < 2; ++n) acc[a][b][m][n] = (f32x4){0.f, 0.f, 0.f, 0.f};
    bf16x8 At[4][2], B0[2][2], B1[2][2];
    const char* cA = (const char*)g.A + (size_t)cur.pm * tstep; const char* cB = (const char*)g.Bt + (size_t)cur.pn * tstep;
    S.a_ready(cur);
    if constexpr (SP2) {
        PG8_STAGE(PG8_SB(0, 0), cB, voffB); PG8_STAGE(PG8_SB(0, 1), cB + hstep, voffB); PG8_STAGE(PG8_SA(0, 0), cA, voffA); PG8_STAGE(PG8_SA(0, 1), cA + hstep, voffA);
        if (wr == 1) PG8_BAR;
        PG8_WAIT_V(2); PG8_BAR;
        PG8_STAGE(PG8_SB(1, 0), cB + kstep, voffB); PG8_STAGE(PG8_SA(1, 0), cA + kstep, voffA); PG8_STAGE(PG8_SB(1, 1), cB + hstep + kstep, voffB);
        PG8_WAIT_V(6); PG8_BAR;
    } else {
        PG8_STAGE(PG8_SB(0, 0), cB, voffB); PG8_STAGE(PG8_SA(0, 0), cA, voffA); PG8_STAGE(PG8_SB(0, 1), cB + hstep, voffB); PG8_STAGE(PG8_SA(0, 1), cA + hstep, voffA);
        if (wr == 1) PG8_BAR;
        PG8_WAIT_V(4); PG8_BAR;
        PG8_STAGE(PG8_SB(1, 0), cB + kstep, voffB); PG8_STAGE(PG8_SA(1, 0), cA + kstep, voffA); PG8_STAGE(PG8_SB(1, 1), cB + hstep + kstep, voffB);
        PG8_WAIT_V(6); PG8_BAR;
    }
    for (;;) {
        const bool has_next = S.next(ui + 1, nxt);
        const char* nA = has_next ? (const char*)g.A + (size_t)nxt.pm * tstep : cA; const char* nB = has_next ? (const char*)g.Bt + (size_t)nxt.pn * tstep : cB;
        for (int t = 0; t < nt; t += 2) {
            const bool last = (t == nt - 2);
            const char* a1 = cA + (size_t)(t + 1) * kstep;
            const char* a2 = last ? nA : cA + (size_t)(t + 2) * kstep; const char* b2 = last ? nB : cB + (size_t)(t + 2) * kstep;
            const char* a3 = a2 + kstep; const char* b3 = b2 + kstep;
            if (last && has_next) S.a_ready(nxt);
            if constexpr (SP2) {
            PG8_LDB(B0, 0, 0); PG8_LDB(B1, 0, 1); PG8_SCHED; PG8_LDA(At, 0, 0); PG8_STAGE(PG8_SA(1, 1), a1 + hstep, voffA);
            PG8_WAIT_V(8); PG8_WAIT_L(0); PG8_BAR; PG8_MMA(0, 0, At, B0); PG8_MMA(0, 1, At, B1); PG8_BAR; PG8_SCHED;
            PG8_LDA(At, 0, 1); PG8_STAGE(PG8_SB(0, 0), b2, voffB); PG8_STAGE(PG8_SB(0, 1), b2 + hstep, voffB); PG8_STAGE(PG8_SA(0, 0), a2, voffA);
            PG8_WAIT_V(8); PG8_WAIT_L(0); PG8_BAR; PG8_MMA(1, 0, At, B0); PG8_MMA(1, 1, At, B1); PG8_BAR; PG8_SCHED;
            PG8_LDB(B0, 1, 0); PG8_LDB(B1, 1, 1); PG8_SCHED; PG8_LDA(At, 1, 0); PG8_STAGE(PG8_SA(0, 1), a2 + hstep, voffA);
            PG8_WAIT_V(8); PG8_WAIT_L(0); PG8_BAR; PG8_MMA(0, 0, At, B0); PG8_MMA(0, 1, At, B1); PG8_BAR; PG8_SCHED;
            PG8_LDA(At, 1, 1); PG8_STAGE(PG8_SB(1, 0), b3, voffB); PG8_STAGE(PG8_SB(1, 1), b3 + hstep, voffB); PG8_STAGE(PG8_SA(1, 0), a3, voffA);
            PG8_WAIT_V(8); PG8_WAIT_L(0); PG8_BAR; PG8_MMA(1, 0, At, B0); PG8_MMA(1, 1, At, B1); PG8_BAR; PG8_SCHED;
            } else {
            PG8_LDB(B0, 0, 0); PG8_SCHED; PG8_LDA(At, 0, 0); PG8_STAGE(PG8_SA(1, 1), a1 + hstep, voffA);
            PG8_WAIT_L(8); PG8_BAR; PG8_WAIT_L(0); PG8_MMA(0, 0, At, B0); PG8_BAR; PG8_SCHED;
            PG8_LDB(B1, 0, 1); PG8_STAGE(PG8_SB(0, 0), b2, voffB);
            PG8_BAR; PG8_WAIT_L(0); PG8_MMA(0, 1, At, B1); PG8_BAR;
            PG8_LDA(At, 0, 1); PG8_STAGE(PG8_SA(0, 0), a2, voffA);
            PG8_BAR; PG8_WAIT_L(0); PG8_MMA(1, 0, At, B0); PG8_BAR; PG8_SCHED;
            PG8_STAGE(PG8_SB(0, 1), b2 + hstep, voffB);
            PG8_WAIT_V(6); PG8_BAR; PG8_MMA(1, 1, At, B1); PG8_BAR;
            PG8_LDB(B0, 1, 0); PG8_SCHED; PG8_LDA(At, 1, 0); PG8_STAGE(PG8_SA(0, 1), a2 + hstep, voffA);
            PG8_WAIT_L(8); PG8_BAR; PG8_WAIT_L(0); PG8_MMA(0, 0, At, B0); PG8_BAR; PG8_SCHED;
            PG8_LDB(B1, 1, 1); PG8_STAGE(PG8_SB(1, 0), b3, voffB);
            PG8_BAR; PG8_WAIT_L(0); PG8_MMA(0, 1, At, B1); PG8_BAR;
            PG8_LDA(At, 1, 1); PG8_STAGE(PG8_SA(1, 0), a3, voffA);
            PG8_BAR; PG8_WAIT_L(0); PG8_MMA(1, 0, At, B0); PG8_BAR; PG8_SCHED;
            PG8_STAGE(PG8_SB(1, 1), b3 + hstep, voffB);
            PG8_WAIT_V(6); PG8_BAR; PG8_MMA(1, 1, At, B1); PG8_BAR;
            }
        }
        if constexpr (ALIGN_EPI) { if (wr == 0) PG8_BAR; }
        if constexpr (!Epi::AFTER_DRAIN) { E(acc, cur, wr, wc, fr, fq); S.done(cur); }
        if (!has_next) break;
#pragma unroll
        for (int a = 0; a < 2; ++a)
#pragma unroll
            for (int b = 0; b < 2; ++b)
#pragma unroll
                for (int m = 0; m < 4; ++m)
#pragma unroll
                    for (int n = 0; n < 2; ++n) acc[a][b][m][n] = (f32x4){0.f, 0.f, 0.f, 0.f};
        cur = nxt; cA = nA; cB = nB; ++ui;
        if constexpr (ALIGN_EPI) { if (wr == 1) PG8_BAR; }
    }
    PG8_WAIT_V(0);
    if constexpr (!ALIGN_EPI) { if (wr == 0) PG8_BAR; }
    PG8_BAR;
    if constexpr (Epi::AFTER_DRAIN) { E.fused(acc, cur, wr, wc, fr, fq, lds, wid, lane); S.done(cur); }
#undef PG8_SA
#undef PG8_SB
#undef PG8_STAGE
#undef PG8_LDA
#undef PG8_LDB
#undef PG8_MMA
#undef PG8_WAIT_V
#undef PG8_WAIT_L
#undef PG8_BAR
#undef PG8_SCHED
}
}

#ifndef REP_SYNC
#define REP_SYNC 1
#endif
#ifndef REP_P1
#define REP_P1 1
#endif
#ifndef MK_ALIGN_EPI
#define MK_ALIGN_EPI true
#endif
#ifndef MK_SP2
#define MK_SP2 true
#endif
#ifndef NT_Z
#define NT_Z 0
#endif
#ifndef STAG1
#define STAG1 0
#endif
#ifndef STAG3
#define STAG3 0
#endif
#ifndef STAG5
#define STAG5 0
#endif
#ifndef REP_K3
#define REP_K3 0
#endif
#ifndef REP_P0
#define REP_P0 1
#endif
#ifndef REP_PLE
#define REP_PLE 1
#endif
#ifndef REP_P5
#define REP_P5 1
#endif
#ifndef REP_A
#define REP_A 1
#endif
#ifndef REP_P2E
#define REP_P2E 1
#endif
#ifndef REP_P2O
#define REP_P2O 1
#endif
namespace mk {
using pg8::bf16_t; using pg8::bf16x8; using pg8::f32x4; using pg8::u32x4;
typedef unsigned u32x2 __attribute__((ext_vector_type(2)));
typedef float f32x2 __attribute__((ext_vector_type(2)));
typedef short bf16x4 __attribute__((ext_vector_type(4)));
#define MK_LAS __attribute__((address_space(3)))
constexpr int M = 65536, D = 1024, NB = 3072, DP = 256, SEQ = 4096, WB = 512, DEPTH = 4;
constexpr float LN_EPS = 1e-5f;
constexpr float ALPHA = 1.681792830507429f;
constexpr int NTHREADS = 512, NWAVES = 8;
constexpr int LDS_BYTES = 147520;
constexpr int LDS_RED = 139264;
constexpr int VT_STRIDE = 132;
constexpr size_t WS_WIN = 0;
constexpr size_t WS_WOUT = WS_WIN + (size_t)4 * NB * D * 2;
constexpr size_t WS_WGATE = WS_WOUT + (size_t)4 * D * D * 2;
constexpr size_t WS_WPLE = WS_WGATE + (size_t)4 * D * D * 2;
constexpr size_t WS_WS = WS_WPLE + (size_t)4 * D * DP * 2;
constexpr size_t WS_WP = WS_WS + (size_t)2 * 8 * 128 * 128 * 2;
constexpr size_t WS_XB = WS_WP + (size_t)2 * 4 * 128 * 128 * 2;
constexpr size_t WS_PB = WS_XB + (size_t)2 * M * D * 2;
constexpr size_t WS_Z = WS_PB + (size_t)4 * M * DP * 2;
constexpr size_t WS_Y = WS_Z + (size_t)M * NB * 2;
constexpr size_t WS_STATS = WS_Y + (size_t)M * D * 2;
constexpr size_t WS_C12 = WS_STATS + (size_t)M * 16 * 2 * 4;
constexpr size_t WS_BAR = WS_C12 + (size_t)4 * 2 * D * 4;
constexpr size_t WS_END = WS_BAR + (size_t)XCD_BAR_WORDS * 4;

struct Params { const float* in[26]; float* out; unsigned char* ws; };

__device__ __forceinline__ float bf2f(unsigned short b) { return __uint_as_float((unsigned)b << 16); }
__device__ __forceinline__ float bflo(unsigned w) { return __uint_as_float(w << 16); }
__device__ __forceinline__ float bfhi(unsigned w) { return __uint_as_float(w & 0xffff0000u); }
__device__ __forceinline__ unsigned short f2bf(float f) { unsigned u = __float_as_uint(f); u += 0x7FFFu + ((u >> 16) & 1u); return (unsigned short)(u >> 16); }
__device__ __forceinline__ unsigned pk2(float lo, float hi) { return pg8::cvt_pk_bf16(lo, hi); }
__device__ __forceinline__ float sigmoidf_(float x) { return __builtin_amdgcn_rcpf(1.0f + __expf(-x)); }
__device__ __forceinline__ float siluf_(float x) { return x * sigmoidf_(x); }
__device__ __forceinline__ float geluf_(float x) { return x * sigmoidf_(1.5957691216057308f * (x + 0.044715f * x * x * x)); }
__device__ __forceinline__ float silu2_(float a, float b) { return (a * b) * __builtin_amdgcn_rcpf((1.0f + __expf(-a)) * (1.0f + __expf(-b))); }
__device__ __forceinline__ float gelu_silu_(float u, float g) { return (u * g) * __builtin_amdgcn_rcpf((1.0f + __expf(-1.5957691216057308f * (u + 0.044715f * u * u * u))) * (1.0f + __expf(-g))); }
template <int CTRL> __device__ __forceinline__ float dpp_f(float v) { return __builtin_bit_cast(float, __builtin_amdgcn_update_dpp(0, __builtin_bit_cast(int, v), CTRL, 0xf, 0xf, false)); }
__device__ __forceinline__ float wave_sum(float v) {
    v += dpp_f<0x128>(v); v += dpp_f<0x124>(v); v += dpp_f<0x122>(v); v += dpp_f<0x121>(v);
    const int vi = __builtin_bit_cast(int, v);
    const float r0 = __builtin_bit_cast(float, __builtin_amdgcn_readlane(vi, 0)), r1 = __builtin_bit_cast(float, __builtin_amdgcn_readlane(vi, 16));
    const float r2 = __builtin_bit_cast(float, __builtin_amdgcn_readlane(vi, 32)), r3 = __builtin_bit_cast(float, __builtin_amdgcn_readlane(vi, 48));
    return (r0 + r1) + (r2 + r3);
}

struct EpiNull {
    static constexpr bool PERM = true, AFTER_DRAIN = false;
    __device__ __forceinline__ void operator()(const f32x4 (&acc)[2][2][4][2], const pg8::Unit&, int, int, int, int) const {
#pragma unroll
        for (int a = 0; a < 2; ++a)
#pragma unroll
            for (int b = 0; b < 2; ++b)
#pragma unroll
                for (int m = 0; m < 4; ++m)
#pragma unroll
                    for (int n = 0; n < 2; ++n) asm volatile("" :: "v"(acc[a][b][m][n]));
    }
};
struct EpiZ {
    static constexpr bool PERM = true, AFTER_DRAIN = false;
    bf16_t* O; int ld; const MK_LAS float* lbias; int oddmode;
    __device__ __forceinline__ void operator()(const f32x4 (&acc)[2][2][4][2], const pg8::Unit& u, int wr, int wc, int fr, int fq) const {
        const int row0 = u.pm * 256 + wr * 64 + fr, col0 = u.pn * 256 + wc * 64 + 16 * fq;
        f32x4 bv[2][2];
#pragma unroll
        for (int bj = 0; bj < 2; ++bj)
#pragma unroll
            for (int n = 0; n < 2; ++n) bv[bj][n] = lbias ? *(const MK_LAS f32x4*)(lbias + col0 + 8 * bj + 4 * n) : (f32x4){0.f, 0.f, 0.f, 0.f};
        if (oddmode && u.pn >= 4) {
            const bool gate = u.pn < 8;
            const int scol = gate ? 1536 + ((col0 - 1024) >> 1) : 1024 + ((col0 - 2048) >> 1);
#pragma unroll
            for (int ai = 0; ai < 2; ++ai)
#pragma unroll
                for (int m = 0; m < 4; ++m) { bf16_t* rowp = O + (size_t)(row0 + ai * 128 + m * 16) * ld + scol;
                    f32x4 y0 = acc[ai][1][m][0] + bv[1][0], y1 = acc[ai][1][m][1] + bv[1][1];
                    if (gate) {
#pragma unroll
                        for (int e = 0; e < 4; ++e) { y0[e] = siluf_(y0[e]); y1[e] = siluf_(y1[e]); } }
                    const f32x4 v0 = (acc[ai][0][m][0] + bv[0][0]) * y0, v1 = (acc[ai][0][m][1] + bv[0][1]) * y1;
                    u32x4 w; w.x = pg8::cvt_pk_bf16(v0[0], v0[1]); w.y = pg8::cvt_pk_bf16(v0[2], v0[3]); w.z = pg8::cvt_pk_bf16(v1[0], v1[1]); w.w = pg8::cvt_pk_bf16(v1[2], v1[3]);
                    *(u32x4*)rowp = w; }
            return;
        }
        const int scol = col0;
#pragma unroll
        for (int ai = 0; ai < 2; ++ai)
#pragma unroll
            for (int m = 0; m < 4; ++m) { bf16_t* rowp = O + (size_t)(row0 + ai * 128 + m * 16) * ld + scol;
#pragma unroll
                for (int bj = 0; bj < 2; ++bj) { const f32x4 v0 = acc[ai][bj][m][0] + bv[bj][0], v1 = acc[ai][bj][m][1] + bv[bj][1];
                    u32x4 w; w.x = pg8::cvt_pk_bf16(v0[0], v0[1]); w.y = pg8::cvt_pk_bf16(v0[2], v0[3]); w.z = pg8::cvt_pk_bf16(v1[0], v1[1]); w.w = pg8::cvt_pk_bf16(v1[2], v1[3]);
                    *(u32x4*)(rowp + bj * 8) = w; } }
    }
};
struct EpiT {
    static constexpr bool PERM = true, AFTER_DRAIN = false;
    const bf16_t* xs; bf16_t* xt; const float* bias; float* stats;
    __device__ __forceinline__ void operator()(const f32x4 (&acc)[2][2][4][2], const pg8::Unit& u, int wr, int wc, int fr, int fq) const {
        const int row0 = u.pm * 256 + wr * 64 + fr, col0 = u.pn * 256 + wc * 64 + 16 * fq;
        f32x4 bv[2][2];
#pragma unroll
        for (int bj = 0; bj < 2; ++bj)
#pragma unroll
            for (int n = 0; n < 2; ++n) bv[bj][n] = *(const f32x4*)(bias + col0 + 8 * bj + 4 * n);
        u32x4 xr[4][2];
#pragma unroll
        for (int g = 0; g < 4; ++g) { const bf16_t* p = xs + (size_t)(row0 + g * 16) * D + col0; xr[g][0] = *(const u32x4*)p; xr[g][1] = *(const u32x4*)(p + 8); }
#pragma unroll
        for (int g = 0; g < 8; ++g) {
            const int ai = g >> 2, m = g & 3, row = row0 + ai * 128 + m * 16; bf16_t* p = xt + (size_t)row * D + col0;
            const u32x4 xc0 = xr[g & 3][0], xc1 = xr[g & 3][1];
            if (g < 4) { const bf16_t* pn = xs + (size_t)(row0 + 128 + g * 16) * D + col0; xr[g][0] = *(const u32x4*)pn; xr[g][1] = *(const u32x4*)(pn + 8); }
            float s = 0.f, s2 = 0.f;
#pragma unroll
            for (int bj = 0; bj < 2; ++bj) { const u32x4 x4 = bj ? xc1 : xc0;
                const f32x4 v0 = acc[ai][bj][m][0] + bv[bj][0] + (f32x4){bflo(x4.x), bfhi(x4.x), bflo(x4.y), bfhi(x4.y)} * ALPHA;
                const f32x4 v1 = acc[ai][bj][m][1] + bv[bj][1] + (f32x4){bflo(x4.z), bfhi(x4.z), bflo(x4.w), bfhi(x4.w)} * ALPHA;
                u32x4 w; w.x = pg8::cvt_pk_bf16(v0[0], v0[1]); w.y = pg8::cvt_pk_bf16(v0[2], v0[3]); w.z = pg8::cvt_pk_bf16(v1[0], v1[1]); w.w = pg8::cvt_pk_bf16(v1[2], v1[3]);
                *(u32x4*)(p + bj * 8) = w;
                const float r0 = bflo(w.x), r1 = bfhi(w.x), r2 = bflo(w.y), r3 = bfhi(w.y), r4 = bflo(w.z), r5 = bfhi(w.z), r6 = bflo(w.w), r7 = bfhi(w.w);
                s += ((r0 + r1) + (r2 + r3)) + ((r4 + r5) + (r6 + r7));
                s2 += ((r0 * r0 + r1 * r1) + (r2 * r2 + r3 * r3)) + ((r4 * r4 + r5 * r5) + (r6 * r6 + r7 * r7)); }
            s += __shfl_xor(s, 16); s += __shfl_xor(s, 32); s2 += __shfl_xor(s2, 16); s2 += __shfl_xor(s2, 32);
            if (fq == 0) *(f32x2*)(stats + ((size_t)(u.pn * 4 + wc) * M + row) * 2) = (f32x2){s, s2};
        }
    }
};
struct EpiGate2 {
    static constexpr bool PERM = true, AFTER_DRAIN = false;
    const bf16_t* tb; const bf16_t* ple; bf16_t* xo; float* fo; const float* stats; const MK_LAS float* lv;
    __device__ __forceinline__ void operator()(const f32x4 (&acc)[2][2][4][2], const pg8::Unit& u, int wr, int wc, int fr, int fq) const {
        const int row0 = u.pm * 256 + wr * 64 + fr, col0 = u.pn * 256 + wc * 64 + 16 * fq;
        f32x4 sa[2], sb[2]; u32x4 tw[2][2], pw[2][2];
        { const float* sp = stats + ((size_t)(fq * 4) * M + row0) * 2; const f32x2 q0 = *(const f32x2*)sp, q1 = *(const f32x2*)(sp + (size_t)2 * M), q2 = *(const f32x2*)(sp + (size_t)4 * M), q3 = *(const f32x2*)(sp + (size_t)6 * M); sa[0] = (f32x4){q0.x, q0.y, q1.x, q1.y}; sb[0] = (f32x4){q2.x, q2.y, q3.x, q3.y};
          const size_t o = (size_t)row0 * D + col0; tw[0][0] = *(const u32x4*)(tb + o); tw[0][1] = *(const u32x4*)(tb + o + 8); pw[0][0] = *(const u32x4*)(ple + o); pw[0][1] = *(const u32x4*)(ple + o + 8); }
#pragma unroll
        for (int g = 0; g < 8; ++g) {
            const int ai = g >> 2, m = g & 3, row = row0 + ai * 128 + m * 16, cur = g & 1;
            if (g < 7) { const int g1 = g + 1, nb = g1 & 1, rown = row0 + (g1 >> 2) * 128 + (g1 & 3) * 16;
                const float* sp = stats + ((size_t)(fq * 4) * M + rown) * 2; const f32x2 q0 = *(const f32x2*)sp, q1 = *(const f32x2*)(sp + (size_t)2 * M), q2 = *(const f32x2*)(sp + (size_t)4 * M), q3 = *(const f32x2*)(sp + (size_t)6 * M); sa[nb] = (f32x4){q0.x, q0.y, q1.x, q1.y}; sb[nb] = (f32x4){q2.x, q2.y, q3.x, q3.y};
                const size_t o = (size_t)rown * D + col0; tw[nb][0] = *(const u32x4*)(tb + o); tw[nb][1] = *(const u32x4*)(tb + o + 8); pw[nb][0] = *(const u32x4*)(ple + o); pw[nb][1] = *(const u32x4*)(ple + o + 8); }
            float mu, rs;
            { const f32x4 a = sa[cur], b = sb[cur];
              float s = (a[0] + a[2]) + (b[0] + b[2]), s2 = (a[1] + a[3]) + (b[1] + b[3]);
              s += __shfl_xor(s, 16); s += __shfl_xor(s, 32); s2 += __shfl_xor(s2, 16); s2 += __shfl_xor(s2, 32);
              mu = s * (1.f / D); const float var = s2 * (1.f / D) - mu * mu; rs = 1.f / sqrtf(fmaxf(var, 0.f) + LN_EPS); }
#pragma unroll
            for (int bj = 0; bj < 2; ++bj) {
                const int c = col0 + bj * 8; const size_t o = (size_t)row * D + c;
                const u32x4 t4 = tw[cur][bj], p4 = pw[cur][bj];
                f32x4 x[2];
#pragma unroll
                for (int n = 0; n < 2; ++n) {
                    const f32x4 gv = *(const MK_LAS f32x4*)(lv + c + 4 * n), bb = *(const MK_LAS f32x4*)(lv + 1024 + c + 4 * n), c1v = *(const MK_LAS f32x4*)(lv + 2048 + c + 4 * n), c2v = *(const MK_LAS f32x4*)(lv + 3072 + c + 4 * n);
                    const unsigned ta = n ? t4.z : t4.x, tbw = n ? t4.w : t4.y, pa = n ? p4.z : p4.x, pb2 = n ? p4.w : p4.y;
                    const f32x4 tv = (f32x4){bflo(ta), bfhi(ta), bflo(tbw), bfhi(tbw)}, pv = (f32x4){bflo(pa), bfhi(pa), bflo(pb2), bfhi(pb2)};
                    const f32x4 gp = (acc[ai][bj][m][n] - c1v * mu) * rs + c2v;
                    const f32x4 h = (tv - mu) * rs * gv + bb;
#pragma unroll
                    for (int e = 0; e < 4; ++e) x[n][e] = h[e] + sigmoidf_(gp[e]) * pv[e];
                }
                if (fo) { *(f32x4*)(fo + o) = x[0]; *(f32x4*)(fo + o + 4) = x[1]; }
                else { u32x4 w; w.x = pg8::cvt_pk_bf16(x[0][0], x[0][1]); w.y = pg8::cvt_pk_bf16(x[0][2], x[0][3]); w.z = pg8::cvt_pk_bf16(x[1][0], x[1][1]); w.w = pg8::cvt_pk_bf16(x[1][2], x[1][3]); *(u32x4*)(xo + o) = w; }
            }
        }
    }
};

__device__ __forceinline__ int orig_col_odd(int L) {
    if (L < 1024) return L;
    if (L < 2048) { const int g = (L - 1024) >> 4, e = L & 15; return e < 8 ? 1536 + 8 * g + e : 2560 + 8 * g + (e - 8); }
    const int g = (L - 2048) >> 4, e = L & 15;
    return e < 8 ? 1024 + 8 * g + e : 2048 + 8 * g + (e - 8);
}
__device__ __forceinline__ int phys_row(int L) { const int r = L & 255; return (L & ~255) + 128 * ((r >> 3) & 1) + 32 * (r >> 6) + 8 * ((r >> 4) & 3) + (r & 7); }
__device__ __forceinline__ void p0_transpose_item(const float* W, int K, int N, bf16_t* WT, MK_LAS float* scr, int item, int lane, const float* rowscale = nullptr, bool remap = true, bool oddmap = false) {
    const int nblk = N / 32, kb = item / nblk, nb = item % nblk, k0 = 64 * kb, n0 = 32 * nb;
    const int scol = oddmap ? orig_col_odd(n0 + (lane & 31)) : n0 + (lane & 31);
    float wl[32];
#pragma unroll
    for (int i = 0; i < 32; ++i) wl[i] = W[(size_t)(k0 + 2 * i + (lane >> 5)) * N + scol];
#pragma unroll
    for (int i = 0; i < 32; ++i) { const int kk = 2 * i + (lane >> 5); float wv = wl[i]; if (rowscale) wv *= rowscale[k0 + kk]; scr[kk * 33 + (lane & 31)] = wv; }
    asm volatile("s_waitcnt lgkmcnt(0)" ::: "memory");
    const int c = lane & 7;
#pragma unroll
    for (int j = 0; j < 4; ++j) { const int n = (lane >> 3) + 8 * j; const MK_LAS float* s = scr + (8 * c) * 33 + n;
        u32x4 o; o.x = pk2(s[0 * 33], s[1 * 33]); o.y = pk2(s[2 * 33], s[3 * 33]); o.z = pk2(s[4 * 33], s[5 * 33]); o.w = pk2(s[6 * 33], s[7 * 33]);
        *(u32x4*)(WT + (size_t)(remap ? phys_row(n0 + n) : (n0 + n)) * K + k0 + 8 * c) = o; }
    asm volatile("s_waitcnt lgkmcnt(0)" ::: "memory");
}
__device__ __forceinline__ void cvt_rows(const float* src, bf16_t* dst, size_t n8, size_t i0, size_t stride) {
    for (size_t i = i0; i < n8; i += 4 * stride) {
        f32x4 a[4], b[4];
#pragma unroll
        for (int k = 0; k < 4; ++k) { const size_t ii = (i + k * stride < n8) ? i + k * stride : i; a[k] = __builtin_nontemporal_load((const f32x4*)(src + ii * 8)); b[k] = __builtin_nontemporal_load((const f32x4*)(src + ii * 8 + 4)); }
#pragma unroll
        for (int k = 0; k < 4; ++k) { if (i + k * stride < n8) { u32x4 o; o.x = pk2(a[k][0], a[k][1]); o.y = pk2(a[k][2], a[k][3]); o.z = pk2(b[k][0], b[k][1]); o.w = pk2(b[k][2], b[k][3]); *(u32x4*)(dst + (i + k * stride) * 8) = o; } }
    }
}
__device__ __forceinline__ void p0_prologue(const Params& P, MK_LAS unsigned char* lds) {
    int tid_ = threadIdx.x; asm volatile("" : "+v"(tid_));
    const int tid = tid_, lane = tid & 63, wave = tid >> 6;
    MK_LAS float* scr = (MK_LAS float*)(lds + wave * 16384);
    const int gw = blockIdx.x * NWAVES + wave, NGW = gridDim.x * NWAVES;
    unsigned char* ws = P.ws;
    constexpr int I_IN = (D / 64) * (NB / 32), I_SQ = (D / 64) * (D / 32), I_PLE = (DP / 64) * (D / 32), I_POOL = (128 / 64) * (128 / 32);
    constexpr int PER_L = I_IN + 2 * I_SQ + I_PLE, NITEMS = 4 * PER_L + 8 * I_POOL;
    for (int it = gw; it < NITEMS; it += NGW) {
        if (it < 4 * PER_L) {
            const int l = it / PER_L, j = l >> 1; int r = it % PER_L;
            if (r < I_IN) { const float* W = ((l & 1) ? P.in[14] : P.in[2]) + (size_t)j * D * NB; p0_transpose_item(W, D, NB, (bf16_t*)(ws + WS_WIN) + (size_t)l * NB * D, scr, r, lane, nullptr, true, (l & 1) != 0); continue; } r -= I_IN;
            if (r < I_SQ) { const float* W = ((l & 1) ? P.in[19] : P.in[12]) + (size_t)j * D * D; p0_transpose_item(W, D, D, (bf16_t*)(ws + WS_WOUT) + (size_t)l * D * D, scr, r, lane); continue; } r -= I_SQ;
            if (r < I_SQ) { p0_transpose_item(P.in[24] + (size_t)l * D * D, D, D, (bf16_t*)(ws + WS_WGATE) + (size_t)l * D * D, scr, r, lane, P.in[21] + (size_t)l * D); continue; } r -= I_SQ;
            p0_transpose_item(P.in[23] + (size_t)l * DP * D, DP, D, (bf16_t*)(ws + WS_WPLE) + (size_t)l * D * DP, scr, r, lane);
        } else {
            const int r = it - 4 * PER_L, mtx = r / I_POOL;
            p0_transpose_item(P.in[16] + (size_t)mtx * 128 * 128, 128, 128, (bf16_t*)(ws + WS_WP) + (size_t)mtx * 128 * 128, scr, r % I_POOL, lane, nullptr, false);
        }
    }
    const size_t gt = (size_t)blockIdx.x * NTHREADS + tid, GT = (size_t)gridDim.x * NTHREADS;
    for (size_t i = gt; i < (size_t)2 * 8 * 128 * 128; i += GT) { const int s = (int)(i & 127), t = (int)((i >> 7) & 127); ((bf16_t*)(ws + WS_WS))[i] = (s <= t) ? f2bf(P.in[10][i]) : (bf16_t)0; }
    cvt_rows(P.in[0], (bf16_t*)(ws + WS_XB), (size_t)M * D / 8, gt, GT);
    cvt_rows(P.in[1], (bf16_t*)(ws + WS_PB), (size_t)4 * M * DP / 8, gt, GT);
    __syncthreads();
    for (int task = blockIdx.x; task < 4 * (D / 16); task += gridDim.x) {
        const int l = task / (D / 16), n = (task % (D / 16)) * 16 + (tid & 15), kg = tid >> 4;
        const float* Wg = P.in[24] + (size_t)l * D * D + n; const float* g = P.in[21] + (size_t)l * D; const float* b = P.in[22] + (size_t)l * D;
        float s1 = 0.f, s2 = 0.f;
#pragma unroll 8
        for (int k = kg * 32; k < kg * 32 + 32; ++k) { const float w = Wg[(size_t)k * D]; s1 += bf2f(f2bf(g[k] * w)); s2 += b[k] * w; }
        MK_LAS float* red = (MK_LAS float*)lds;
        red[tid * 2] = s1; red[tid * 2 + 1] = s2;
        __syncthreads();
        if (tid < 16) { float a1 = 0.f, a2 = 0.f;
            for (int w = 0; w < 32; ++w) { a1 += red[(w * 16 + tid) * 2]; a2 += red[(w * 16 + tid) * 2 + 1]; }
            float* c12 = (float*)(ws + WS_C12) + (size_t)l * 2 * D; c12[n] = a1; c12[D + n] = a2 + P.in[25][(size_t)l * D + n]; }
        __syncthreads();
    }
}

__device__ __forceinline__ void even_a_branch(const bf16_t* z, bf16_t* y, const float* cw, const float* cb, const float* lg, const float* lb, int run, MK_LAS unsigned char* lds) {
    unsigned tid_ = threadIdx.x; asm volatile("" : "+v"(tid_));
    const unsigned tid = tid_, lane = tid & 63u, c = tid; const int wave = __builtin_amdgcn_readfirstlane((int)(tid >> 6));
    MK_LAS float* LA = (MK_LAS float*)lds;
    MK_LAS float* LO = (MK_LAS float*)(lds + 65536);
    float wk[31];
#pragma unroll
    for (int k = 0; k < 31; ++k) wk[k] = (cw + k * WB)[c];
    const float cbv = cb[c];
    const f32x4 g0 = *(const f32x4*)(lg + 8u * lane), g1 = *(const f32x4*)(lg + 8u * lane + 4u), b0 = *(const f32x4*)(lb + 8u * lane), b1 = *(const f32x4*)(lb + 8u * lane + 4u);
    const int row0 = run * 256, pos0 = row0 & (SEQ - 1);
    float win[38];
#pragma unroll
    for (int i = 0; i < 30; ++i) { float v = 0.f;
        if (pos0 - 30 + i >= 0) { const bf16_t* zr = z + (size_t)(row0 - 30 + i) * NB; v = bf2f(zr[c]) * sigmoidf_(bf2f(zr[c + 512u])); }
        win[8 + i] = v; }
    u32x4 rv[4], rg[4];
    { const bf16_t* zw = z + (size_t)(row0 + 4 * wave) * NB;
#pragma unroll
      for (int tt = 0; tt < 4; ++tt) { rv[tt] = *(const u32x4*)(zw + (size_t)tt * NB + 8u * lane); rg[tt] = *(const u32x4*)(zw + (size_t)tt * NB + 512u + 8u * lane); } }
    for (int st = 0; st < 8; ++st) {
        const bf16_t* zst = z + (size_t)(row0 + st * 32 + 4 * wave) * NB;
#pragma unroll
        for (int tt = 0; tt < 4; ++tt) {
            const u32x4 v = rv[tt], g = rg[tt];
            f32x4 a0, a1;
            a0[0] = bflo(v.x) * sigmoidf_(bflo(g.x)); a0[1] = bfhi(v.x) * sigmoidf_(bfhi(g.x)); a0[2] = bflo(v.y) * sigmoidf_(bflo(g.y)); a0[3] = bfhi(v.y) * sigmoidf_(bfhi(g.y));
            a1[0] = bflo(v.z) * sigmoidf_(bflo(g.z)); a1[1] = bfhi(v.z) * sigmoidf_(bfhi(g.z)); a1[2] = bflo(v.w) * sigmoidf_(bflo(g.w)); a1[3] = bfhi(v.w) * sigmoidf_(bfhi(g.w));
            MK_LAS float* p = LA + (4 * wave + tt) * 512 + 8u * lane;
            *(MK_LAS f32x4*)p = a0; *(MK_LAS f32x4*)(p + 4) = a1;
        }
        __syncthreads();
        u32x4 gt[4];
#pragma unroll
        for (int tt = 0; tt < 4; ++tt) gt[tt] = *(const u32x4*)(zst + (size_t)tt * NB + 1024u + 8u * lane);
        if (st < 7) {
#pragma unroll
            for (int tt = 0; tt < 4; ++tt) { rv[tt] = *(const u32x4*)(zst + (size_t)(32 + tt) * NB + 8u * lane); rg[tt] = *(const u32x4*)(zst + (size_t)(32 + tt) * NB + 512u + 8u * lane); }
        }
#pragma unroll
        for (int ch = 0; ch < 4; ++ch) {
#pragma unroll
            for (int i = 0; i < 30; ++i) win[i] = win[i + 8];
#pragma unroll
            for (int i = 0; i < 8; ++i) win[30 + i] = LA[(ch * 8 + i) * 512 + c];
#pragma unroll
            for (int i = 0; i < 8; ++i) { float s = cbv;
#pragma unroll
                for (int k = 0; k < 31; ++k) s += wk[k] * win[i + k];
                LO[(ch * 8 + i) * 512 + c] = s; }
        }
        __syncthreads();
#pragma unroll
        for (int tt = 0; tt < 4; ++tt) {
            const MK_LAS float* p = LO + (4 * wave + tt) * 512 + 8u * lane;
            f32x4 v0 = *(const MK_LAS f32x4*)p, v1 = *(const MK_LAS f32x4*)(p + 4);
            float s = ((v0[0] + v0[1]) + (v0[2] + v0[3])) + ((v1[0] + v1[1]) + (v1[2] + v1[3]));
            float s2 = ((v0[0] * v0[0] + v0[1] * v0[1]) + (v0[2] * v0[2] + v0[3] * v0[3])) + ((v1[0] * v1[0] + v1[1] * v1[1]) + (v1[2] * v1[2] + v1[3] * v1[3]));
            s = wave_sum(s); s2 = wave_sum(s2);
            const float mean = s * (1.f / WB), var = s2 * (1.f / WB) - mean * mean, rstd = 1.f / sqrtf(fmaxf(var, 0.f) + LN_EPS);
            v0 = (v0 - mean) * rstd * g0 + b0; v1 = (v1 - mean) * rstd * g1 + b1;
            const u32x4 g = gt[tt];
            u32x4 o;
            o.x = pk2(silu2_(v0[0], bflo(g.x)), silu2_(v0[1], bfhi(g.x))); o.y = pk2(silu2_(v0[2], bflo(g.y)), silu2_(v0[3], bfhi(g.y)));
            o.z = pk2(silu2_(v1[0], bflo(g.z)), silu2_(v1[1], bfhi(g.z))); o.w = pk2(silu2_(v1[2], bflo(g.w)), silu2_(v1[3], bfhi(g.w)));
            *(u32x4*)(y + (size_t)(row0 + st * 32 + 4 * wave + tt) * D + 8u * lane) = o;
        }
    }
}
__device__ __forceinline__ void even_b_block(const bf16_t* z, bf16_t* y, const float* lvg, const float* lvb, const bf16_t* WsM  , const float* bs  , int blk, MK_LAS unsigned char* lds) {
    int tid_ = threadIdx.x; asm volatile("" : "+v"(tid_));
    const int tid = tid_, lane = tid & 63, wave = __builtin_amdgcn_readfirstlane(tid >> 6);
    const int brow0 = blk * 128;
    const f32x4 g0 = *(const f32x4*)(lvg + 8 * lane), g1 = *(const f32x4*)(lvg + 8 * lane + 4), b0 = *(const f32x4*)(lvb + 8 * lane), b1 = *(const f32x4*)(lvb + 8 * lane + 4);
    for (int grp = 0; grp < 2; ++grp) {
        const int t0 = 16 * wave + 8 * grp;
        const bf16_t* zr = z + (size_t)(brow0 + t0) * NB + 2048 + 8 * lane;
        u32x4 raw[8];
#pragma unroll
        for (int tt = 0; tt < 8; ++tt) raw[tt] = *(const u32x4*)(zr + (size_t)tt * NB);
        u32x4 outp[8];
#pragma unroll
        for (int p = 0; p < 4; ++p) {
            f32x4 va[2][2];
#pragma unroll
            for (int e = 0; e < 2; ++e) { const u32x4 r = raw[2 * p + e];
                f32x4 v0 = (f32x4){geluf_(bflo(r.x)), geluf_(bfhi(r.x)), geluf_(bflo(r.y)), geluf_(bfhi(r.y))}, v1 = (f32x4){geluf_(bflo(r.z)), geluf_(bfhi(r.z)), geluf_(bflo(r.w)), geluf_(bfhi(r.w))};
                float s = ((v0[0] + v0[1]) + (v0[2] + v0[3])) + ((v1[0] + v1[1]) + (v1[2] + v1[3]));
                float s2 = ((v0[0] * v0[0] + v0[1] * v0[1]) + (v0[2] * v0[2] + v0[3] * v0[3])) + ((v1[0] * v1[0] + v1[1] * v1[1]) + (v1[2] * v1[2] + v1[3] * v1[3]));
                s = wave_sum(s); s2 = wave_sum(s2);
                const float mean = s * (1.f / WB), var = s2 * (1.f / WB) - mean * mean, rstd = 1.f / sqrtf(fmaxf(var, 0.f) + LN_EPS);
                va[e][0] = (v0 - mean) * rstd * g0 + b0; va[e][1] = (v1 - mean) * rstd * g1 + b1; }
#pragma unroll
            for (int i = 0; i < 8; ++i) { const unsigned w = pg8::cvt_pk_bf16(va[0][i >> 2][i & 3], va[1][i >> 2][i & 3]);
                if (p == 0) outp[i].x = w; else if (p == 1) outp[i].y = w; else if (p == 2) outp[i].z = w; else outp[i].w = w; }
        }
        const int cbk = (t0 >> 3) ^ (lane & 15);
#pragma unroll
        for (int i = 0; i < 8; ++i) *(MK_LAS u32x4*)(lds + (8 * lane + i) * 256 + cbk * 16) = outp[i];
    }
    __syncthreads();
    const int h = wave, n = lane & 15, q = lane >> 4;
    for (int nh = 0; nh < 2; ++nh) {
        u32x2 uw[4][4], gw[4][4];
#pragma unroll
        for (int nt = 0; nt < 4; ++nt) { const size_t row = (size_t)(brow0 + 16 * (nh * 4 + nt) + n);
#pragma unroll
            for (int mt = 0; mt < 4; ++mt) { const int ch = h * 64 + 16 * mt + 4 * q; uw[nt][mt] = *(const u32x2*)(z + row * NB + 1536 + ch); gw[nt][mt] = *(const u32x2*)(z + row * NB + 2560 + ch); } }
        f32x4 acc[4][4];
#pragma unroll
        for (int mt = 0; mt < 4; ++mt)
#pragma unroll
            for (int nt = 0; nt < 4; ++nt) acc[mt][nt] = (f32x4){0.f, 0.f, 0.f, 0.f};
#pragma unroll
        for (int ks = 0; ks < 4; ++ks) {
            if (2 * ks <= nh * 4 + 3) {
                bf16x8 a[4];
#pragma unroll
                for (int mt = 0; mt < 4; ++mt) { const int row = h * 64 + 16 * mt + n; a[mt] = *(const MK_LAS bf16x8*)(lds + row * 256 + (((4 * ks + q) ^ ((row >> 3) & 15)) * 16)); }
#pragma unroll
                for (int nt = 0; nt < 4; ++nt) {
                    const int ntg = nh * 4 + nt;
                    if (2 * ks <= ntg) {
                        const bf16x8 b = *(const bf16x8*)(WsM + ((size_t)h * 128 + 16 * ntg + n) * 128 + 32 * ks + 8 * q);
#pragma unroll
                        for (int mt = 0; mt < 4; ++mt) acc[mt][nt] = __builtin_amdgcn_mfma_f32_16x16x32_bf16(a[mt], b, acc[mt][nt], 0, 0, 0);
                    }
                }
            }
        }
#pragma unroll
        for (int nt = 0; nt < 4; ++nt) {
            const int t = 16 * (nh * 4 + nt) + n; const size_t row = (size_t)(brow0 + t); const float bsv = bs[h * 128 + t];
#pragma unroll
            for (int mt = 0; mt < 4; ++mt) {
                const int ch = h * 64 + 16 * mt + 4 * q;
                const u32x2 u2 = uw[nt][mt], g2 = gw[nt][mt];
                const float o0 = gelu_silu_(bflo(u2.x), bflo(g2.x)) * (acc[mt][nt][0] + bsv);
                const float o1 = gelu_silu_(bfhi(u2.x), bfhi(g2.x)) * (acc[mt][nt][1] + bsv);
                const float o2 = gelu_silu_(bflo(u2.y), bflo(g2.y)) * (acc[mt][nt][2] + bsv);
                const float o3 = gelu_silu_(bfhi(u2.y), bfhi(g2.y)) * (acc[mt][nt][3] + bsv);
                u32x2 w; w.x = pk2(o0, o1); w.y = pk2(o2, o3); *(u32x2*)(y + row * D + 512 + ch) = w;
            }
        }
    }
    __syncthreads();
}

__device__ __forceinline__ MK_LAS unsigned short* c_elem(MK_LAS unsigned char* lds, int r, int c) { return (MK_LAS unsigned short*)(lds + r * 1024 + ((((c >> 3) ^ (r & 15))) * 16) + (c & 7) * 2); }
template <int G>
__device__ __forceinline__ void odd_c_pool(MK_LAS unsigned char* lds, int c_, bool seqstart) {
    int c = c_; asm volatile("" : "+v"(c));
    constexpr int WIN = 2 << G;
    float ring[WIN]; float sum = 0.f;
#pragma unroll
    for (int i = 0; i < WIN; ++i) ring[i] = 0.f;
#pragma unroll
    for (int h = 16 - WIN; h < 15; ++h) {
        const float v = seqstart ? 0.f : bf2f(*c_elem(lds, h, c));
        sum += v; ring[(h + 1) % WIN] = v; }
#pragma unroll 1
    for (int t0 = 0; t0 < 128; t0 += 16) {
#pragma unroll
        for (int i = 0; i < 16; ++i) {
            const int tt = t0 + i; MK_LAS unsigned short* p = c_elem(lds, tt + 15, c);
            const float v = bf2f(*p);
            sum += v - ring[i % WIN]; ring[i % WIN] = v;
            const float inv = (seqstart && tt < WIN) ? 1.0f / (float)(tt + 1) : 1.0f / (float)WIN;
            *p = f2bf(sum * inv - v);
        }
    }
}
template <int G>
__device__ __forceinline__ void odd_c_mma(const bf16_t* z, bf16_t* y, const float* pscale, const MK_LAS unsigned char* lds, int srow0, int half, int n_, int q_, const bf16x8 (&afr)[8][4]) {
    int n = n_, q = q_; asm volatile("" : "+v"(n), "+v"(q));
#pragma unroll 1
    for (int tl = 0; tl < 4; ++tl) {
        const int tloc = (half * 4 + tl) * 16 + n, row = srow0 + tloc, r = tloc + 15;
        u32x2 gwd[8];
#pragma unroll
        for (int mt = 0; mt < 8; ++mt) gwd[mt] = *(const u32x2*)(z + (size_t)row * NB + 512 + G * 128 + 16 * mt + 4 * q);
        f32x4 acc[8];
#pragma unroll
        for (int mt = 0; mt < 8; ++mt) acc[mt] = (f32x4){0.f, 0.f, 0.f, 0.f};
#pragma unroll
        for (int ks = 0; ks < 4; ++ks) {
            const bf16x8 bfrag = *(const MK_LAS bf16x8*)(lds + r * 1024 + (((G * 16 + 4 * ks + q) ^ (r & 15)) * 16));
#pragma unroll
            for (int mt = 0; mt < 8; ++mt) acc[mt] = __builtin_amdgcn_mfma_f32_16x16x32_bf16(afr[mt][ks], bfrag, acc[mt], 0, 0, 0);
        }
#pragma unroll
        for (int mt = 0; mt < 8; ++mt) {
            const int ch = G * 128 + 16 * mt + 4 * q;
            const f32x4 ps = *(const f32x4*)(pscale + ch);
            u32x2 w; w.x = pk2(acc[mt][0] * ps[0] * siluf_(bflo(gwd[mt].x)), acc[mt][1] * ps[1] * siluf_(bfhi(gwd[mt].x)));
            w.y = pk2(acc[mt][2] * ps[2] * siluf_(bflo(gwd[mt].y)), acc[mt][3] * ps[3] * siluf_(bfhi(gwd[mt].y)));
            *(u32x2*)(y + (size_t)row * D + ch) = w;
        }
    }
}
template <int G>
__device__ __forceinline__ void odd_c_group(const bf16_t* z, bf16_t* y, const bf16_t* WpT, const float* pscale, MK_LAS unsigned char* lds, int half, int tid, int n, int q) {
    bf16x8 afr[8][4];
#pragma unroll
    for (int mt = 0; mt < 8; ++mt)
#pragma unroll
        for (int ks = 0; ks < 4; ++ks) afr[mt][ks] = *(const bf16x8*)(WpT + ((size_t)G * 128 + 16 * mt + n) * 128 + 32 * ks + 8 * q);
    for (int run = blockIdx.x; run < M / 256; run += gridDim.x) {
        for (int sub = 0; sub < 2; ++sub) {
            const int srow0 = run * 256 + sub * 128;
            { int tl_ = tid; asm volatile("" : "+v"(tl_)); const int bk = tl_ & 63, r8 = tl_ >> 6;
#pragma unroll
              for (int hb = 0; hb < 3; ++hb) {
                  u32x4 st[6];
#pragma unroll
                  for (int i = 0; i < 6; ++i) { const int r = (hb * 6 + i) * 8 + r8; int grow = srow0 - 15 + (r < 143 ? r : 142); grow = grow < 0 ? 0 : grow; st[i] = *(const u32x4*)(z + (size_t)grow * NB + 8 * bk); }
#pragma unroll
                  for (int i = 0; i < 6; ++i) { const int r = (hb * 6 + i) * 8 + r8; if (r < 143) *(MK_LAS u32x4*)(lds + r * 1024 + ((bk ^ (r & 15)) * 16)) = st[i]; }
                  asm volatile("" ::: "memory");
              } }
            __syncthreads();
            odd_c_pool<G>(lds, tid, (srow0 & (SEQ - 1)) == 0);
            __syncthreads();
            odd_c_mma<G>(z, y, pscale, lds, srow0, half, n, q, afr);
            __syncthreads();
        }
    }
}
__device__ __forceinline__ void unpack8(const u32x4 w, float (&f)[8]) { f[0] = bflo(w.x); f[1] = bfhi(w.x); f[2] = bflo(w.y); f[3] = bfhi(w.y); f[4] = bflo(w.z); f[5] = bfhi(w.z); f[6] = bflo(w.w); f[7] = bfhi(w.w); }
__device__ __forceinline__ void odd_mixer(const bf16_t* z, bf16_t* y, const bf16_t* WpT  , const float* pscale, const float* cdw  , MK_LAS unsigned char* lds) {
    int tid_ = threadIdx.x; asm volatile("" : "+v"(tid_));
    const int tid = tid_, lane = tid & 63, wave = __builtin_amdgcn_readfirstlane(tid >> 6);
    const int n = lane & 15, q = lane >> 4;
    { const int g = wave >> 1, half = wave & 1;
      if (g == 0) odd_c_group<0>(z, y, WpT, pscale, lds, half, tid, n, q);
      else if (g == 1) odd_c_group<1>(z, y, WpT, pscale, lds, half, tid, n, q);
      else if (g == 2) odd_c_group<2>(z, y, WpT, pscale, lds, half, tid, n, q);
      else odd_c_group<3>(z, y, WpT, pscale, lds, half, tid, n, q); }
    const int c8 = lane * 8;
    f32x4 wa[3], wb[3];
#pragma unroll
    for (int k = 0; k < 3; ++k) { wa[k] = *(const f32x4*)(cdw + k * WB + c8); wb[k] = *(const f32x4*)(cdw + k * WB + c8 + 4); }
    for (int run = blockIdx.x; run < M / 256; run += gridDim.x) {
        const int r0 = run * 256 + 32 * wave, pos = r0 & (SEQ - 1);
        const bf16_t* zr = z + (size_t)r0 * NB + c8;
        float pm1[8], pm2[8];
        { const int bk = pos > 0 ? 1 : 0;
          const u32x4 d1 = *(const u32x4*)(zr - (ptrdiff_t)bk * NB + 1024), d2 = *(const u32x4*)(zr - (ptrdiff_t)(2 * bk) * NB + 1024);
          float a[8]; unpack8(d1, a);
#pragma unroll
          for (int e = 0; e < 8; ++e) pm1[e] = bk ? a[e] : 0.f;
          unpack8(d2, a);
#pragma unroll
          for (int e = 0; e < 8; ++e) pm2[e] = bk ? a[e] : 0.f; }
        for (int i0 = 0; i0 < 32; i0 += 4) {
            u32x4 dd[4], db[4];
#pragma unroll
            for (int i = 0; i < 4; ++i) { const bf16_t* p = zr + (size_t)(i0 + i) * NB; dd[i] = *(const u32x4*)(p + 1024); db[i] = *(const u32x4*)(p + 1536); }
#pragma unroll
            for (int i = 0; i < 4; ++i) {
                float pc[8], dbf[8], o[8]; unpack8(dd[i], pc); unpack8(db[i], dbf);
#pragma unroll
                for (int e = 0; e < 8; ++e) {
                    const float w0 = e < 4 ? wa[0][e & 3] : wb[0][e & 3], w1 = e < 4 ? wa[1][e & 3] : wb[1][e & 3], w2 = e < 4 ? wa[2][e & 3] : wb[2][e & 3];
                    const float conv = w0 * pm2[e] + w1 * pm1[e] + w2 * pc[e];
                    o[e] = dbf[e] * conv; pm2[e] = pm1[e]; pm1[e] = pc[e]; }
                u32x4 ow; ow.x = pk2(o[0], o[1]); ow.y = pk2(o[2], o[3]); ow.z = pk2(o[4], o[5]); ow.w = pk2(o[6], o[7]);
                *(u32x4*)(y + (size_t)(r0 + i0 + i) * D + 512 + c8) = ow;
            }
        }
    }
}

__global__ void __launch_bounds__(512) fwd_megakernel(Params P, int ph_lo, int ph_hi) {
    extern __shared__ __attribute__((aligned(16))) unsigned char lds_raw[];
    MK_LAS unsigned char* lds = (MK_LAS unsigned char*)lds_raw;
    cg::grid_group grid = cg::this_grid();
    if (threadIdx.x == 0) { ((MK_LAS unsigned*)(lds + LDS_BYTES - 16))[0] = 0u; ((MK_LAS unsigned*)(lds + LDS_BYTES - 16))[1] = 0u; }
    __syncthreads();
    const XcdBarrier xbar = xcd_barrier_post((unsigned*)(P.ws + WS_BAR), (volatile LAS unsigned*)(lds + LDS_BYTES - 16));
    int ph = 0;
#define MK_IN() (ph_lo <= ph && ph < ph_hi)
#define MK_STAGGER(ticks) do { if ((ticks) > 0 && ((blockIdx.x >> 3) & 1)) { const unsigned long long t0_ = __builtin_amdgcn_s_memrealtime(); while (__builtin_amdgcn_s_memrealtime() - t0_ < (unsigned long long)(ticks)) __builtin_amdgcn_s_sleep(16); } } while (0)
#define MK_SEAM() do { if (ph_lo <= ph && ph + 1 < ph_hi) { for (int r_ = 0; r_ < REP_SYNC; ++r_) { if (ph_hi < 0) grid.sync(); else xcd_barrier(xbar); } } ++ph; } while (0)
    if (MK_IN()) { for (int r0_ = 0; r0_ < REP_P0; ++r0_) { p0_prologue(P, lds); __syncthreads(); } }
    MK_SEAM();
#pragma clang loop unroll(disable)
    for (int l0 = 0; l0 < DEPTH; ++l0) {
#define MK_LAUNDER() int l = l0; asm volatile("" : "+s"(l)); const int j = l >> 1; const bool odd = l & 1; unsigned char* ws = P.ws; asm volatile("" : "+s"(ws)); bf16_t* xcur = (bf16_t*)(ws + WS_XB); bf16_t* tbuf = (bf16_t*)(ws + WS_XB) + (size_t)M * D; bf16_t* z = (bf16_t*)(ws + WS_Z); bf16_t* yb = (bf16_t*)(ws + WS_Y); bf16_t* ple = (bf16_t*)(ws + WS_Z);
        if (MK_IN()) { MK_LAUNDER()
            pg8::Gemm g{xcur, (const bf16_t*)(ws + WS_WIN) + (size_t)l * NB * D, M, NB, D}; pg8::StaticOrder S; S.init(M, NB, (int)gridDim.x, (int)blockIdx.x);
            { const float* bsrc = (odd ? P.in[15] : P.in[3]) + (size_t)j * NB; MK_LAS float* lb = (MK_LAS float*)(lds + 131072);
              int ti_ = threadIdx.x; asm volatile("" : "+v"(ti_));
              for (int i = ti_; i < NB; i += NTHREADS) lb[i] = bsrc[odd ? orig_col_odd(i) : i];
              __syncthreads(); }
            EpiZ E{z, NB, (const MK_LAS float*)(lds + 131072), odd ? 1 : 0};
            MK_STAGGER(STAG1);
            for (int rep = 0; rep < REP_P1; ++rep) pg8::gemm_phase<EpiZ, pg8::StaticOrder, MK_ALIGN_EPI, MK_SP2>(lds, g, S, E);
        }
        MK_SEAM();
        if (MK_IN()) { MK_LAUNDER()
            for (int rep = 0; rep < (odd ? REP_P2O : REP_P2E); ++rep)
            if (!odd) {
                for (int run = blockIdx.x; run < M / 256; run += gridDim.x) {
                    for (int ra = 0; ra < REP_A; ++ra) even_a_branch(z, yb, P.in[4] + (size_t)j * 31 * WB, P.in[5] + j * WB, P.in[6] + j * WB, P.in[7] + j * WB, run, lds);
                    __syncthreads();
                    for (int bb = 0; bb < 2; ++bb)
                        even_b_block(z, yb, P.in[8] + j * WB, P.in[9] + j * WB, (const bf16_t*)(ws + WS_WS) + (size_t)j * 8 * 128 * 128, P.in[11] + j * 8 * 128, run * 2 + bb, lds);
                }
            } else {
                odd_mixer(z, yb, (const bf16_t*)(ws + WS_WP) + (size_t)j * 4 * 128 * 128, P.in[17] + j * WB, P.in[18] + (size_t)j * 3 * WB, lds);
            }
        }
        MK_SEAM();
        if (MK_IN()) { MK_LAUNDER()
            { pg8::Gemm g{yb, (const bf16_t*)(ws + WS_WOUT) + (size_t)l * D * D, M, D, D}; pg8::StaticOrder S; S.init(M, D, (int)gridDim.x, (int)blockIdx.x);
              MK_STAGGER(STAG3);
              EpiT E{xcur, tbuf, (odd ? P.in[20] : P.in[13]) + (size_t)j * D, (float*)(ws + WS_STATS)};
#if REP_K3
              { EpiNull EN; pg8::gemm_phase<EpiNull, pg8::StaticOrder, MK_ALIGN_EPI, MK_SP2>(lds, g, S, EN); }
#endif
              pg8::gemm_phase<EpiT, pg8::StaticOrder, MK_ALIGN_EPI, MK_SP2>(lds, g, S, E); }
            { pg8::Gemm g{(const bf16_t*)(ws + WS_PB) + (size_t)l * M * DP, (const bf16_t*)(ws + WS_WPLE) + (size_t)l * D * DP, M, D, DP}; pg8::StaticOrder S; S.init(M, D, (int)gridDim.x, (int)blockIdx.x);
              EpiZ E{ple, D, nullptr, 0};
              for (int rp_ = 0; rp_ < REP_PLE; ++rp_) pg8::gemm_phase<EpiZ, pg8::StaticOrder, MK_ALIGN_EPI, MK_SP2>(lds, g, S, E); }
        }
        MK_SEAM();
        if (MK_IN()) { MK_LAUNDER()
            pg8::Gemm g{tbuf, (const bf16_t*)(ws + WS_WGATE) + (size_t)l * D * D, M, D, D}; pg8::StaticOrder S; S.init(M, D, (int)gridDim.x, (int)blockIdx.x);
            const float* c12 = (const float*)(ws + WS_C12) + (size_t)l * 2 * D;
            { int ti_ = threadIdx.x; asm volatile("" : "+v"(ti_)); MK_LAS float* lvw = (MK_LAS float*)(lds + 131072);
              const float* lg_ = P.in[21] + (size_t)l * D; const float* lb_ = P.in[22] + (size_t)l * D;
              for (int i = ti_; i < 1024; i += NTHREADS) { const int vec = i >> 8, idx = (i & 255) * 4; const float* src = vec == 0 ? lg_ : vec == 1 ? lb_ : vec == 2 ? c12 : c12 + D;
                  *(MK_LAS f32x4*)(lvw + vec * 1024 + idx) = *(const f32x4*)(src + idx); }
              __syncthreads(); }
            MK_STAGGER(STAG5);
            EpiGate2 E{tbuf, ple, xcur, (l == DEPTH - 1) ? P.out : nullptr, (const float*)(ws + WS_STATS), (const MK_LAS float*)(lds + 131072)};
            for (int r5_ = 0; r5_ < REP_P5; ++r5_) pg8::gemm_phase<EpiGate2, pg8::StaticOrder, MK_ALIGN_EPI, MK_SP2>(lds, g, S, E);
        }
        MK_SEAM();
    }
#undef MK_IN
#undef MK_LAUNDER
#undef MK_SEAM
}
}

extern "C" void kernel_launch(void* const* d_in, const int* in_sizes, int n_in, void* d_out, int out_size, void* d_ws, size_t ws_size, hipStream_t stream) {
    static int ready = 0;
    if (!ready) {
        if (n_in != 26 || out_size != mk::M * mk::D || ws_size < mk::WS_END) { fprintf(stderr, "kernel_launch: unexpected shapes (n_in %d out %d ws %zu need %zu)\n", n_in, out_size, ws_size, (size_t)mk::WS_END); }
        if (hipFuncSetAttribute((const void*)mk::fwd_megakernel, hipFuncAttributeMaxDynamicSharedMemorySize, mk::LDS_BYTES) != hipSuccess) fprintf(stderr, "kernel_launch: hipFuncSetAttribute failed\n");
        ready = 1;
    }
    (void)hipMemsetAsync((unsigned char*)d_ws + mk::WS_BAR, 0, (size_t)XCD_BAR_WORDS * 4, stream);
    mk::Params P{};
    for (int i = 0; i < 26; ++i) P.in[i] = (const float*)d_in[i];
    P.out = (float*)d_out; P.ws = (unsigned char*)d_ws;
    int lo = 0, hi = 1 + 4 * mk::DEPTH;
    void* args[] = {&P, &lo, &hi};
    hipError_t e = hipLaunchCooperativeKernel((const void*)mk::fwd_megakernel, dim3(256), dim3(mk::NTHREADS), args, mk::LDS_BYTES, stream);
    if (e != hipSuccess) fprintf(stderr, "cooperative launch failed: %s\n", hipGetErrorString(e));
}
```

```cpp
#include <hip/hip_runtime.h>
#include <hip/hip_cooperative_groups.h>
#include <cstdio>
namespace cg = cooperative_groups;
#ifndef MK_WGM
#define MK_WGM 8
#endif

#define XB_TMO      128
#define XB_XCNT(j)  (256  + 64 * (j))
#define XB_XSUB(j)  (1280 + 64 * (j))
#define XB_XGEN(j)  (2304 + 64 * (j))
#define XB_TOP      3328
#define XB_TOPGEN   3392
#define XCD_BAR_WORDS 3456
#define XB_SPIN_CAP (1u << 18)
#define LAS __attribute__((address_space(3)))

__device__ __forceinline__ unsigned xb_ld(unsigned* p)              { return __hip_atomic_load(p, __ATOMIC_RELAXED, __HIP_MEMORY_SCOPE_AGENT); }
__device__ __forceinline__ unsigned xb_add(unsigned* p, unsigned v) { return __hip_atomic_fetch_add(p, v, __ATOMIC_RELAXED, __HIP_MEMORY_SCOPE_AGENT); }
__device__ __forceinline__ unsigned xb_xcc_id() { return (unsigned)__builtin_amdgcn_s_getreg((3 << 11) | 20) & 0xFu; }
#define XB_SPIN(cond, bar) do { unsigned _sp = 0; while (cond) { __builtin_amdgcn_s_sleep(1); \
    if ((++_sp & 255u) == 0u) { if (xb_ld(&(bar)[XB_TMO])) break; if (_sp > XB_SPIN_CAP) { atomicAdd(&(bar)[XB_TMO], 1u); break; } } } } while (0)

struct XcdBarrier {
    unsigned* bar; unsigned x;
    volatile LAS unsigned* st;
};

__device__ __forceinline__ XcdBarrier xcd_barrier_post(unsigned* bar, volatile LAS unsigned* st) {
    XcdBarrier b; b.bar = bar; b.x = xb_xcc_id(); b.st = st;
    if (threadIdx.x == 0) (void)xb_add(&bar[XB_XCNT(b.x)], 1u);
    return b;
}
__device__ __forceinline__ void xcd_barrier_complete(unsigned* bar, unsigned x, unsigned& nloc, unsigned& nx) {
    const unsigned G = gridDim.x * gridDim.y * gridDim.z;
    unsigned sum, cnt, mine, sp = 0u;
    for (;;) {
        sum = 0u; cnt = 0u; mine = 0u;
#pragma unroll
        for (unsigned j = 0; j < 16; ++j) { const unsigned c = xb_ld(&bar[XB_XCNT(j)]); sum += c; cnt += (c > 0u) ? 1u : 0u; mine = (j == x) ? c : mine; }
        if (sum == G) break;
        __builtin_amdgcn_s_sleep(1);
        if ((++sp & 255u) == 0u) { if (xb_ld(&bar[XB_TMO])) break; if (sp > XB_SPIN_CAP) { atomicAdd(&bar[XB_TMO], 1u); break; } }
    }
    nloc = mine > 0u ? mine : 1u; nx = cnt > 0u ? cnt : 1u;
}

__device__ __forceinline__ void xcd_barrier(const XcdBarrier& b) {
    asm volatile("s_waitcnt vmcnt(0)" ::: "memory");
    __syncthreads();
    if (threadIdx.x == 0) {
        unsigned* bar = b.bar;
        __builtin_amdgcn_s_waitcnt(0);
        unsigned nloc = b.st[0], nx = b.st[1];
        if (nloc == 0u) { xcd_barrier_complete(bar, b.x, nloc, nx); b.st[0] = nloc; b.st[1] = nx; }
        const unsigned old = xb_add(&bar[XB_XSUB(b.x)], 1u);
        const unsigned gen = old / nloc;
        if (old + 1u == (gen + 1u) * nloc) {
            __builtin_amdgcn_fence(__ATOMIC_RELEASE, "agent");
            asm volatile("s_waitcnt vmcnt(0)" ::: "memory");
            const unsigned og = xb_add(&bar[XB_TOP], 1u);
            const unsigned tg = og / nx;
            if (og + 1u == (tg + 1u) * nx) xb_add(&bar[XB_TOPGEN], 1u);
            else XB_SPIN(xb_ld(&bar[XB_TOPGEN]) == tg, bar);
            __builtin_amdgcn_fence(__ATOMIC_ACQUIRE, "agent");
            xb_add(&bar[XB_XGEN(b.x)], 1u);
            asm volatile("s_waitcnt vmcnt(0)" ::: "memory");
        } else {
            XB_SPIN(xb_ld(&bar[XB_XGEN(b.x)]) == gen, bar);
            __builtin_amdgcn_fence(__ATOMIC_ACQUIRE, "agent");
            asm volatile("s_waitcnt vmcnt(0)" ::: "memory");
        }
    }
    __syncthreads();
}
namespace pg8 {
#define PG8_LAS __attribute__((address_space(3)))
typedef unsigned short bf16_t;
typedef short bf16x8 __attribute__((ext_vector_type(8)));
typedef float f32x4 __attribute__((ext_vector_type(4)));
typedef unsigned u32x4 __attribute__((ext_vector_type(4)));
constexpr int BM = 256, BK = 64, HALF = 128, HTB = HALF * BK * 2  , STAGE_BYTES = 8 * HTB, NXCD = 8, WGM = MK_WGM;

__host__ __device__ __forceinline__ int lds_byte(int r, int c) { const int st = (r >> 4) * 2 + (c >> 5), rr = r & 15, cc = c & 31, ob = rr * 64 + cc * 2; return st * 1024 + (ob ^ (((ob >> 9) & 1) << 5)); }
__host__ __device__ __forceinline__ void stage_rc(int b, int& R, int& C) { const int st = b / 1024, sb = b % 1024, swz = sb ^ (((sb >> 9) & 1) << 5); R = (st >> 1) * 16 + swz / 64; C = (st & 1) * 32 + (swz % 64) / 2; }
__host__ __device__ __forceinline__ int perm32(int rho) { const int n = rho >> 4, i = rho & 15; return 8 * (i >> 2) + 4 * n + (i & 3); }

struct Unit { int pm, pn; };
struct Gemm { const bf16_t* A; const bf16_t* Bt; int M, N, K; };

struct StaticOrder {
    int nM, nN, nwg, G, c;
    __host__ __device__ void init(int M, int N, int G_, int c_) { nM = M / BM; nN = N / BM; nwg = nM * nN; G = G_; c = c_; }
    __host__ __device__ bool next(int i, Unit& u) const {
        const long L = (long)i * G + c; if (L >= nwg) return false;
        int wgid = (int)L; { const int q = nwg / NXCD, r = nwg % NXCD, xcd = wgid % NXCD, off = wgid / NXCD; wgid = (xcd < r ? xcd * (q + 1) : r * (q + 1) + (xcd - r) * q) + off; }
        const int nig = WGM * nN, gid = wgid / nig, fm = gid * WGM, gsz = (nM - fm) < WGM ? (nM - fm) : WGM;
        u.pm = fm + ((wgid % nig) % gsz); u.pn = (wgid % nig) / gsz; return true;
    }
    __device__ __forceinline__ void a_ready(const Unit&) const {}
    __device__ __forceinline__ void done(const Unit&) const {}
};
__device__ __forceinline__ unsigned cvt_pk_bf16(float lo, float hi) { unsigned r; asm volatile("v_cvt_pk_bf16_f32 %0, %1, %2" : "=v"(r) : "v"(lo), "v"(hi)); return r; }
typedef float f32x2 __attribute__((ext_vector_type(2)));
__device__ __forceinline__ f32x2 gelu_pk(f32x2 v) {
    const f32x2 av = __builtin_elementwise_abs(v), d = av * 0.2316418882f + 1.0f;
    f32x2 t; t.x = __builtin_amdgcn_rcpf(d.x); t.y = __builtin_amdgcn_rcpf(d.y);
    f32x2 q = t * 0.5307027145f + (-0.7265760135f); q = q * t + 0.7107068705f; q = q * t + (-0.142248368f); q = q * t + 0.127414796f; q = q * t;
    const f32x2 s = (v * v) * (-0.72134752044f);
    f32x2 e; e.x = __builtin_amdgcn_exp2f(s.x); e.y = __builtin_amdgcn_exp2f(s.y);
    const f32x2 m = v * (q * e), r = v - m;
    f32x2 o; o.x = v.x < 0.f ? m.x : r.x; o.y = v.y < 0.f ? m.y : r.y; return o;
}

struct EpiF32 {
    static constexpr bool PERM = false, AFTER_DRAIN = false;
    float* C; int ldc; const float* bias;
    __device__ __forceinline__ void operator()(const f32x4 (&acc)[2][2][4][2], const Unit& u, int wr, int wc, int fr, int fq) const {
        const int row0 = u.pm * BM + wr * 64 + fr, col0 = u.pn * BM + wc * 32 + 4 * fq;
        f32x4 bv[2][2];
#pragma unroll
        for (int bj = 0; bj < 2; ++bj)
#pragma unroll
            for (int n = 0; n < 2; ++n) bv[bj][n] = bias ? *(const f32x4*)(bias + col0 + bj * HALF + n * 16) : (f32x4){0.f, 0.f, 0.f, 0.f};
#pragma unroll
        for (int ai = 0; ai < 2; ++ai)
#pragma unroll
            for (int m = 0; m < 4; ++m) { float* rowp = C + (size_t)(row0 + ai * HALF + m * 16) * ldc + col0;
#pragma unroll
                for (int bj = 0; bj < 2; ++bj)
#pragma unroll
                    for (int n = 0; n < 2; ++n) *(f32x4*)(rowp + bj * HALF + n * 16) = acc[ai][bj][m][n] + bv[bj][n]; }
    }
};
template <int ACT  > struct EpiBf16 {
    static constexpr bool PERM = true, AFTER_DRAIN = false;
    bf16_t* O; int ldc; const float* bias; int split_cols; size_t split_stride;
    __device__ __forceinline__ void operator()(const f32x4 (&acc)[2][2][4][2], const Unit& u, int wr, int wc, int fr, int fq) const {
        const int row0 = u.pm * BM + wr * 64 + fr; int colt = u.pn * BM; bf16_t* base = O;
        if (split_cols) { const int t = colt / split_cols; base += (size_t)t * split_stride; colt -= t * split_cols; }
        const int col0 = colt + wc * 32 + 8 * fq, bcol0 = u.pn * BM + wc * 32 + 8 * fq;
        f32x4 bv[2][2];
#pragma unroll
        for (int bj = 0; bj < 2; ++bj)
#pragma unroll
            for (int n = 0; n < 2; ++n) bv[bj][n] = bias ? *(const f32x4*)(bias + bcol0 + bj * HALF + 4 * n) : (f32x4){0.f, 0.f, 0.f, 0.f};
#pragma unroll
        for (int ai = 0; ai < 2; ++ai)
#pragma unroll
            for (int m = 0; m < 4; ++m) { bf16_t* rowp = base + (size_t)(row0 + ai * HALF + m * 16) * ldc + col0;
#pragma unroll
                for (int bj = 0; bj < 2; ++bj) { f32x4 v0 = acc[ai][bj][m][0] + bv[bj][0], v1 = acc[ai][bj][m][1] + bv[bj][1];
                    if (ACT == 1) { f32x2 a = gelu_pk((f32x2){v0[0], v0[1]}), b = gelu_pk((f32x2){v0[2], v0[3]}), c = gelu_pk((f32x2){v1[0], v1[1]}), d = gelu_pk((f32x2){v1[2], v1[3]});
                        v0 = (f32x4){a.x, a.y, b.x, b.y}; v1 = (f32x4){c.x, c.y, d.x, d.y}; }
                    if (ACT == 2) {
#pragma unroll
                        for (int j = 0; j < 4; ++j) { v0[j] = 0.5f * v0[j] * (1.0f + erff(v0[j] * 0.70710678f)); v1[j] = 0.5f * v1[j] * (1.0f + erff(v1[j] * 0.70710678f)); } }
                    u32x4 w; w.x = cvt_pk_bf16(v0[0], v0[1]); w.y = cvt_pk_bf16(v0[2], v0[3]); w.z = cvt_pk_bf16(v1[0], v1[1]); w.w = cvt_pk_bf16(v1[2], v1[3]);
                    *(u32x4*)(rowp + bj * HALF) = w; } }
    }
};
template <class Epi, class Sched, bool ALIGN_EPI = false, bool SP2 = false>
__device__ __forceinline__ void gemm_phase(PG8_LAS unsigned char* lds, const Gemm g, const Sched& S, const Epi& E) {
    int tid_ = threadIdx.x; asm volatile("" : "+v"(tid_));
    const int tid = tid_, wid = __builtin_amdgcn_readfirstlane(tid >> 6), lane = tid & 63, wr = wid >> 2, wc = wid & 3, fr = lane & 15, fq = lane >> 4;
    const int K = g.K, nt = K / BK;
    unsigned voffA[2], voffB[2];
#pragma unroll
    for (int i = 0; i < 2; ++i) { int R, C; stage_rc(tid * 16 + i * 8192, R, C); const int Rb = Epi::PERM ? ((R & ~31) + perm32(R & 31)) : R;
        voffA[i] = (unsigned)(R * K + C) * 2u; voffB[i] = (unsigned)(Rb * K + C) * 2u; }
    const size_t kstep = (size_t)(BK * 2);
    const size_t hstep = (size_t)HALF * K * 2;
    const size_t tstep = 2 * hstep;
    const unsigned ldsw = (unsigned)wid * 1024u;
    const int aoff = lds_byte(wr * 64 + fr, fq * 8), boff = lds_byte(wc * 32 + fr, fq * 8);
#define PG8_SA(b, h) (((b) * 2 + (h)) * HTB)
#define PG8_SB(b, h) ((4 + (b) * 2 + (h)) * HTB)
#define PG8_STAGE(bufoff, gbase, voff) do { _Pragma("unroll") for (int _i = 0; _i < 2; ++_i) \
        __builtin_amdgcn_global_load_lds((const unsigned*)((const char*)(gbase) + (voff)[_i]), (PG8_LAS unsigned*)(lds + (bufoff) + ldsw + _i * 8192), 16, 0, 0); } while (0)
#define PG8_LDA(dst, b, h) do { _Pragma("unroll") for (int m = 0; m < 4; ++m) _Pragma("unroll") for (int k = 0; k < 2; ++k) dst[m][k] = *(const PG8_LAS bf16x8*)(lds + PG8_SA(b, h) + aoff + m * 2048 + k * 1024); } while (0)
#define PG8_LDB(dst, b, h) do { _Pragma("unroll") for (int n = 0; n < 2; ++n) _Pragma("unroll") for (int k = 0; k < 2; ++k) dst[n][k] = *(const PG8_LAS bf16x8*)(lds + PG8_SB(b, h) + boff + n * 2048 + k * 1024); } while (0)
#define PG8_MMA(ai, bj, At, Bt) do { __builtin_amdgcn_s_setprio(1); _Pragma("unroll") for (int m = 0; m < 4; ++m) _Pragma("unroll") for (int n = 0; n < 2; ++n) _Pragma("unroll") for (int k = 0; k < 2; ++k) \
        acc[ai][bj][m][n] = __builtin_amdgcn_mfma_f32_16x16x32_bf16(Bt[n][k], At[m][k], acc[ai][bj][m][n], 0, 0, 0); __builtin_amdgcn_s_setprio(0); } while (0)
#define PG8_WAIT_V(n) asm volatile("s_waitcnt vmcnt(" #n ")" ::: "memory")
#define PG8_WAIT_L(n) asm volatile("s_waitcnt lgkmcnt(" #n ")" ::: "memory")
#define PG8_BAR __builtin_amdgcn_s_barrier()
#define PG8_SCHED __builtin_amdgcn_sched_barrier(0)
    Unit cur, nxt; int ui = 0;
    if (!S.next(0, cur)) return;
    f32x4 acc[2][2][4][2];
#pragma unroll
    for (int a = 0; a < 2; ++a)
#pragma unroll
        for (int b = 0; b < 2; ++b)
#pragma unroll
            for (int m = 0; m < 4; ++m)
#pragma unroll
                for (int n = 0; n < 2; ++n) acc[a][b][m][n] = (f32x4){0.f, 0.f, 0.f, 0.f};
    bf16x8 At[4][2], B0[2][2], B1[2][2];
    const char* cA = (const char*)g.A + (size_t)cur.pm * tstep; const char* cB = (const char*)g.Bt + (size_t)cur.pn * tstep;
    S.a_ready(cur);
    if constexpr (SP2) {
        PG8_STAGE(PG8_SB(0, 0), cB, voffB); PG8_STAGE(PG8_SB(0, 1), cB + hstep, voffB); PG8_STAGE(PG8_SA(0, 0), cA, voffA); PG8_STAGE(PG8_SA(0, 1), cA + hstep, voffA);
        if (wr == 1) PG8_BAR;
        PG8_WAIT_V(2); PG8_BAR;
        PG8_STAGE(PG8_SB(1, 0), cB + kstep, voffB); PG8_STAGE(PG8_SA(1, 0), cA + kstep, voffA); PG8_STAGE(PG8_SB(1, 1), cB + hstep + kstep, voffB);
        PG8_WAIT_V(6); PG8_BAR;
    } else {
        PG8_STAGE(PG8_SB(0, 0), cB, voffB); PG8_STAGE(PG8_SA(0, 0), cA, voffA); PG8_STAGE(PG8_SB(0, 1), cB + hstep, voffB); PG8_STAGE(PG8_SA(0, 1), cA + hstep, voffA);
        if (wr == 1) PG8_BAR;
        PG8_WAIT_V(4); PG8_BAR;
        PG8_STAGE(PG8_SB(1, 0), cB + kstep, voffB); PG8_STAGE(PG8_SA(1, 0), cA + kstep, voffA); PG8_STAGE(PG8_SB(1, 1), cB + hstep + kstep, voffB);
        PG8_WAIT_V(6); PG8_BAR;
    }
    for (;;) {
        const bool has_next = S.next(ui + 1, nxt);
        const char* nA = has_next ? (const char*)g.A + (size_t)nxt.pm * tstep : cA; const char* nB = has_next ? (const char*)g.Bt + (size_t)nxt.pn * tstep : cB;
        for (int t = 0; t < nt; t += 2) {
            const bool last = (t == nt - 2);
            const char* a1 = cA + (size_t)(t + 1) * kstep;
            const char* a2 = last ? nA : cA + (size_t)(t + 2) * kstep; const char* b2 = last ? nB : cB + (size_t)(t + 2) * kstep;
            const char* a3 = a2 + kstep; const char* b3 = b2 + kstep;
            if (last && has_next) S.a_ready(nxt);
            if constexpr (SP2) {
            PG8_LDB(B0, 0, 0); PG8_LDB(B1, 0, 1); PG8_SCHED; PG8_LDA(At, 0, 0); PG8_STAGE(PG8_SA(1, 1), a1 + hstep, voffA);
            PG8_WAIT_V(8); PG8_WAIT_L(0); PG8_BAR; PG8_MMA(0, 0, At, B0); PG8_MMA(0, 1, At, B1); PG8_BAR; PG8_SCHED;
            PG8_LDA(At, 0, 1); PG8_STAGE(PG8_SB(0, 0), b2, voffB); PG8_STAGE(PG8_SB(0, 1), b2 + hstep, voffB); PG8_STAGE(PG8_SA(0, 0), a2, voffA);
            PG8_WAIT_V(8); PG8_WAIT_L(0); PG8_BAR; PG8_MMA(1, 0, At, B0); PG8_MMA(1, 1, At, B1); PG8_BAR; PG8_SCHED;
            PG8_LDB(B0, 1, 0); PG8_LDB(B1, 1, 1); PG8_SCHED; PG8_LDA(At, 1, 0); PG8_STAGE(PG8_SA(0, 1), a2 + hstep, voffA);
            PG8_WAIT_V(8); PG8_WAIT_L(0); PG8_BAR; PG8_MMA(0, 0, At, B0); PG8_MMA(0, 1, At, B1); PG8_BAR; PG8_SCHED;
            PG8_LDA(At, 1, 1); PG8_STAGE(PG8_SB(1, 0), b3, voffB); PG8_STAGE(PG8_SB(1, 1), b3 + hstep, voffB); PG8_STAGE(PG8_SA(1, 0), a3, voffA);
            PG8_WAIT_V(8); PG8_WAIT_L(0); PG8_BAR; PG8_MMA(1, 0, At, B0); PG8_MMA(1, 1, At, B1); PG8_BAR; PG8_SCHED;
            } else {
            PG8_LDB(B0, 0, 0); PG8_SCHED; PG8_LDA(At, 0, 0); PG8_STAGE(PG8_SA(1, 1), a1 + hstep, voffA);
            PG8_WAIT_L(8); PG8_BAR; PG8_WAIT_L(0); PG8_MMA(0, 0, At, B0); PG8_BAR; PG8_SCHED;
            PG8_LDB(B1, 0, 1); PG8_STAGE(PG8_SB(0, 0), b2, voffB);
            PG8_BAR; PG8_WAIT_L(0); PG8_MMA(0, 1, At, B1); PG8_BAR;
            PG8_LDA(At, 0, 1); PG8_STAGE(PG8_SA(0, 0), a2, voffA);
            PG8_BAR; PG8_WAIT_L(0); PG8_MMA(1, 0, At, B0); PG8_BAR; PG8_SCHED;
            PG8_STAGE(PG8_SB(0, 1), b2 + hstep, voffB);
            PG8_WAIT_V(6); PG8_BAR; PG8_MMA(1, 1, At, B1); PG8_BAR;
            PG8_LDB(B0, 1, 0); PG8_SCHED; PG8_LDA(At, 1, 0); PG8_STAGE(PG8_SA(0, 1), a2 + hstep, voffA);
            PG8_WAIT_L(8); PG8_BAR; PG8_WAIT_L(0); PG8_MMA(0, 0, At, B0); PG8_BAR; PG8_SCHED;
            PG8_LDB(B1, 1, 1); PG8_STAGE(PG8_SB(1, 0), b3, voffB);
            PG8_BAR; PG8_WAIT_L(0); PG8_MMA(0, 1, At, B1); PG8_BAR;
            PG8_LDA(At, 1, 1); PG8_STAGE(PG8_SA(1, 0), a3, voffA);
            PG8_BAR; PG8_WAIT_L(0); PG8_MMA(1, 0, At, B0); PG8_BAR; PG8_SCHED;
            PG8_STAGE(PG8_SB(1, 1), b3 + hstep, voffB);
            PG8_WAIT_V(6); PG8_BAR; PG8_MMA(1, 1, At, B1); PG8_BAR;
            }
        }
        if constexpr (ALIGN_EPI) { if (wr == 0) PG8_BAR; }
        if constexpr (!Epi::AFTER_DRAIN) { E(acc, cur, wr, wc, fr, fq); S.done(cur); }
        if (!has_next) break;
#pragma unroll
        for (int a = 0; a < 2; ++a)
#pragma unroll
            for (int b = 0; b < 2; ++b)
#pragma unroll
                for (int m = 0; m < 4; ++m)
#pragma unroll
                    for (int n = 0; n < 2; ++n) acc[a][b][m][n] = (f32x4){0.f, 0.f, 0.f, 0.f};
        cur = nxt; cA = nA; cB = nB; ++ui;
        if constexpr (ALIGN_EPI) { if (wr == 1) PG8_BAR; }
    }
    PG8_WAIT_V(0);
    if constexpr (!ALIGN_EPI) { if (wr == 0) PG8_BAR; }
    PG8_BAR;
    if constexpr (Epi::AFTER_DRAIN) { E.fused(acc, cur, wr, wc, fr, fq, lds, wid, lane); S.done(cur); }
#undef PG8_SA
#undef PG8_SB
#undef PG8_STAGE
#undef PG8_LDA
#undef PG8_LDB
#undef PG8_MMA
#undef PG8_WAIT_V
#undef PG8_WAIT_L
#undef PG8_BAR
#undef PG8_SCHED
}
}

#ifndef REP_SYNC
#define REP_SYNC 1
#endif
#ifndef REP_P1
#define REP_P1 1
#endif
#ifndef MK_ALIGN_EPI
#define MK_ALIGN_EPI true
#endif
#ifndef MK_SP2
#define MK_SP2 true
#endif
#ifndef NT_Z
#define NT_Z 0
#endif
#ifndef STAG1
#define STAG1 0
#endif
#ifndef STAG3
#define STAG3 0
#endif
#ifndef STAG5
#define STAG5 0
#endif
#ifndef REP_K3
#define REP_K3 0
#endif
#ifndef REP_P0
#define REP_P0 1
#endif
#ifndef REP_PLE
#define REP_PLE 1
#endif
#ifndef REP_P5
#define REP_P5 1
#endif
#ifndef REP_A
#define REP_A 1
#endif
#ifndef REP_P2E
#define REP_P2E 1
#endif
#ifndef REP_P2O
#define REP_P2O 1
#endif
namespace mk {
using pg8::bf16_t; using pg8::bf16x8; using pg8::f32x4; using pg8::u32x4;
typedef unsigned u32x2 __attribute__((ext_vector_type(2)));
typedef float f32x2 __attribute__((ext_vector_type(2)));
typedef short bf16x4 __attribute__((ext_vector_type(4)));
#define MK_LAS __attribute__((address_space(3)))
constexpr int M = 65536, D = 1024, NB = 3072, DP = 256, SEQ = 4096, WB = 512, DEPTH = 4;
constexpr float LN_EPS = 1e-5f;
constexpr float ALPHA = 1.681792830507429f;
constexpr int NTHREADS = 512, NWAVES = 8;
constexpr int LDS_BYTES = 147520;
constexpr int LDS_RED = 139264;
constexpr int VT_STRIDE = 132;
constexpr size_t WS_WIN = 0;
constexpr size_t WS_WOUT = WS_WIN + (size_t)4 * NB * D * 2;
constexpr size_t WS_WGATE = WS_WOUT + (size_t)4 * D * D * 2;
constexpr size_t WS_WPLE = WS_WGATE + (size_t)4 * D * D * 2;
constexpr size_t WS_WS = WS_WPLE + (size_t)4 * D * DP * 2;
constexpr size_t WS_WP = WS_WS + (size_t)2 * 8 * 128 * 128 * 2;
constexpr size_t WS_XB = WS_WP + (size_t)2 * 4 * 128 * 128 * 2;
constexpr size_t WS_PB = WS_XB + (size_t)2 * M * D * 2;
constexpr size_t WS_Z = WS_PB + (size_t)4 * M * DP * 2;
constexpr size_t WS_Y = WS_Z + (size_t)M * NB * 2;
constexpr size_t WS_STATS = WS_Y + (size_t)M * D * 2;
constexpr size_t WS_C12 = WS_STATS + (size_t)M * 16 * 2 * 4;
constexpr size_t WS_BAR = WS_C12 + (size_t)4 * 2 * D * 4;
constexpr size_t WS_END = WS_BAR + (size_t)XCD_BAR_WORDS * 4;

struct Params { const float* in[26]; float* out; unsigned char* ws; };

__device__ __forceinline__ float bf2f(unsigned short b) { return __uint_as_float((unsigned)b << 16); }
__device__ __forceinline__ float bflo(unsigned w) { return __uint_as_float(w << 16); }
__device__ __forceinline__ float bfhi(unsigned w) { return __uint_as_float(w & 0xffff0000u); }
__device__ __forceinline__ unsigned short f2bf(float f) { unsigned u = __float_as_uint(f); u += 0x7FFFu + ((u >> 16) & 1u); return (unsigned short)(u >> 16); }
__device__ __forceinline__ unsigned pk2(float lo, float hi) { return pg8::cvt_pk_bf16(lo, hi); }
__device__ __forceinline__ float sigmoidf_(float x) { return __builtin_amdgcn_rcpf(1.0f + __expf(-x)); }
__device__ __forceinline__ float siluf_(float x) { return x * sigmoidf_(x); }
__device__ __forceinline__ float geluf_(float x) { return x * sigmoidf_(1.5957691216057308f * (x + 0.044715f * x * x * x)); }
__device__ __forceinline__ float silu2_(float a, float b) { return (a * b) * __builtin_amdgcn_rcpf((1.0f + __expf(-a)) * (1.0f + __expf(-b))); }
__device__ __forceinline__ float gelu_silu_(float u, float g) { return (u * g) * __builtin_amdgcn_rcpf((1.0f + __expf(-1.5957691216057308f * (u + 0.044715f * u * u * u))) * (1.0f + __expf(-g))); }
template <int CTRL> __device__ __forceinline__ float dpp_f(float v) { return __builtin_bit_cast(float, __builtin_amdgcn_update_dpp(0, __builtin_bit_cast(int, v), CTRL, 0xf, 0xf, false)); }
__device__ __forceinline__ float wave_sum(float v) {
    v += dpp_f<0x128>(v); v += dpp_f<0x124>(v); v += dpp_f<0x122>(v); v += dpp_f<0x121>(v);
    const int vi = __builtin_bit_cast(int, v);
    const float r0 = __builtin_bit_cast(float, __builtin_amdgcn_readlane(vi, 0)), r1 = __builtin_bit_cast(float, __builtin_amdgcn_readlane(vi, 16));
    const float r2 = __builtin_bit_cast(float, __builtin_amdgcn_readlane(vi, 32)), r3 = __builtin_bit_cast(float, __builtin_amdgcn_readlane(vi, 48));
    return (r0 + r1) + (r2 + r3);
}

struct EpiNull {
    static constexpr bool PERM = true, AFTER_DRAIN = false;
    __device__ __forceinline__ void operator()(const f32x4 (&acc)[2][2][4][2], const pg8::Unit&, int, int, int, int) const {
#pragma unroll
        for (int a = 0; a < 2; ++a)
#pragma unroll
            for (int b = 0; b < 2; ++b)
#pragma unroll
                for (int m = 0; m < 4; ++m)
#pragma unroll
                    for (int n = 0; n < 2; ++n) asm volatile("" :: "v"(acc[a][b][m][n]));
    }
};
struct EpiZ {
    static constexpr bool PERM = true, AFTER_DRAIN = false;
    bf16_t* O; int ld; const MK_LAS float* lbias; int oddmode;
    __device__ __forceinline__ void operator()(const f32x4 (&acc)[2][2][4][2], const pg8::Unit& u, int wr, int wc, int fr, int fq) const {
        const int row0 = u.pm * 256 + wr * 64 + fr, col0 = u.pn * 256 + wc * 64 + 16 * fq;
        f32x4 bv[2][2];
#pragma unroll
        for (int bj = 0; bj < 2; ++bj)
#pragma unroll
            for (int n = 0; n < 2; ++n) bv[bj][n] = lbias ? *(const MK_LAS f32x4*)(lbias + col0 + 8 * bj + 4 * n) : (f32x4){0.f, 0.f, 0.f, 0.f};
        if (oddmode == 1 && u.pn >= 4) {
            const bool gate = u.pn < 8;
            const int scol = gate ? 1536 + ((col0 - 1024) >> 1) : 1024 + ((col0 - 2048) >> 1);
#pragma unroll
            for (int ai = 0; ai < 2; ++ai)
#pragma unroll
                for (int m = 0; m < 4; ++m) { bf16_t* rowp = O + (size_t)(row0 + ai * 128 + m * 16) * ld + scol;
                    f32x4 y0 = acc[ai][1][m][0] + bv[1][0], y1 = acc[ai][1][m][1] + bv[1][1];
                    if (gate) {
#pragma unroll
                        for (int e = 0; e < 4; ++e) { y0[e] = siluf_(y0[e]); y1[e] = siluf_(y1[e]); } }
                    const f32x4 v0 = (acc[ai][0][m][0] + bv[0][0]) * y0, v1 = (acc[ai][0][m][1] + bv[0][1]) * y1;
                    u32x4 w; w.x = pg8::cvt_pk_bf16(v0[0], v0[1]); w.y = pg8::cvt_pk_bf16(v0[2], v0[3]); w.z = pg8::cvt_pk_bf16(v1[0], v1[1]); w.w = pg8::cvt_pk_bf16(v1[2], v1[3]);
                    *(u32x4*)rowp = w; }
            return;
        }
        if (oddmode == 2 && u.pn >= 8) {
            const int pcol = 1536 + ((col0 - 2048) >> 1);
#pragma unroll
            for (int ai = 0; ai < 2; ++ai)
#pragma unroll
                for (int m = 0; m < 4; ++m) { bf16_t* rowp = O + (size_t)(row0 + ai * 128 + m * 16) * ld + pcol;
                    const f32x4 x0 = acc[ai][0][m][0] + bv[0][0], x1 = acc[ai][0][m][1] + bv[0][1], y0 = acc[ai][1][m][0] + bv[1][0], y1 = acc[ai][1][m][1] + bv[1][1];
                    u32x4 w; w.x = pg8::cvt_pk_bf16(gelu_silu_(x0[0], y0[0]), gelu_silu_(x0[1], y0[1])); w.y = pg8::cvt_pk_bf16(gelu_silu_(x0[2], y0[2]), gelu_silu_(x0[3], y0[3]));
                    w.z = pg8::cvt_pk_bf16(gelu_silu_(x1[0], y1[0]), gelu_silu_(x1[1], y1[1])); w.w = pg8::cvt_pk_bf16(gelu_silu_(x1[2], y1[2]), gelu_silu_(x1[3], y1[3]));
                    *(u32x4*)rowp = w; }
            return;
        }
        const int scol = col0 + ((oddmode == 2 && u.pn >= 6) ? 512 : 0);
#pragma unroll
        for (int ai = 0; ai < 2; ++ai)
#pragma unroll
            for (int m = 0; m < 4; ++m) { bf16_t* rowp = O + (size_t)(row0 + ai * 128 + m * 16) * ld + scol;
#pragma unroll
                for (int bj = 0; bj < 2; ++bj) { const f32x4 v0 = acc[ai][bj][m][0] + bv[bj][0], v1 = acc[ai][bj][m][1] + bv[bj][1];
                    u32x4 w; w.x = pg8::cvt_pk_bf16(v0[0], v0[1]); w.y = pg8::cvt_pk_bf16(v0[2], v0[3]); w.z = pg8::cvt_pk_bf16(v1[0], v1[1]); w.w = pg8::cvt_pk_bf16(v1[2], v1[3]);
                    *(u32x4*)(rowp + bj * 8) = w; } }
    }
};
struct EpiT {
    static constexpr bool PERM = true, AFTER_DRAIN = false;
    const bf16_t* xs; bf16_t* xt; const float* bias; float* stats;
    __device__ __forceinline__ void operator()(const f32x4 (&acc)[2][2][4][2], const pg8::Unit& u, int wr, int wc, int fr, int fq) const {
        const int row0 = u.pm * 256 + wr * 64 + fr, col0 = u.pn * 256 + wc * 64 + 16 * fq;
        f32x4 bv[2][2];
#pragma unroll
        for (int bj = 0; bj < 2; ++bj)
#pragma unroll
            for (int n = 0; n < 2; ++n) bv[bj][n] = *(const f32x4*)(bias + col0 + 8 * bj + 4 * n);
        u32x4 xr[4][2];
#pragma unroll
        for (int g = 0; g < 4; ++g) { const bf16_t* p = xs + (size_t)(row0 + g * 16) * D + col0; xr[g][0] = *(const u32x4*)p; xr[g][1] = *(const u32x4*)(p + 8); }
#pragma unroll
        for (int g = 0; g < 8; ++g) {
            const int ai = g >> 2, m = g & 3, row = row0 + ai * 128 + m * 16; bf16_t* p = xt + (size_t)row * D + col0;
            const u32x4 xc0 = xr[g & 3][0], xc1 = xr[g & 3][1];
            if (g < 4) { const bf16_t* pn = xs + (size_t)(row0 + 128 + g * 16) * D + col0; xr[g][0] = *(const u32x4*)pn; xr[g][1] = *(const u32x4*)(pn + 8); }
            float s = 0.f, s2 = 0.f;
#pragma unroll
            for (int bj = 0; bj < 2; ++bj) { const u32x4 x4 = bj ? xc1 : xc0;
                const f32x4 v0 = acc[ai][bj][m][0] + bv[bj][0] + (f32x4){bflo(x4.x), bfhi(x4.x), bflo(x4.y), bfhi(x4.y)} * ALPHA;
                const f32x4 v1 = acc[ai][bj][m][1] + bv[bj][1] + (f32x4){bflo(x4.z), bfhi(x4.z), bflo(x4.w), bfhi(x4.w)} * ALPHA;
                u32x4 w; w.x = pg8::cvt_pk_bf16(v0[0], v0[1]); w.y = pg8::cvt_pk_bf16(v0[2], v0[3]); w.z = pg8::cvt_pk_bf16(v1[0], v1[1]); w.w = pg8::cvt_pk_bf16(v1[2], v1[3]);
                *(u32x4*)(p + bj * 8) = w;
                const float r0 = bflo(w.x), r1 = bfhi(w.x), r2 = bflo(w.y), r3 = bfhi(w.y), r4 = bflo(w.z), r5 = bfhi(w.z), r6 = bflo(w.w), r7 = bfhi(w.w);
                s += ((r0 + r1) + (r2 + r3)) + ((r4 + r5) + (r6 + r7));
                s2 += ((r0 * r0 + r1 * r1) + (r2 * r2 + r3 * r3)) + ((r4 * r4 + r5 * r5) + (r6 * r6 + r7 * r7)); }
            s += __shfl_xor(s, 16); s += __shfl_xor(s, 32); s2 += __shfl_xor(s2, 16); s2 += __shfl_xor(s2, 32);
            if (fq == 0) *(f32x2*)(stats + ((size_t)(u.pn * 4 + wc) * M + row) * 2) = (f32x2){s, s2};
        }
    }
};
struct EpiGate2 {
    static constexpr bool PERM = true, AFTER_DRAIN = false;
    const bf16_t* tb; const bf16_t* ple; bf16_t* xo; float* fo; const float* stats; const MK_LAS float* lv;
    __device__ __forceinline__ void operator()(const f32x4 (&acc)[2][2][4][2], const pg8::Unit& u, int wr, int wc, int fr, int fq) const {
        const int row0 = u.pm * 256 + wr * 64 + fr, col0 = u.pn * 256 + wc * 64 + 16 * fq;
        f32x4 sa[2], sb[2]; u32x4 tw[2][2], pw[2][2];
        { const float* sp = stats + ((size_t)(fq * 4) * M + row0) * 2; const f32x2 q0 = *(const f32x2*)sp, q1 = *(const f32x2*)(sp + (size_t)2 * M), q2 = *(const f32x2*)(sp + (size_t)4 * M), q3 = *(const f32x2*)(sp + (size_t)6 * M); sa[0] = (f32x4){q0.x, q0.y, q1.x, q1.y}; sb[0] = (f32x4){q2.x, q2.y, q3.x, q3.y};
          const size_t o = (size_t)row0 * D + col0; tw[0][0] = *(const u32x4*)(tb + o); tw[0][1] = *(const u32x4*)(tb + o + 8); pw[0][0] = *(const u32x4*)(ple + o); pw[0][1] = *(const u32x4*)(ple + o + 8); }
#pragma unroll
        for (int g = 0; g < 8; ++g) {
            const int ai = g >> 2, m = g & 3, row = row0 + ai * 128 + m * 16, cur = g & 1;
            if (g < 7) { const int g1 = g + 1, nb = g1 & 1, rown = row0 + (g1 >> 2) * 128 + (g1 & 3) * 16;
                const float* sp = stats + ((size_t)(fq * 4) * M + rown) * 2; const f32x2 q0 = *(const f32x2*)sp, q1 = *(const f32x2*)(sp + (size_t)2 * M), q2 = *(const f32x2*)(sp + (size_t)4 * M), q3 = *(const f32x2*)(sp + (size_t)6 * M); sa[nb] = (f32x4){q0.x, q0.y, q1.x, q1.y}; sb[nb] = (f32x4){q2.x, q2.y, q3.x, q3.y};
                const size_t o = (size_t)rown * D + col0; tw[nb][0] = *(const u32x4*)(tb + o); tw[nb][1] = *(const u32x4*)(tb + o + 8); pw[nb][0] = *(const u32x4*)(ple + o); pw[nb][1] = *(const u32x4*)(ple + o + 8); }
            float mu, rs;
            { const f32x4 a = sa[cur], b = sb[cur];
              float s = (a[0] + a[2]) + (b[0] + b[2]), s2 = (a[1] + a[3]) + (b[1] + b[3]);
              s += __shfl_xor(s, 16); s += __shfl_xor(s, 32); s2 += __shfl_xor(s2, 16); s2 += __shfl_xor(s2, 32);
              mu = s * (1.f / D); const float var = s2 * (1.f / D) - mu * mu; rs = 1.f / sqrtf(fmaxf(var, 0.f) + LN_EPS); }
#pragma unroll
            for (int bj = 0; bj < 2; ++bj) {
                const int c = col0 + bj * 8; const size_t o = (size_t)row * D + c;
                const u32x4 t4 = tw[cur][bj], p4 = pw[cur][bj];
                f32x4 x[2];
#pragma unroll
                for (int n = 0; n < 2; ++n) {
                    const f32x4 gv = *(const MK_LAS f32x4*)(lv + c + 4 * n), bb = *(const MK_LAS f32x4*)(lv + 1024 + c + 4 * n), c1v = *(const MK_LAS f32x4*)(lv + 2048 + c + 4 * n), c2v = *(const MK_LAS f32x4*)(lv + 3072 + c + 4 * n);
                    const unsigned ta = n ? t4.z : t4.x, tbw = n ? t4.w : t4.y, pa = n ? p4.z : p4.x, pb2 = n ? p4.w : p4.y;
                    const f32x4 tv = (f32x4){bflo(ta), bfhi(ta), bflo(tbw), bfhi(tbw)}, pv = (f32x4){bflo(pa), bfhi(pa), bflo(pb2), bfhi(pb2)};
                    const f32x4 gp = (acc[ai][bj][m][n] - c1v * mu) * rs + c2v;
                    const f32x4 h = (tv - mu) * rs * gv + bb;
#pragma unroll
                    for (int e = 0; e < 4; ++e) x[n][e] = h[e] + sigmoidf_(gp[e]) * pv[e];
                }
                if (fo) { *(f32x4*)(fo + o) = x[0]; *(f32x4*)(fo + o + 4) = x[1]; }
                else { u32x4 w; w.x = pg8::cvt_pk_bf16(x[0][0], x[0][1]); w.y = pg8::cvt_pk_bf16(x[0][2], x[0][3]); w.z = pg8::cvt_pk_bf16(x[1][0], x[1][1]); w.w = pg8::cvt_pk_bf16(x[1][2], x[1][3]); *(u32x4*)(xo + o) = w; }
            }
        }
    }
};

__device__ __forceinline__ int orig_col_odd(int L) {
    if (L < 1024) return L;
    if (L < 2048) { const int g = (L - 1024) >> 4, e = L & 15; return e < 8 ? 1536 + 8 * g + e : 2560 + 8 * g + (e - 8); }
    const int g = (L - 2048) >> 4, e = L & 15;
    return e < 8 ? 1024 + 8 * g + e : 2048 + 8 * g + (e - 8);
}
__device__ __forceinline__ int orig_col_even(int L) {
    if (L < 1536) return L;
    if (L < 2048) return L + 512;
    const int g = (L - 2048) >> 4, e = L & 15;
    return e < 8 ? 1536 + 8 * g + e : 2560 + 8 * g + (e - 8);
}
__device__ __forceinline__ int phys_row(int L) { const int r = L & 255; return (L & ~255) + 128 * ((r >> 3) & 1) + 32 * (r >> 6) + 8 * ((r >> 4) & 3) + (r & 7); }
__device__ __forceinline__ void p0_transpose_item(const float* W, int K, int N, bf16_t* WT, MK_LAS float* scr, int item, int lane, const float* rowscale = nullptr, bool remap = true, int cmap = 0) {
    const int nblk = N / 32, kb = item / nblk, nb = item % nblk, k0 = 64 * kb, n0 = 32 * nb;
    const int scol = cmap == 1 ? orig_col_odd(n0 + (lane & 31)) : (cmap == 2 ? orig_col_even(n0 + (lane & 31)) : n0 + (lane & 31));
    float wl[32];
#pragma unroll
    for (int i = 0; i < 32; ++i) wl[i] = W[(size_t)(k0 + 2 * i + (lane >> 5)) * N + scol];
#pragma unroll
    for (int i = 0; i < 32; ++i) { const int kk = 2 * i + (lane >> 5); float wv = wl[i]; if (rowscale) wv *= rowscale[k0 + kk]; scr[kk * 33 + (lane & 31)] = wv; }
    asm volatile("s_waitcnt lgkmcnt(0)" ::: "memory");
    const int c = lane & 7;
#pragma unroll
    for (int j = 0; j < 4; ++j) { const int n = (lane >> 3) + 8 * j; const MK_LAS float* s = scr + (8 * c) * 33 + n;
        u32x4 o; o.x = pk2(s[0 * 33], s[1 * 33]); o.y = pk2(s[2 * 33], s[3 * 33]); o.z = pk2(s[4 * 33], s[5 * 33]); o.w = pk2(s[6 * 33], s[7 * 33]);
        *(u32x4*)(WT + (size_t)(remap ? phys_row(n0 + n) : (n0 + n)) * K + k0 + 8 * c) = o; }
    asm volatile("s_waitcnt lgkmcnt(0)" ::: "memory");
}
__device__ __forceinline__ void cvt_rows(const float* src, bf16_t* dst, size_t n8, size_t i0, size_t stride) {
    for (size_t i = i0; i < n8; i += 4 * stride) {
        f32x4 a[4], b[4];
#pragma unroll
        for (int k = 0; k < 4; ++k) { const size_t ii = (i + k * stride < n8) ? i + k * stride : i; a[k] = __builtin_nontemporal_load((const f32x4*)(src + ii * 8)); b[k] = __builtin_nontemporal_load((const f32x4*)(src + ii * 8 + 4)); }
#pragma unroll
        for (int k = 0; k < 4; ++k) { if (i + k * stride < n8) { u32x4 o; o.x = pk2(a[k][0], a[k][1]); o.y = pk2(a[k][2], a[k][3]); o.z = pk2(b[k][0], b[k][1]); o.w = pk2(b[k][2], b[k][3]); *(u32x4*)(dst + (i + k * stride) * 8) = o; } }
    }
}
__device__ __forceinline__ void p0_prologue(const Params& P, MK_LAS unsigned char* lds) {
    int tid_ = threadIdx.x; asm volatile("" : "+v"(tid_));
    const int tid = tid_, lane = tid & 63, wave = tid >> 6;
    MK_LAS float* scr = (MK_LAS float*)(lds + wave * 16384);
    const int gw = blockIdx.x * NWAVES + wave, NGW = gridDim.x * NWAVES;
    unsigned char* ws = P.ws;
    constexpr int I_IN = (D / 64) * (NB / 32), I_SQ = (D / 64) * (D / 32), I_PLE = (DP / 64) * (D / 32), I_POOL = (128 / 64) * (128 / 32);
    constexpr int PER_L = I_IN + 2 * I_SQ + I_PLE, NITEMS = 4 * PER_L + 8 * I_POOL;
    for (int it = gw; it < NITEMS; it += NGW) {
        if (it < 4 * PER_L) {
            const int l = it / PER_L, j = l >> 1; int r = it % PER_L;
            if (r < I_IN) { const float* W = ((l & 1) ? P.in[14] : P.in[2]) + (size_t)j * D * NB; p0_transpose_item(W, D, NB, (bf16_t*)(ws + WS_WIN) + (size_t)l * NB * D, scr, r, lane, nullptr, true, (l & 1) ? 1 : 2); continue; } r -= I_IN;
            if (r < I_SQ) { const float* W = ((l & 1) ? P.in[19] : P.in[12]) + (size_t)j * D * D; p0_transpose_item(W, D, D, (bf16_t*)(ws + WS_WOUT) + (size_t)l * D * D, scr, r, lane); continue; } r -= I_SQ;
            if (r < I_SQ) { p0_transpose_item(P.in[24] + (size_t)l * D * D, D, D, (bf16_t*)(ws + WS_WGATE) + (size_t)l * D * D, scr, r, lane, P.in[21] + (size_t)l * D); continue; } r -= I_SQ;
            p0_transpose_item(P.in[23] + (size_t)l * DP * D, DP, D, (bf16_t*)(ws + WS_WPLE) + (size_t)l * D * DP, scr, r, lane);
        } else {
            const int r = it - 4 * PER_L, mtx = r / I_POOL;
            p0_transpose_item(P.in[16] + (size_t)mtx * 128 * 128, 128, 128, (bf16_t*)(ws + WS_WP) + (size_t)mtx * 128 * 128, scr, r % I_POOL, lane, nullptr, false);
        }
    }
    const size_t gt = (size_t)blockIdx.x * NTHREADS + tid, GT = (size_t)gridDim.x * NTHREADS;
    for (size_t i = gt; i < (size_t)2 * 8 * 128 * 128; i += GT) { const int s = (int)(i & 127), t = (int)((i >> 7) & 127); ((bf16_t*)(ws + WS_WS))[i] = (s <= t) ? f2bf(P.in[10][i]) : (bf16_t)0; }
    cvt_rows(P.in[0], (bf16_t*)(ws + WS_XB), (size_t)M * D / 8, gt, GT);
    cvt_rows(P.in[1], (bf16_t*)(ws + WS_PB), (size_t)4 * M * DP / 8, gt, GT);
    __syncthreads();
    for (int task = blockIdx.x; task < 4 * (D / 16); task += gridDim.x) {
        const int l = task / (D / 16), n = (task % (D / 16)) * 16 + (tid & 15), kg = tid >> 4;
        const float* Wg = P.in[24] + (size_t)l * D * D + n; const float* g = P.in[21] + (size_t)l * D; const float* b = P.in[22] + (size_t)l * D;
        float s1 = 0.f, s2 = 0.f;
#pragma unroll 8
        for (int k = kg * 32; k < kg * 32 + 32; ++k) { const float w = Wg[(size_t)k * D]; s1 += bf2f(f2bf(g[k] * w)); s2 += b[k] * w; }
        MK_LAS float* red = (MK_LAS float*)lds;
        red[tid * 2] = s1; red[tid * 2 + 1] = s2;
        __syncthreads();
        if (tid < 16) { float a1 = 0.f, a2 = 0.f;
            for (int w = 0; w < 32; ++w) { a1 += red[(w * 16 + tid) * 2]; a2 += red[(w * 16 + tid) * 2 + 1]; }
            float* c12 = (float*)(ws + WS_C12) + (size_t)l * 2 * D; c12[n] = a1; c12[D + n] = a2 + P.in[25][(size_t)l * D + n]; }
        __syncthreads();
    }
}

__device__ __forceinline__ void even_a_branch(const bf16_t* z, bf16_t* y, const float* cw, const float* cb, const float* lg, const float* lb, int run, MK_LAS unsigned char* lds) {
    unsigned tid_ = threadIdx.x; asm volatile("" : "+v"(tid_));
    const unsigned tid = tid_, lane = tid & 63u, c = tid; const int wave = __builtin_amdgcn_readfirstlane((int)(tid >> 6));
    MK_LAS float* LA = (MK_LAS float*)lds;
    MK_LAS float* LO = (MK_LAS float*)(lds + 65536);
    float wk[31];
#pragma unroll
    for (int k = 0; k < 31; ++k) wk[k] = (cw + k * WB)[c];
    const float cbv = cb[c];
    const f32x4 g0 = *(const f32x4*)(lg + 8u * lane), g1 = *(const f32x4*)(lg + 8u * lane + 4u), b0 = *(const f32x4*)(lb + 8u * lane), b1 = *(const f32x4*)(lb + 8u * lane + 4u);
    const int row0 = run * 256, pos0 = row0 & (SEQ - 1);
    float win[38];
#pragma unroll
    for (int i = 0; i < 30; ++i) { float v = 0.f;
        if (pos0 - 30 + i >= 0) { const bf16_t* zr = z + (size_t)(row0 - 30 + i) * NB; v = bf2f(zr[c]) * sigmoidf_(bf2f(zr[c + 512u])); }
        win[8 + i] = v; }
    u32x4 rv[4], rg[4];
    { const bf16_t* zw = z + (size_t)(row0 + 4 * wave) * NB;
#pragma unroll
      for (int tt = 0; tt < 4; ++tt) { rv[tt] = *(const u32x4*)(zw + (size_t)tt * NB + 8u * lane); rg[tt] = *(const u32x4*)(zw + (size_t)tt * NB + 512u + 8u * lane); } }
    for (int st = 0; st < 8; ++st) {
        const bf16_t* zst = z + (size_t)(row0 + st * 32 + 4 * wave) * NB;
#pragma unroll
        for (int tt = 0; tt < 4; ++tt) {
            const u32x4 v = rv[tt], g = rg[tt];
            f32x4 a0, a1;
            a0[0] = bflo(v.x) * sigmoidf_(bflo(g.x)); a0[1] = bfhi(v.x) * sigmoidf_(bfhi(g.x)); a0[2] = bflo(v.y) * sigmoidf_(bflo(g.y)); a0[3] = bfhi(v.y) * sigmoidf_(bfhi(g.y));
            a1[0] = bflo(v.z) * sigmoidf_(bflo(g.z)); a1[1] = bfhi(v.z) * sigmoidf_(bfhi(g.z)); a1[2] = bflo(v.w) * sigmoidf_(bflo(g.w)); a1[3] = bfhi(v.w) * sigmoidf_(bfhi(g.w));
            MK_LAS float* p = LA + (4 * wave + tt) * 512 + 8u * lane;
            *(MK_LAS f32x4*)p = a0; *(MK_LAS f32x4*)(p + 4) = a1;
        }
        __syncthreads();
        u32x4 gt[4];
#pragma unroll
        for (int tt = 0; tt < 4; ++tt) gt[tt] = *(const u32x4*)(zst + (size_t)tt * NB + 1024u + 8u * lane);
        if (st < 7) {
#pragma unroll
            for (int tt = 0; tt < 4; ++tt) { rv[tt] = *(const u32x4*)(zst + (size_t)(32 + tt) * NB + 8u * lane); rg[tt] = *(const u32x4*)(zst + (size_t)(32 + tt) * NB + 512u + 8u * lane); }
        }
#pragma unroll
        for (int ch = 0; ch < 4; ++ch) {
#pragma unroll
            for (int i = 0; i < 30; ++i) win[i] = win[i + 8];
#pragma unroll
            for (int i = 0; i < 8; ++i) win[30 + i] = LA[(ch * 8 + i) * 512 + c];
#pragma unroll
            for (int i = 0; i < 8; ++i) { float s = cbv;
#pragma unroll
                for (int k = 0; k < 31; ++k) s += wk[k] * win[i + k];
                LO[(ch * 8 + i) * 512 + c] = s; }
        }
        __syncthreads();
#pragma unroll
        for (int tt = 0; tt < 4; ++tt) {
            const MK_LAS float* p = LO + (4 * wave + tt) * 512 + 8u * lane;
            f32x4 v0 = *(const MK_LAS f32x4*)p, v1 = *(const MK_LAS f32x4*)(p + 4);
            float s = ((v0[0] + v0[1]) + (v0[2] + v0[3])) + ((v1[0] + v1[1]) + (v1[2] + v1[3]));
            float s2 = ((v0[0] * v0[0] + v0[1] * v0[1]) + (v0[2] * v0[2] + v0[3] * v0[3])) + ((v1[0] * v1[0] + v1[1] * v1[1]) + (v1[2] * v1[2] + v1[3] * v1[3]));
            s = wave_sum(s); s2 = wave_sum(s2);
            const float mean = s * (1.f / WB), var = s2 * (1.f / WB) - mean * mean, rstd = 1.f / sqrtf(fmaxf(var, 0.f) + LN_EPS);
            v0 = (v0 - mean) * rstd * g0 + b0; v1 = (v1 - mean) * rstd * g1 + b1;
            const u32x4 g = gt[tt];
            u32x4 o;
            o.x = pk2(silu2_(v0[0], bflo(g.x)), silu2_(v0[1], bfhi(g.x))); o.y = pk2(silu2_(v0[2], bflo(g.y)), silu2_(v0[3], bfhi(g.y)));
            o.z = pk2(silu2_(v1[0], bflo(g.z)), silu2_(v1[1], bfhi(g.z))); o.w = pk2(silu2_(v1[2], bflo(g.w)), silu2_(v1[3], bfhi(g.w)));
            *(u32x4*)(y + (size_t)(row0 + st * 32 + 4 * wave + tt) * D + 8u * lane) = o;
        }
    }
}
__device__ __forceinline__ void even_b_block(const bf16_t* z, bf16_t* y, const float* lvg, const float* lvb, const bf16_t* WsM  , const float* bs  , int blk, MK_LAS unsigned char* lds) {
    int tid_ = threadIdx.x; asm volatile("" : "+v"(tid_));
    const int tid = tid_, lane = tid & 63, wave = __builtin_amdgcn_readfirstlane(tid >> 6);
    const int brow0 = blk * 128;
    const f32x4 g0 = *(const f32x4*)(lvg + 8 * lane), g1 = *(const f32x4*)(lvg + 8 * lane + 4), b0 = *(const f32x4*)(lvb + 8 * lane), b1 = *(const f32x4*)(lvb + 8 * lane + 4);
    for (int grp = 0; grp < 2; ++grp) {
        const int t0 = 16 * wave + 8 * grp;
        const bf16_t* zr = z + (size_t)(brow0 + t0) * NB + 2048 + 8 * lane;
        u32x4 raw[8];
#pragma unroll
        for (int tt = 0; tt < 8; ++tt) raw[tt] = *(const u32x4*)(zr + (size_t)tt * NB);
        u32x4 outp[8];
#pragma unroll
        for (int p = 0; p < 4; ++p) {
            f32x4 va[2][2];
#pragma unroll
            for (int e = 0; e < 2; ++e) { const u32x4 r = raw[2 * p + e];
                f32x4 v0 = (f32x4){geluf_(bflo(r.x)), geluf_(bfhi(r.x)), geluf_(bflo(r.y)), geluf_(bfhi(r.y))}, v1 = (f32x4){geluf_(bflo(r.z)), geluf_(bfhi(r.z)), geluf_(bflo(r.w)), geluf_(bfhi(r.w))};
                float s = ((v0[0] + v0[1]) + (v0[2] + v0[3])) + ((v1[0] + v1[1]) + (v1[2] + v1[3]));
                float s2 = ((v0[0] * v0[0] + v0[1] * v0[1]) + (v0[2] * v0[2] + v0[3] * v0[3])) + ((v1[0] * v1[0] + v1[1] * v1[1]) + (v1[2] * v1[2] + v1[3] * v1[3]));
                s = wave_sum(s); s2 = wave_sum(s2);
                const float mean = s * (1.f / WB), var = s2 * (1.f / WB) - mean * mean, rstd = 1.f / sqrtf(fmaxf(var, 0.f) + LN_EPS);
                va[e][0] = (v0 - mean) * rstd * g0 + b0; va[e][1] = (v1 - mean) * rstd * g1 + b1; }
#pragma unroll
            for (int i = 0; i < 8; ++i) { const unsigned w = pg8::cvt_pk_bf16(va[0][i >> 2][i & 3], va[1][i >> 2][i & 3]);
                if (p == 0) outp[i].x = w; else if (p == 1) outp[i].y = w; else if (p == 2) outp[i].z = w; else outp[i].w = w; }
        }
        const int cbk = (t0 >> 3) ^ (lane & 15);
#pragma unroll
        for (int i = 0; i < 8; ++i) *(MK_LAS u32x4*)(lds + (8 * lane + i) * 256 + cbk * 16) = outp[i];
    }
    __syncthreads();
    const int h = wave, n = lane & 15, q = lane >> 4;
    for (int nh = 0; nh < 2; ++nh) {
        u32x2 uw[4][4];
#pragma unroll
        for (int nt = 0; nt < 4; ++nt) { const size_t row = (size_t)(brow0 + 16 * (nh * 4 + nt) + n);
#pragma unroll
            for (int mt = 0; mt < 4; ++mt) { const int ch = h * 64 + 16 * mt + 4 * q; uw[nt][mt] = *(const u32x2*)(z + row * NB + 1536 + ch); } }
        f32x4 acc[4][4];
#pragma unroll
        for (int mt = 0; mt < 4; ++mt)
#pragma unroll
            for (int nt = 0; nt < 4; ++nt) acc[mt][nt] = (f32x4){0.f, 0.f, 0.f, 0.f};
#pragma unroll
        for (int ks = 0; ks < 4; ++ks) {
            if (2 * ks <= nh * 4 + 3) {
                bf16x8 a[4];
#pragma unroll
                for (int mt = 0; mt < 4; ++mt) { const int row = h * 64 + 16 * mt + n; a[mt] = *(const MK_LAS bf16x8*)(lds + row * 256 + (((4 * ks + q) ^ ((row >> 3) & 15)) * 16)); }
#pragma unroll
                for (int nt = 0; nt < 4; ++nt) {
                    const int ntg = nh * 4 + nt;
                    if (2 * ks <= ntg) {
                        const bf16x8 b = *(const bf16x8*)(WsM + ((size_t)h * 128 + 16 * ntg + n) * 128 + 32 * ks + 8 * q);
#pragma unroll
                        for (int mt = 0; mt < 4; ++mt) acc[mt][nt] = __builtin_amdgcn_mfma_f32_16x16x32_bf16(a[mt], b, acc[mt][nt], 0, 0, 0);
                    }
                }
            }
        }
#pragma unroll
        for (int nt = 0; nt < 4; ++nt) {
            const int t = 16 * (nh * 4 + nt) + n; const size_t row = (size_t)(brow0 + t); const float bsv = bs[h * 128 + t];
#pragma unroll
            for (int mt = 0; mt < 4; ++mt) {
                const int ch = h * 64 + 16 * mt + 4 * q;
                const u32x2 u2 = uw[nt][mt];
                const float o0 = bflo(u2.x) * (acc[mt][nt][0] + bsv), o1 = bfhi(u2.x) * (acc[mt][nt][1] + bsv), o2 = bflo(u2.y) * (acc[mt][nt][2] + bsv), o3 = bfhi(u2.y) * (acc[mt][nt][3] + bsv);
                u32x2 w; w.x = pk2(o0, o1); w.y = pk2(o2, o3); *(u32x2*)(y + row * D + 512 + ch) = w;
            }
        }
    }
    __syncthreads();
}

__device__ __forceinline__ MK_LAS unsigned short* c_elem(MK_LAS unsigned char* lds, int r, int c) { return (MK_LAS unsigned short*)(lds + r * 1024 + ((((c >> 3) ^ (r & 15))) * 16) + (c & 7) * 2); }
template <int G>
__device__ __forceinline__ void odd_c_pool(MK_LAS unsigned char* lds, int c_, bool seqstart) {
    int c = c_; asm volatile("" : "+v"(c));
    constexpr int WIN = 2 << G;
    float ring[WIN]; float sum = 0.f;
#pragma unroll
    for (int i = 0; i < WIN; ++i) ring[i] = 0.f;
#pragma unroll
    for (int h = 16 - WIN; h < 15; ++h) {
        const float v = seqstart ? 0.f : bf2f(*c_elem(lds, h, c));
        sum += v; ring[(h + 1) % WIN] = v; }
#pragma unroll 1
    for (int t0 = 0; t0 < 128; t0 += 16) {
#pragma unroll
        for (int i = 0; i < 16; ++i) {
            const int tt = t0 + i; MK_LAS unsigned short* p = c_elem(lds, tt + 15, c);
            const float v = bf2f(*p);
            sum += v - ring[i % WIN]; ring[i % WIN] = v;
            const float inv = (seqstart && tt < WIN) ? 1.0f / (float)(tt + 1) : 1.0f / (float)WIN;
            *p = f2bf(sum * inv - v);
        }
    }
}
template <int G>
__device__ __forceinline__ void odd_c_mma(const bf16_t* z, bf16_t* y, const float* pscale, const MK_LAS unsigned char* lds, int srow0, int half, int n_, int q_, const bf16x8 (&afr)[8][4]) {
    int n = n_, q = q_; asm volatile("" : "+v"(n), "+v"(q));
#pragma unroll 1
    for (int tl = 0; tl < 4; ++tl) {
        const int tloc = (half * 4 + tl) * 16 + n, row = srow0 + tloc, r = tloc + 15;
        u32x2 gwd[8];
#pragma unroll
        for (int mt = 0; mt < 8; ++mt) gwd[mt] = *(const u32x2*)(z + (size_t)row * NB + 512 + G * 128 + 16 * mt + 4 * q);
        f32x4 acc[8];
#pragma unroll
        for (int mt = 0; mt < 8; ++mt) acc[mt] = (f32x4){0.f, 0.f, 0.f, 0.f};
#pragma unroll
        for (int ks = 0; ks < 4; ++ks) {
            const bf16x8 bfrag = *(const MK_LAS bf16x8*)(lds + r * 1024 + (((G * 16 + 4 * ks + q) ^ (r & 15)) * 16));
#pragma unroll
            for (int mt = 0; mt < 8; ++mt) acc[mt] = __builtin_amdgcn_mfma_f32_16x16x32_bf16(afr[mt][ks], bfrag, acc[mt], 0, 0, 0);
        }
#pragma unroll
        for (int mt = 0; mt < 8; ++mt) {
            const int ch = G * 128 + 16 * mt + 4 * q;
            const f32x4 ps = *(const f32x4*)(pscale + ch);
            u32x2 w; w.x = pk2(acc[mt][0] * ps[0] * siluf_(bflo(gwd[mt].x)), acc[mt][1] * ps[1] * siluf_(bfhi(gwd[mt].x)));
            w.y = pk2(acc[mt][2] * ps[2] * siluf_(bflo(gwd[mt].y)), acc[mt][3] * ps[3] * siluf_(bfhi(gwd[mt].y)));
            *(u32x2*)(y + (size_t)row * D + ch) = w;
        }
    }
}
template <int G>
__device__ __forceinline__ void odd_c_group(const bf16_t* z, bf16_t* y, const bf16_t* WpT, const float* pscale, MK_LAS unsigned char* lds, int half, int tid, int n, int q) {
    bf16x8 afr[8][4];
#pragma unroll
    for (int mt = 0; mt < 8; ++mt)
#pragma unroll
        for (int ks = 0; ks < 4; ++ks) afr[mt][ks] = *(const bf16x8*)(WpT + ((size_t)G * 128 + 16 * mt + n) * 128 + 32 * ks + 8 * q);
    for (int run = blockIdx.x; run < M / 256; run += gridDim.x) {
        for (int sub = 0; sub < 2; ++sub) {
            const int srow0 = run * 256 + sub * 128;
            { int tl_ = tid; asm volatile("" : "+v"(tl_)); const int bk = tl_ & 63, r8 = tl_ >> 6;
#pragma unroll
              for (int hb = 0; hb < 3; ++hb) {
                  u32x4 st[6];
#pragma unroll
                  for (int i = 0; i < 6; ++i) { const int r = (hb * 6 + i) * 8 + r8; int grow = srow0 - 15 + (r < 143 ? r : 142); grow = grow < 0 ? 0 : grow; st[i] = *(const u32x4*)(z + (size_t)grow * NB + 8 * bk); }
#pragma unroll
                  for (int i = 0; i < 6; ++i) { const int r = (hb * 6 + i) * 8 + r8; if (r < 143) *(MK_LAS u32x4*)(lds + r * 1024 + ((bk ^ (r & 15)) * 16)) = st[i]; }
                  asm volatile("" ::: "memory");
              } }
            __syncthreads();
            odd_c_pool<G>(lds, tid, (srow0 & (SEQ - 1)) == 0);
            __syncthreads();
            odd_c_mma<G>(z, y, pscale, lds, srow0, half, n, q, afr);
            __syncthreads();
        }
    }
}
__device__ __forceinline__ void unpack8(const u32x4 w, float (&f)[8]) { f[0] = bflo(w.x); f[1] = bfhi(w.x); f[2] = bflo(w.y); f[3] = bfhi(w.y); f[4] = bflo(w.z); f[5] = bfhi(w.z); f[6] = bflo(w.w); f[7] = bfhi(w.w); }
__device__ __forceinline__ void odd_mixer(const bf16_t* z, bf16_t* y, const bf16_t* WpT  , const float* pscale, const float* cdw  , MK_LAS unsigned char* lds) {
    int tid_ = threadIdx.x; asm volatile("" : "+v"(tid_));
    const int tid = tid_, lane = tid & 63, wave = __builtin_amdgcn_readfirstlane(tid >> 6);
    const int n = lane & 15, q = lane >> 4;
    { const int g = wave >> 1, half = wave & 1;
      if (g == 0) odd_c_group<0>(z, y, WpT, pscale, lds, half, tid, n, q);
      else if (g == 1) odd_c_group<1>(z, y, WpT, pscale, lds, half, tid, n, q);
      else if (g == 2) odd_c_group<2>(z, y, WpT, pscale, lds, half, tid, n, q);
      else odd_c_group<3>(z, y, WpT, pscale, lds, half, tid, n, q); }
    const int c8 = lane * 8;
    f32x4 wa[3], wb[3];
#pragma unroll
    for (int k = 0; k < 3; ++k) { wa[k] = *(const f32x4*)(cdw + k * WB + c8); wb[k] = *(const f32x4*)(cdw + k * WB + c8 + 4); }
    for (int run = blockIdx.x; run < M / 256; run += gridDim.x) {
        const int r0 = run * 256 + 32 * wave, pos = r0 & (SEQ - 1);
        const bf16_t* zr = z + (size_t)r0 * NB + c8;
        float pm1[8], pm2[8];
        { const int bk = pos > 0 ? 1 : 0;
          const u32x4 d1 = *(const u32x4*)(zr - (ptrdiff_t)bk * NB + 1024), d2 = *(const u32x4*)(zr - (ptrdiff_t)(2 * bk) * NB + 1024);
          float a[8]; unpack8(d1, a);
#pragma unroll
          for (int e = 0; e < 8; ++e) pm1[e] = bk ? a[e] : 0.f;
          unpack8(d2, a);
#pragma unroll
          for (int e = 0; e < 8; ++e) pm2[e] = bk ? a[e] : 0.f; }
        for (int i0 = 0; i0 < 32; i0 += 4) {
            u32x4 dd[4], db[4];
#pragma unroll
            for (int i = 0; i < 4; ++i) { const bf16_t* p = zr + (size_t)(i0 + i) * NB; dd[i] = *(const u32x4*)(p + 1024); db[i] = *(const u32x4*)(p + 1536); }
#pragma unroll
            for (int i = 0; i < 4; ++i) {
                float pc[8], dbf[8], o[8]; unpack8(dd[i], pc); unpack8(db[i], dbf);
#pragma unroll
                for (int e = 0; e < 8; ++e) {
                    const float w0 = e < 4 ? wa[0][e & 3] : wb[0][e & 3], w1 = e < 4 ? wa[1][e & 3] : wb[1][e & 3], w2 = e < 4 ? wa[2][e & 3] : wb[2][e & 3];
                    const float conv = w0 * pm2[e] + w1 * pm1[e] + w2 * pc[e];
                    o[e] = dbf[e] * conv; pm2[e] = pm1[e]; pm1[e] = pc[e]; }
                u32x4 ow; ow.x = pk2(o[0], o[1]); ow.y = pk2(o[2], o[3]); ow.z = pk2(o[4], o[5]); ow.w = pk2(o[6], o[7]);
                *(u32x4*)(y + (size_t)(r0 + i0 + i) * D + 512 + c8) = ow;
            }
        }
    }
}

__global__ void __launch_bounds__(512) fwd_megakernel(Params P, int ph_lo, int ph_hi) {
    extern __shared__ __attribute__((aligned(16))) unsigned char lds_raw[];
    MK_LAS unsigned char* lds = (MK_LAS unsigned char*)lds_raw;
    cg::grid_group grid = cg::this_grid();
    if (threadIdx.x == 0) { ((MK_LAS unsigned*)(lds + LDS_BYTES - 16))[0] = 0u; ((MK_LAS unsigned*)(lds + LDS_BYTES - 16))[1] = 0u; }
    __syncthreads();
    const XcdBarrier xbar = xcd_barrier_post((unsigned*)(P.ws + WS_BAR), (volatile LAS unsigned*)(lds + LDS_BYTES - 16));
    int ph = 0;
#define MK_IN() (ph_lo <= ph && ph < ph_hi)
#define MK_STAGGER(ticks) do { if ((ticks) > 0 && ((blockIdx.x >> 3) & 1)) { const unsigned long long t0_ = __builtin_amdgcn_s_memrealtime(); while (__builtin_amdgcn_s_memrealtime() - t0_ < (unsigned long long)(ticks)) __builtin_amdgcn_s_sleep(16); } } while (0)
#define MK_SEAM() do { if (ph_lo <= ph && ph + 1 < ph_hi) { for (int r_ = 0; r_ < REP_SYNC; ++r_) { if (ph_hi < 0) grid.sync(); else xcd_barrier(xbar); } } ++ph; } while (0)
    if (MK_IN()) { for (int r0_ = 0; r0_ < REP_P0; ++r0_) { p0_prologue(P, lds); __syncthreads(); } }
    MK_SEAM();
#pragma clang loop unroll(disable)
    for (int l0 = 0; l0 < DEPTH; ++l0) {
#define MK_LAUNDER() int l = l0; asm volatile("" : "+s"(l)); const int j = l >> 1; const bool odd = l & 1; unsigned char* ws = P.ws; asm volatile("" : "+s"(ws)); bf16_t* xcur = (bf16_t*)(ws + WS_XB); bf16_t* tbuf = (bf16_t*)(ws + WS_XB) + (size_t)M * D; bf16_t* z = (bf16_t*)(ws + WS_Z); bf16_t* yb = (bf16_t*)(ws + WS_Y); bf16_t* ple = (bf16_t*)(ws + WS_Z);
        if (MK_IN()) { MK_LAUNDER()
            pg8::Gemm g{xcur, (const bf16_t*)(ws + WS_WIN) + (size_t)l * NB * D, M, NB, D}; pg8::StaticOrder S; S.init(M, NB, (int)gridDim.x, (int)blockIdx.x);
            { const float* bsrc = (odd ? P.in[15] : P.in[3]) + (size_t)j * NB; MK_LAS float* lb = (MK_LAS float*)(lds + 131072);
              int ti_ = threadIdx.x; asm volatile("" : "+v"(ti_));
              for (int i = ti_; i < NB; i += NTHREADS) lb[i] = bsrc[odd ? orig_col_odd(i) : orig_col_even(i)];
              __syncthreads(); }
            EpiZ E{z, NB, (const MK_LAS float*)(lds + 131072), odd ? 1 : 2};
            MK_STAGGER(STAG1);
            for (int rep = 0; rep < REP_P1; ++rep) pg8::gemm_phase<EpiZ, pg8::StaticOrder, MK_ALIGN_EPI, MK_SP2>(lds, g, S, E);
        }
        MK_SEAM();
        if (MK_IN()) { MK_LAUNDER()
            for (int rep = 0; rep < (odd ? REP_P2O : REP_P2E); ++rep)
            if (!odd) {
                for (int run = blockIdx.x; run < M / 256; run += gridDim.x) {
                    for (int ra = 0; ra < REP_A; ++ra) even_a_branch(z, yb, P.in[4] + (size_t)j * 31 * WB, P.in[5] + j * WB, P.in[6] + j * WB, P.in[7] + j * WB, run, lds);
                    __syncthreads();
                    for (int bb = 0; bb < 2; ++bb)
                        even_b_block(z, yb, P.in[8] + j * WB, P.in[9] + j * WB, (const bf16_t*)(ws + WS_WS) + (size_t)j * 8 * 128 * 128, P.in[11] + j * 8 * 128, run * 2 + bb, lds);
                }
            } else {
                odd_mixer(z, yb, (const bf16_t*)(ws + WS_WP) + (size_t)j * 4 * 128 * 128, P.in[17] + j * WB, P.in[18] + (size_t)j * 3 * WB, lds);
            }
        }
        MK_SEAM();
        if (MK_IN()) { MK_LAUNDER()
            { pg8::Gemm g{yb, (const bf16_t*)(ws + WS_WOUT) + (size_t)l * D * D, M, D, D}; pg8::StaticOrder S; S.init(M, D, (int)gridDim.x, (int)blockIdx.x);
              MK_STAGGER(STAG3);
              EpiT E{xcur, tbuf, (odd ? P.in[20] : P.in[13]) + (size_t)j * D, (float*)(ws + WS_STATS)};
#if REP_K3
              { EpiNull EN; pg8::gemm_phase<EpiNull, pg8::StaticOrder, MK_ALIGN_EPI, MK_SP2>(lds, g, S, EN); }
#endif
              pg8::gemm_phase<EpiT, pg8::StaticOrder, MK_ALIGN_EPI, MK_SP2>(lds, g, S, E); }
            { pg8::Gemm g{(const bf16_t*)(ws + WS_PB) + (size_t)l * M * DP, (const bf16_t*)(ws + WS_WPLE) + (size_t)l * D * DP, M, D, DP}; pg8::StaticOrder S; S.init(M, D, (int)gridDim.x, (int)blockIdx.x);
              EpiZ E{ple, D, nullptr, 0};
              for (int rp_ = 0; rp_ < REP_PLE; ++rp_) pg8::gemm_phase<EpiZ, pg8::StaticOrder, MK_ALIGN_EPI, MK_SP2>(lds, g, S, E); }
        }
        MK_SEAM();
        if (MK_IN()) { MK_LAUNDER()
            pg8::Gemm g{tbuf, (const bf16_t*)(ws + WS_WGATE) + (size_t)l * D * D, M, D, D}; pg8::StaticOrder S; S.init(M, D, (int)gridDim.x, (int)blockIdx.x);
            const float* c12 = (const float*)(ws + WS_C12) + (size_t)l * 2 * D;
            { int ti_ = threadIdx.x; asm volatile("" : "+v"(ti_)); MK_LAS float* lvw = (MK_LAS float*)(lds + 131072);
              const float* lg_ = P.in[21] + (size_t)l * D; const float* lb_ = P.in[22] + (size_t)l * D;
              for (int i = ti_; i < 1024; i += NTHREADS) { const int vec = i >> 8, idx = (i & 255) * 4; const float* src = vec == 0 ? lg_ : vec == 1 ? lb_ : vec == 2 ? c12 : c12 + D;
                  *(MK_LAS f32x4*)(lvw + vec * 1024 + idx) = *(const f32x4*)(src + idx); }
              __syncthreads(); }
            MK_STAGGER(STAG5);
            EpiGate2 E{tbuf, ple, xcur, (l == DEPTH - 1) ? P.out : nullptr, (const float*)(ws + WS_STATS), (const MK_LAS float*)(lds + 131072)};
            for (int r5_ = 0; r5_ < REP_P5; ++r5_) pg8::gemm_phase<EpiGate2, pg8::StaticOrder, MK_ALIGN_EPI, MK_SP2>(lds, g, S, E);
        }
        MK_SEAM();
    }
#undef MK_IN
#undef MK_LAUNDER
#undef MK_SEAM
}
}

extern "C" void kernel_launch(void* const* d_in, const int* in_sizes, int n_in, void* d_out, int out_size, void* d_ws, size_t ws_size, hipStream_t stream) {
    static int ready = 0;
    if (!ready) {
        if (n_in != 26 || out_size != mk::M * mk::D || ws_size < mk::WS_END) { fprintf(stderr, "kernel_launch: unexpected shapes (n_in %d out %d ws %zu need %zu)\n", n_in, out_size, ws_size, (size_t)mk::WS_END); }
        if (hipFuncSetAttribute((const void*)mk::fwd_megakernel, hipFuncAttributeMaxDynamicSharedMemorySize, mk::LDS_BYTES) != hipSuccess) fprintf(stderr, "kernel_launch: hipFuncSetAttribute failed\n");
        ready = 1;
    }
    (void)hipMemsetAsync((unsigned char*)d_ws + mk::WS_BAR, 0, (size_t)XCD_BAR_WORDS * 4, stream);
    mk::Params P{};
    for (int i = 0; i < 26; ++i) P.in[i] = (const float*)d_in[i];
    P.out = (float*)d_out; P.ws = (unsigned char*)d_ws;
    int lo = 0, hi = 1 + 4 * mk::DEPTH;
    void* args[] = {&P, &lo, &hi};
    hipError_t e = hipLaunchCooperativeKernel((const void*)mk::fwd_megakernel, dim3(256), dim3(mk::NTHREADS), args, mk::LDS_BYTES, stream);
    if (e != hipSuccess) fprintf(stderr, "cooperative launch failed: %s\n", hipGetErrorString(e));
}
```

```cpp
#include <hip/hip_runtime.h>
#include <hip/hip_cooperative_groups.h>
#include <cstdio>
namespace cg = cooperative_groups;
#ifndef MK_WGM
#define MK_WGM 8
#endif

#define XB_TMO      128
#define XB_XCNT(j)  (256  + 64 * (j))
#define XB_XSUB(j)  (1280 + 64 * (j))
#define XB_XGEN(j)  (2304 + 64 * (j))
#define XB_TOP      3328
#define XB_TOPGEN   3392
#define XCD_BAR_WORDS 3456
#define XB_SPIN_CAP (1u << 18)
#define LAS __attribute__((address_space(3)))

__device__ __forceinline__ unsigned xb_ld(unsigned* p)              { return __hip_atomic_load(p, __ATOMIC_RELAXED, __HIP_MEMORY_SCOPE_AGENT); }
__device__ __forceinline__ unsigned xb_add(unsigned* p, unsigned v) { return __hip_atomic_fetch_add(p, v, __ATOMIC_RELAXED, __HIP_MEMORY_SCOPE_AGENT); }
__device__ __forceinline__ unsigned xb_xcc_id() { return (unsigned)__builtin_amdgcn_s_getreg((3 << 11) | 20) & 0xFu; }
#define XB_SPIN(cond, bar) do { unsigned _sp = 0; while (cond) { __builtin_amdgcn_s_sleep(1); \
    if ((++_sp & 255u) == 0u) { if (xb_ld(&(bar)[XB_TMO])) break; if (_sp > XB_SPIN_CAP) { atomicAdd(&(bar)[XB_TMO], 1u); break; } } } } while (0)

struct XcdBarrier {
    unsigned* bar; unsigned x;
    volatile LAS unsigned* st;
};

__device__ __forceinline__ XcdBarrier xcd_barrier_post(unsigned* bar, volatile LAS unsigned* st) {
    XcdBarrier b; b.bar = bar; b.x = xb_xcc_id(); b.st = st;
    if (threadIdx.x == 0) (void)xb_add(&bar[XB_XCNT(b.x)], 1u);
    return b;
}
__device__ __forceinline__ void xcd_barrier_complete(unsigned* bar, unsigned x, unsigned& nloc, unsigned& nx) {
    const unsigned G = gridDim.x * gridDim.y * gridDim.z;
    unsigned sum, cnt, mine, sp = 0u;
    for (;;) {
        sum = 0u; cnt = 0u; mine = 0u;
#pragma unroll
        for (unsigned j = 0; j < 16; ++j) { const unsigned c = xb_ld(&bar[XB_XCNT(j)]); sum += c; cnt += (c > 0u) ? 1u : 0u; mine = (j == x) ? c : mine; }
        if (sum == G) break;
        __builtin_amdgcn_s_sleep(1);
        if ((++sp & 255u) == 0u) { if (xb_ld(&bar[XB_TMO])) break; if (sp > XB_SPIN_CAP) { atomicAdd(&bar[XB_TMO], 1u); break; } }
    }
    nloc = mine > 0u ? mine : 1u; nx = cnt > 0u ? cnt : 1u;
}

__device__ __forceinline__ void xcd_barrier(const XcdBarrier& b) {
    asm volatile("s_waitcnt vmcnt(0)" ::: "memory");
    __syncthreads();
    if (threadIdx.x == 0) {
        unsigned* bar = b.bar;
        __builtin_amdgcn_s_waitcnt(0);
        unsigned nloc = b.st[0], nx = b.st[1];
        if (nloc == 0u) { xcd_barrier_complete(bar, b.x, nloc, nx); b.st[0] = nloc; b.st[1] = nx; }
        const unsigned old = xb_add(&bar[XB_XSUB(b.x)], 1u);
        const unsigned gen = old / nloc;
        if (old + 1u == (gen + 1u) * nloc) {
            __builtin_amdgcn_fence(__ATOMIC_RELEASE, "agent");
            asm volatile("s_waitcnt vmcnt(0)" ::: "memory");
            const unsigned og = xb_add(&bar[XB_TOP], 1u);
            const unsigned tg = og / nx;
            if (og + 1u == (tg + 1u) * nx) xb_add(&bar[XB_TOPGEN], 1u);
            else XB_SPIN(xb_ld(&bar[XB_TOPGEN]) == tg, bar);
            __builtin_amdgcn_fence(__ATOMIC_ACQUIRE, "agent");
            xb_add(&bar[XB_XGEN(b.x)], 1u);
            asm volatile("s_waitcnt vmcnt(0)" ::: "memory");
        } else {
            XB_SPIN(xb_ld(&bar[XB_XGEN(b.x)]) == gen, bar);
            __builtin_amdgcn_fence(__ATOMIC_ACQUIRE, "agent");
            asm volatile("s_waitcnt vmcnt(0)" ::: "memory");
        }
    }
    __syncthreads();
}
namespace pg8 {
#define PG8_LAS __attribute__((address_space(3)))
typedef unsigned short bf16_t;
typedef short bf16x8 __attribute__((ext_vector_type(8)));
typedef float f32x4 __attribute__((ext_vector_type(4)));
typedef unsigned u32x4 __attribute__((ext_vector_type(4)));
constexpr int BM = 256, BK = 64, HALF = 128, HTB = HALF * BK * 2  , STAGE_BYTES = 8 * HTB, NXCD = 8, WGM = MK_WGM;

__host__ __device__ __forceinline__ int lds_byte(int r, int c) { const int st = (r >> 4) * 2 + (c >> 5), rr = r & 15, cc = c & 31, ob = rr * 64 + cc * 2; return st * 1024 + (ob ^ (((ob >> 9) & 1) << 5)); }
__host__ __device__ __forceinline__ void stage_rc(int b, int& R, int& C) { const int st = b / 1024, sb = b % 1024, swz = sb ^ (((sb >> 9) & 1) << 5); R = (st >> 1) * 16 + swz / 64; C = (st & 1) * 32 + (swz % 64) / 2; }
__host__ __device__ __forceinline__ int perm32(int rho) { const int n = rho >> 4, i = rho & 15; return 8 * (i >> 2) + 4 * n + (i & 3); }

struct Unit { int pm, pn; };
struct Gemm { const bf16_t* A; const bf16_t* Bt; int M, N, K; };

struct StaticOrder {
    int nM, nN, nwg, G, c;
    __host__ __device__ void init(int M, int N, int G_, int c_) { nM = M / BM; nN = N / BM; nwg = nM * nN; G = G_; c = c_; }
    __host__ __device__ bool next(int i, Unit& u) const {
        const long L = (long)i * G + c; if (L >= nwg) return false;
        int wgid = (int)L; { const int q = nwg / NXCD, r = nwg % NXCD, xcd = wgid % NXCD, off = wgid / NXCD; wgid = (xcd < r ? xcd * (q + 1) : r * (q + 1) + (xcd - r) * q) + off; }
        const int nig = WGM * nN, gid = wgid / nig, fm = gid * WGM, gsz = (nM - fm) < WGM ? (nM - fm) : WGM;
        u.pm = fm + ((wgid % nig) % gsz); u.pn = (wgid % nig) / gsz; return true;
    }
    __device__ __forceinline__ void a_ready(const Unit&) const {}
    __device__ __forceinline__ void done(const Unit&) const {}
};
__device__ __forceinline__ unsigned cvt_pk_bf16(float lo, float hi) { unsigned r; asm volatile("v_cvt_pk_bf16_f32 %0, %1, %2" : "=v"(r) : "v"(lo), "v"(hi)); return r; }
typedef float f32x2 __attribute__((ext_vector_type(2)));
__device__ __forceinline__ f32x2 gelu_pk(f32x2 v) {
    const f32x2 av = __builtin_elementwise_abs(v), d = av * 0.2316418882f + 1.0f;
    f32x2 t; t.x = __builtin_amdgcn_rcpf(d.x); t.y = __builtin_amdgcn_rcpf(d.y);
    f32x2 q = t * 0.5307027145f + (-0.7265760135f); q = q * t + 0.7107068705f; q = q * t + (-0.142248368f); q = q * t + 0.127414796f; q = q * t;
    const f32x2 s = (v * v) * (-0.72134752044f);
    f32x2 e; e.x = __builtin_amdgcn_exp2f(s.x); e.y = __builtin_amdgcn_exp2f(s.y);
    const f32x2 m = v * (q * e), r = v - m;
    f32x2 o; o.x = v.x < 0.f ? m.x : r.x; o.y = v.y < 0.f ? m.y : r.y; return o;
}

struct EpiF32 {
    static constexpr bool PERM = false, AFTER_DRAIN = false;
    float* C; int ldc; const float* bias;
    __device__ __forceinline__ void operator()(const f32x4 (&acc)[2][2][4][2], const Unit& u, int wr, int wc, int fr, int fq) const {
        const int row0 = u.pm * BM + wr * 64 + fr, col0 = u.pn * BM + wc * 32 + 4 * fq;
        f32x4 bv[2][2];
#pragma unroll
        for (int bj = 0; bj < 2; ++bj)
#pragma unroll
            for (int n = 0; n < 2; ++n) bv[bj][n] = bias ? *(const f32x4*)(bias + col0 + bj * HALF + n * 16) : (f32x4){0.f, 0.f, 0.f, 0.f};
#pragma unroll
        for (int ai = 0; ai < 2; ++ai)
#pragma unroll
            for (int m = 0; m < 4; ++m) { float* rowp = C + (size_t)(row0 + ai * HALF + m * 16) * ldc + col0;
#pragma unroll
                for (int bj = 0; bj < 2; ++bj)
#pragma unroll
                    for (int n = 0; n < 2; ++n) *(f32x4*)(rowp + bj * HALF + n * 16) = acc[ai][bj][m][n] + bv[bj][n]; }
    }
};
template <int ACT  > struct EpiBf16 {
    static constexpr bool PERM = true, AFTER_DRAIN = false;
    bf16_t* O; int ldc; const float* bias; int split_cols; size_t split_stride;
    __device__ __forceinline__ void operator()(const f32x4 (&acc)[2][2][4][2], const Unit& u, int wr, int wc, int fr, int fq) const {
        const int row0 = u.pm * BM + wr * 64 + fr; int colt = u.pn * BM; bf16_t* base = O;
        if (split_cols) { const int t = colt / split_cols; base += (size_t)t * split_stride; colt -= t * split_cols; }
        const int col0 = colt + wc * 32 + 8 * fq, bcol0 = u.pn * BM + wc * 32 + 8 * fq;
        f32x4 bv[2][2];
#pragma unroll
        for (int bj = 0; bj < 2; ++bj)
#pragma unroll
            for (int n = 0; n < 2; ++n) bv[bj][n] = bias ? *(const f32x4*)(bias + bcol0 + bj * HALF + 4 * n) : (f32x4){0.f, 0.f, 0.f, 0.f};
#pragma unroll
        for (int ai = 0; ai < 2; ++ai)
#pragma unroll
            for (int m = 0; m < 4; ++m) { bf16_t* rowp = base + (size_t)(row0 + ai * HALF + m * 16) * ldc + col0;
#pragma unroll
                for (int bj = 0; bj < 2; ++bj) { f32x4 v0 = acc[ai][bj][m][0] + bv[bj][0], v1 = acc[ai][bj][m][1] + bv[bj][1];
                    if (ACT == 1) { f32x2 a = gelu_pk((f32x2){v0[0], v0[1]}), b = gelu_pk((f32x2){v0[2], v0[3]}), c = gelu_pk((f32x2){v1[0], v1[1]}), d = gelu_pk((f32x2){v1[2], v1[3]});
                        v0 = (f32x4){a.x, a.y, b.x, b.y}; v1 = (f32x4){c.x, c.y, d.x, d.y}; }
                    if (ACT == 2) {
#pragma unroll
                        for (int j = 0; j < 4; ++j) { v0[j] = 0.5f * v0[j] * (1.0f + erff(v0[j] * 0.70710678f)); v1[j] = 0.5f * v1[j] * (1.0f + erff(v1[j] * 0.70710678f)); } }
                    u32x4 w; w.x = cvt_pk_bf16(v0[0], v0[1]); w.y = cvt_pk_bf16(v0[2], v0[3]); w.z = cvt_pk_bf16(v1[0], v1[1]); w.w = cvt_pk_bf16(v1[2], v1[3]);
                    *(u32x4*)(rowp + bj * HALF) = w; } }
    }
};
template <class Epi, class Sched, bool ALIGN_EPI = false, bool SP2 = false>
__device__ __forceinline__ void gemm_phase(PG8_LAS unsigned char* lds, const Gemm g, const Sched& S, const Epi& E) {
    int tid_ = threadIdx.x; asm volatile("" : "+v"(tid_));
    const int tid = tid_, wid = __builtin_amdgcn_readfirstlane(tid >> 6), lane = tid & 63, wr = wid >> 2, wc = wid & 3, fr = lane & 15, fq = lane >> 4;
    const int K = g.K, nt = K / BK;
    unsigned voffA[2], voffB[2];
#pragma unroll
    for (int i = 0; i < 2; ++i) { int R, C; stage_rc(tid * 16 + i * 8192, R, C); const int Rb = Epi::PERM ? ((R & ~31) + perm32(R & 31)) : R;
        voffA[i] = (unsigned)(R * K + C) * 2u; voffB[i] = (unsigned)(Rb * K + C) * 2u; }
    const size_t kstep = (size_t)(BK * 2);
    const size_t hstep = (size_t)HALF * K * 2;
    const size_t tstep = 2 * hstep;
    const unsigned ldsw = (unsigned)wid * 1024u;
    const int aoff = lds_byte(wr * 64 + fr, fq * 8), boff = lds_byte(wc * 32 + fr, fq * 8);
#define PG8_SA(b, h) (((b) * 2 + (h)) * HTB)
#define PG8_SB(b, h) ((4 + (b) * 2 + (h)) * HTB)
#define PG8_STAGE(bufoff, gbase, voff) do { _Pragma("unroll") for (int _i = 0; _i < 2; ++_i) \
        __builtin_amdgcn_global_load_lds((const unsigned*)((const char*)(gbase) + (voff)[_i]), (PG8_LAS unsigned*)(lds + (bufoff) + ldsw + _i * 8192), 16, 0, 0); } while (0)
#define PG8_LDA(dst, b, h) do { _Pragma("unroll") for (int m = 0; m < 4; ++m) _Pragma("unroll") for (int k = 0; k < 2; ++k) dst[m][k] = *(const PG8_LAS bf16x8*)(lds + PG8_SA(b, h) + aoff + m * 2048 + k * 1024); } while (0)
#define PG8_LDB(dst, b, h) do { _Pragma("unroll") for (int n = 0; n < 2; ++n) _Pragma("unroll") for (int k = 0; k < 2; ++k) dst[n][k] = *(const PG8_LAS bf16x8*)(lds + PG8_SB(b, h) + boff + n * 2048 + k * 1024); } while (0)
#define PG8_MMA(ai, bj, At, Bt) do { __builtin_amdgcn_s_setprio(1); _Pragma("unroll") for (int m = 0; m < 4; ++m) _Pragma("unroll") for (int n = 0; n < 2; ++n) _Pragma("unroll") for (int k = 0; k < 2; ++k) \
        acc[ai][bj][m][n] = __builtin_amdgcn_mfma_f32_16x16x32_bf16(Bt[n][k], At[m][k], acc[ai][bj][m][n], 0, 0, 0); __builtin_amdgcn_s_setprio(0); } while (0)
#define PG8_WAIT_V(n) asm volatile("s_waitcnt vmcnt(" #n ")" ::: "memory")
#define PG8_WAIT_L(n) asm volatile("s_waitcnt lgkmcnt(" #n ")" ::: "memory")
#define PG8_BAR __builtin_amdgcn_s_barrier()
#define PG8_SCHED __builtin_amdgcn_sched_barrier(0)
    Unit cur, nxt; int ui = 0;
    if (!S.next(0, cur)) return;
    f32x4 acc[2][2][4][2];
#pragma unroll
    for (int a = 0; a < 2; ++a)
#pragma unroll
        for (int b = 0; b < 2; ++b)
#pragma unroll
            for (int m = 0; m < 4; ++m)
#pragma unroll
                for (int n = 0; n < 2; ++n) acc[a][b][m][n] = (f32x4){0.f, 0.f, 0.f, 0.f};
    bf16x8 At[4][2], B0[2][2], B1[2][2];
    const char* cA = (const char*)g.A + (size_t)cur.pm * tstep; const char* cB = (const char*)g.Bt + (size_t)cur.pn * tstep;
    S.a_ready(cur);
    if constexpr (SP2) {
        PG8_STAGE(PG8_SB(0, 0), cB, voffB); PG8_STAGE(PG8_SB(0, 1), cB + hstep, voffB); PG8_STAGE(PG8_SA(0, 0), cA, voffA); PG8_STAGE(PG8_SA(0, 1), cA + hstep, voffA);
        if (wr == 1) PG8_BAR;
        PG8_WAIT_V(2); PG8_BAR;
        PG8_STAGE(PG8_SB(1, 0), cB + kstep, voffB); PG8_STAGE(PG8_SA(1, 0), cA + kstep, voffA); PG8_STAGE(PG8_SB(1, 1), cB + hstep + kstep, voffB);
        PG8_WAIT_V(6); PG8_BAR;
    } else {
        PG8_STAGE(PG8_SB(0, 0), cB, voffB); PG8_STAGE(PG8_SA(0, 0), cA, voffA); PG8_STAGE(PG8_SB(0, 1), cB + hstep, voffB); PG8_STAGE(PG8_SA(0, 1), cA + hstep, voffA);
        if (wr == 1) PG8_BAR;
        PG8_WAIT_V(4); PG8_BAR;
        PG8_STAGE(PG8_SB(1, 0), cB + kstep, voffB); PG8_STAGE(PG8_SA(1, 0), cA + kstep, voffA); PG8_STAGE(PG8_SB(1, 1), cB + hstep + kstep, voffB);
        PG8_WAIT_V(6); PG8_BAR;
    }
    for (;;) {
        const bool has_next = S.next(ui + 1, nxt);
        const char* nA = has_next ? (const char*)g.A + (size_t)nxt.pm * tstep : cA; const char* nB = has_next ? (const char*)g.Bt + (size_t)nxt.pn * tstep : cB;
        for (int t = 0; t < nt; t += 2) {
            const bool last = (t == nt - 2);
            const char* a1 = cA + (size_t)(t + 1) * kstep;
            const char* a2 = last ? nA : cA + (size_t)(t + 2) * kstep; const char* b2 = last ? nB : cB + (size_t)(t + 2) * kstep;
            const char* a3 = a2 + kstep; const char* b3 = b2 + kstep;
            if (last && has_next) S.a_ready(nxt);
            if constexpr (SP2) {
            PG8_LDB(B0, 0, 0); PG8_LDB(B1, 0, 1); PG8_SCHED; PG8_LDA(At, 0, 0); PG8_STAGE(PG8_SA(1, 1), a1 + hstep, voffA);
            PG8_WAIT_V(8); PG8_WAIT_L(0); PG8_BAR; PG8_MMA(0, 0, At, B0); PG8_MMA(0, 1, At, B1); PG8_BAR; PG8_SCHED;
            PG8_LDA(At, 0, 1); PG8_STAGE(PG8_SB(0, 0), b2, voffB); PG8_STAGE(PG8_SB(0, 1), b2 + hstep, voffB); PG8_STAGE(PG8_SA(0, 0), a2, voffA);
            PG8_WAIT_V(8); PG8_WAIT_L(0); PG8_BAR; PG8_MMA(1, 0, At, B0); PG8_MMA(1, 1, At, B1); PG8_BAR; PG8_SCHED;
            PG8_LDB(B0, 1, 0); PG8_LDB(B1, 1, 1); PG8_SCHED; PG8_LDA(At, 1, 0); PG8_STAGE(PG8_SA(0, 1), a2 + hstep, voffA);
            PG8_WAIT_V(8); PG8_WAIT_L(0); PG8_BAR; PG8_MMA(0, 0, At, B0); PG8_MMA(0, 1, At, B1); PG8_BAR; PG8_SCHED;
            PG8_LDA(At, 1, 1); PG8_STAGE(PG8_SB(1, 0), b3, voffB); PG8_STAGE(PG8_SB(1, 1), b3 + hstep, voffB); PG8_STAGE(PG8_SA(1, 0), a3, voffA);
            PG8_WAIT_V(8); PG8_WAIT_L(0); PG8_BAR; PG8_MMA(1, 0, At, B0); PG8_MMA(1, 1, At, B1); PG8_BAR; PG8_SCHED;
            } else {
            PG8_LDB(B0, 0, 0); PG8_SCHED; PG8_LDA(At, 0, 0); PG8_STAGE(PG8_SA(1, 1), a1 + hstep, voffA);
            PG8_WAIT_L(8); PG8_BAR; PG8_WAIT_L(0); PG8_MMA(0, 0, At, B0); PG8_BAR; PG8_SCHED;
            PG8_LDB(B1, 0, 1); PG8_STAGE(PG8_SB(0, 0), b2, voffB);
            PG8_BAR; PG8_WAIT_L(0); PG8_MMA(0, 1, At, B1); PG8_BAR;
            PG8_LDA(At, 0, 1); PG8_STAGE(PG8_SA(0, 0), a2, voffA);
            PG8_BAR; PG8_WAIT_L(0); PG8_MMA(1, 0, At, B0); PG8_BAR; PG8_SCHED;
            PG8_STAGE(PG8_SB(0, 1), b2 + hstep, voffB);
            PG8_WAIT_V(6); PG8_BAR; PG8_MMA(1, 1, At, B1); PG8_BAR;
            PG8_LDB(B0, 1, 0); PG8_SCHED; PG8_LDA(At, 1, 0); PG8_STAGE(PG8_SA(0, 1), a2 + hstep, voffA);
            PG8_WAIT_L(8); PG8_BAR; PG8_WAIT_L(0); PG8_MMA(0, 0, At, B0); PG8_BAR; PG8_SCHED;
            PG8_LDB(B1, 1, 1); PG8_STAGE(PG8_SB(1, 0), b3, voffB);
            PG8_BAR; PG8_WAIT_L(0); PG8_MMA(0, 1, At, B1); PG8_BAR;
            PG8_LDA(At, 1, 1); PG8_STAGE(PG8_SA(1, 0), a3, voffA);
            PG8_BAR; PG8_WAIT_L(0); PG8_MMA(1, 0, At, B0); PG8_BAR; PG8_SCHED;
            PG8_STAGE(PG8_SB(1, 1), b3 + hstep, voffB);
            PG8_WAIT_V(6); PG8_BAR; PG8_MMA(1, 1, At, B1); PG8_BAR;
            }
        }
        if constexpr (ALIGN_EPI) { if (wr == 0) PG8_BAR; }
        if constexpr (!Epi::AFTER_DRAIN) { E(acc, cur, wr, wc, fr, fq); S.done(cur); }
        if (!has_next) break;
#pragma unroll
        for (int a = 0; a < 2; ++a)
#pragma unroll
            for (int b = 0; b < 2; ++b)
#pragma unroll
                for (int m = 0; m < 4; ++m)
#pragma unroll
                    for (int n = 0; n < 2; ++n) acc[a][b][m][n] = (f32x4){0.f, 0.f, 0.f, 0.f};
        cur = nxt; cA = nA; cB = nB; ++ui;
        if constexpr (ALIGN_EPI) { if (wr == 1) PG8_BAR; }
    }
    PG8_WAIT_V(0);
    if constexpr (!ALIGN_EPI) { if (wr == 0) PG8_BAR; }
    PG8_BAR;
    if constexpr (Epi::AFTER_DRAIN) { E.fused(acc, cur, wr, wc, fr, fq, lds, wid, lane); S.done(cur); }
#undef PG8_SA
#undef PG8_SB
#undef PG8_STAGE
#undef PG8_LDA
#undef PG8_LDB
#undef PG8_MMA
#undef PG8_WAIT_V
#undef PG8_WAIT_L
#undef PG8_BAR
#undef PG8_SCHED
}
}

#ifndef REP_SYNC
#define REP_SYNC 1
#endif
#ifndef REP_P1
#define REP_P1 1
#endif
#ifndef MK_ALIGN_EPI
#define MK_ALIGN_EPI true
#endif
#ifndef MK_SP2
#define MK_SP2 true
#endif
#ifndef NT_Z
#define NT_Z 0
#endif
#ifndef STAG1
#define STAG1 0
#endif
#ifndef STAG3
#define STAG3 0
#endif
#ifndef STAG5
#define STAG5 0
#endif
#ifndef REP_K3
#define REP_K3 0
#endif
#ifndef REP_P0
#define REP_P0 1
#endif
#ifndef REP_PLE
#define REP_PLE 1
#endif
#ifndef REP_P5
#define REP_P5 1
#endif
#ifndef REP_A
#define REP_A 1
#endif
#ifndef REP_P2E
#define REP_P2E 1
#endif
#ifndef REP_P2O
#define REP_P2O 1
#endif
namespace mk {
using pg8::bf16_t; using pg8::bf16x8; using pg8::f32x4; using pg8::u32x4;
typedef unsigned u32x2 __attribute__((ext_vector_type(2)));
typedef float f32x2 __attribute__((ext_vector_type(2)));
typedef short bf16x4 __attribute__((ext_vector_type(4)));
#define MK_LAS __attribute__((address_space(3)))
constexpr int M = 65536, D = 1024, NB = 3072, DP = 256, SEQ = 4096, WB = 512, DEPTH = 4;
constexpr float LN_EPS = 1e-5f;
constexpr float ALPHA = 1.681792830507429f;
constexpr int NTHREADS = 512, NWAVES = 8;
constexpr int LDS_BYTES = 147520;
constexpr int LDS_RED = 139264;
constexpr int VT_STRIDE = 132;
constexpr size_t WS_WIN = 0;
constexpr size_t WS_WOUT = WS_WIN + (size_t)4 * NB * D * 2;
constexpr size_t WS_WGATE = WS_WOUT + (size_t)4 * D * D * 2;
constexpr size_t WS_WPLE = WS_WGATE + (size_t)4 * D * D * 2;
constexpr size_t WS_WS = WS_WPLE + (size_t)4 * D * DP * 2;
constexpr size_t WS_WP = WS_WS + (size_t)2 * 8 * 128 * 128 * 2;
constexpr size_t WS_XB = WS_WP + (size_t)2 * 4 * 128 * 128 * 2;
constexpr size_t WS_PB = WS_XB + (size_t)2 * M * D * 2;
constexpr size_t WS_Z = WS_PB + (size_t)4 * M * DP * 2;
constexpr size_t WS_Y = WS_Z + (size_t)M * NB * 2;
constexpr size_t WS_STATS = WS_Y + (size_t)M * D * 2;
constexpr size_t WS_C12 = WS_STATS + (size_t)M * 16 * 2 * 4;
constexpr size_t WS_BAR = WS_C12 + (size_t)4 * 2 * D * 4;
constexpr size_t WS_END = WS_BAR + (size_t)XCD_BAR_WORDS * 4;

struct Params { const float* in[26]; float* out; unsigned char* ws; };

__device__ __forceinline__ float bf2f(unsigned short b) { return __uint_as_float((unsigned)b << 16); }
__device__ __forceinline__ float bflo(unsigned w) { return __uint_as_float(w << 16); }
__device__ __forceinline__ float bfhi(unsigned w) { return __uint_as_float(w & 0xffff0000u); }
__device__ __forceinline__ unsigned short f2bf(float f) { unsigned u = __float_as_uint(f); u += 0x7FFFu + ((u >> 16) & 1u); return (unsigned short)(u >> 16); }
__device__ __forceinline__ unsigned pk2(float lo, float hi) { return pg8::cvt_pk_bf16(lo, hi); }
__device__ __forceinline__ float sigmoidf_(float x) { return __builtin_amdgcn_rcpf(1.0f + __expf(-x)); }
__device__ __forceinline__ float siluf_(float x) { return x * sigmoidf_(x); }
__device__ __forceinline__ float geluf_(float x) { return x * sigmoidf_(1.5957691216057308f * (x + 0.044715f * x * x * x)); }
__device__ __forceinline__ float silu2_(float a, float b) { return (a * b) * __builtin_amdgcn_rcpf((1.0f + __expf(-a)) * (1.0f + __expf(-b))); }
__device__ __forceinline__ float gelu_silu_(float u, float g) { return (u * g) * __builtin_amdgcn_rcpf((1.0f + __expf(-1.5957691216057308f * (u + 0.044715f * u * u * u))) * (1.0f + __expf(-g))); }
template <int CTRL> __device__ __forceinline__ float dpp_f(float v) { return __builtin_bit_cast(float, __builtin_amdgcn_update_dpp(0, __builtin_bit_cast(int, v), CTRL, 0xf, 0xf, false)); }
__device__ __forceinline__ float wave_sum(float v) {
    v += dpp_f<0x128>(v); v += dpp_f<0x124>(v); v += dpp_f<0x122>(v); v += dpp_f<0x121>(v);
    const int vi = __builtin_bit_cast(int, v);
    const float r0 = __builtin_bit_cast(float, __builtin_amdgcn_readlane(vi, 0)), r1 = __builtin_bit_cast(float, __builtin_amdgcn_readlane(vi, 16));
    const float r2 = __builtin_bit_cast(float, __builtin_amdgcn_readlane(vi, 32)), r3 = __builtin_bit_cast(float, __builtin_amdgcn_readlane(vi, 48));
    return (r0 + r1) + (r2 + r3);
}

struct EpiNull {
    static constexpr bool PERM = true, AFTER_DRAIN = false;
    __device__ __forceinline__ void operator()(const f32x4 (&acc)[2][2][4][2], const pg8::Unit&, int, int, int, int) const {
#pragma unroll
        for (int a = 0; a < 2; ++a)
#pragma unroll
            for (int b = 0; b < 2; ++b)
#pragma unroll
                for (int m = 0; m < 4; ++m)
#pragma unroll
                    for (int n = 0; n < 2; ++n) asm volatile("" :: "v"(acc[a][b][m][n]));
    }
};
struct EpiZ {
    static constexpr bool PERM = true, AFTER_DRAIN = false;
    bf16_t* O; int ld; const MK_LAS float* lbias; int oddmode;
    __device__ __forceinline__ void operator()(const f32x4 (&acc)[2][2][4][2], const pg8::Unit& u, int wr, int wc, int fr, int fq) const {
        const int row0 = u.pm * 256 + wr * 64 + fr, col0 = u.pn * 256 + wc * 64 + 16 * fq;
        f32x4 bv[2][2];
#pragma unroll
        for (int bj = 0; bj < 2; ++bj)
#pragma unroll
            for (int n = 0; n < 2; ++n) bv[bj][n] = lbias ? *(const MK_LAS f32x4*)(lbias + col0 + 8 * bj + 4 * n) : (f32x4){0.f, 0.f, 0.f, 0.f};
        if (oddmode == 1 && u.pn >= 4) {
            const bool gate = u.pn < 8;
            const int scol = gate ? 1536 + ((col0 - 1024) >> 1) : 1024 + ((col0 - 2048) >> 1);
#pragma unroll
            for (int ai = 0; ai < 2; ++ai)
#pragma unroll
                for (int m = 0; m < 4; ++m) { bf16_t* rowp = O + (size_t)(row0 + ai * 128 + m * 16) * ld + scol;
                    f32x4 y0 = acc[ai][1][m][0] + bv[1][0], y1 = acc[ai][1][m][1] + bv[1][1];
                    if (gate) {
#pragma unroll
                        for (int e = 0; e < 4; ++e) { y0[e] = siluf_(y0[e]); y1[e] = siluf_(y1[e]); } }
                    const f32x4 v0 = (acc[ai][0][m][0] + bv[0][0]) * y0, v1 = (acc[ai][0][m][1] + bv[0][1]) * y1;
                    u32x4 w; w.x = pg8::cvt_pk_bf16(v0[0], v0[1]); w.y = pg8::cvt_pk_bf16(v0[2], v0[3]); w.z = pg8::cvt_pk_bf16(v1[0], v1[1]); w.w = pg8::cvt_pk_bf16(v1[2], v1[3]);
                    *(u32x4*)rowp = w; }
            return;
        }
        if (oddmode == 2 && u.pn < 4) {
            const int pcol = col0 >> 1;
#pragma unroll
            for (int ai = 0; ai < 2; ++ai)
#pragma unroll
                for (int m = 0; m < 4; ++m) { bf16_t* rowp = O + (size_t)(row0 + ai * 128 + m * 16) * ld + pcol;
                    const f32x4 x0 = acc[ai][0][m][0] + bv[0][0], x1 = acc[ai][0][m][1] + bv[0][1], y0 = acc[ai][1][m][0] + bv[1][0], y1 = acc[ai][1][m][1] + bv[1][1];
                    u32x4 w; w.x = pg8::cvt_pk_bf16(x0[0] * sigmoidf_(y0[0]), x0[1] * sigmoidf_(y0[1])); w.y = pg8::cvt_pk_bf16(x0[2] * sigmoidf_(y0[2]), x0[3] * sigmoidf_(y0[3]));
                    w.z = pg8::cvt_pk_bf16(x1[0] * sigmoidf_(y1[0]), x1[1] * sigmoidf_(y1[1])); w.w = pg8::cvt_pk_bf16(x1[2] * sigmoidf_(y1[2]), x1[3] * sigmoidf_(y1[3]));
                    *(u32x4*)rowp = w; }
            return;
        }
        if (oddmode == 2 && u.pn >= 8) {
            const int pcol = 1536 + ((col0 - 2048) >> 1);
#pragma unroll
            for (int ai = 0; ai < 2; ++ai)
#pragma unroll
                for (int m = 0; m < 4; ++m) { bf16_t* rowp = O + (size_t)(row0 + ai * 128 + m * 16) * ld + pcol;
                    const f32x4 x0 = acc[ai][0][m][0] + bv[0][0], x1 = acc[ai][0][m][1] + bv[0][1], y0 = acc[ai][1][m][0] + bv[1][0], y1 = acc[ai][1][m][1] + bv[1][1];
                    u32x4 w; w.x = pg8::cvt_pk_bf16(gelu_silu_(x0[0], y0[0]), gelu_silu_(x0[1], y0[1])); w.y = pg8::cvt_pk_bf16(gelu_silu_(x0[2], y0[2]), gelu_silu_(x0[3], y0[3]));
                    w.z = pg8::cvt_pk_bf16(gelu_silu_(x1[0], y1[0]), gelu_silu_(x1[1], y1[1])); w.w = pg8::cvt_pk_bf16(gelu_silu_(x1[2], y1[2]), gelu_silu_(x1[3], y1[3]));
                    *(u32x4*)rowp = w; }
            return;
        }
        const int scol = col0 + ((oddmode == 2 && u.pn >= 6) ? 512 : 0);
#pragma unroll
        for (int ai = 0; ai < 2; ++ai)
#pragma unroll
            for (int m = 0; m < 4; ++m) { bf16_t* rowp = O + (size_t)(row0 + ai * 128 + m * 16) * ld + scol;
#pragma unroll
                for (int bj = 0; bj < 2; ++bj) { const f32x4 v0 = acc[ai][bj][m][0] + bv[bj][0], v1 = acc[ai][bj][m][1] + bv[bj][1];
                    u32x4 w; w.x = pg8::cvt_pk_bf16(v0[0], v0[1]); w.y = pg8::cvt_pk_bf16(v0[2], v0[3]); w.z = pg8::cvt_pk_bf16(v1[0], v1[1]); w.w = pg8::cvt_pk_bf16(v1[2], v1[3]);
                    *(u32x4*)(rowp + bj * 8) = w; } }
    }
};
struct EpiT {
    static constexpr bool PERM = true, AFTER_DRAIN = false;
    const bf16_t* xs; bf16_t* xt; const float* bias; float* stats;
    __device__ __forceinline__ void operator()(const f32x4 (&acc)[2][2][4][2], const pg8::Unit& u, int wr, int wc, int fr, int fq) const {
        const int row0 = u.pm * 256 + wr * 64 + fr, col0 = u.pn * 256 + wc * 64 + 16 * fq;
        f32x4 bv[2][2];
#pragma unroll
        for (int bj = 0; bj < 2; ++bj)
#pragma unroll
            for (int n = 0; n < 2; ++n) bv[bj][n] = *(const f32x4*)(bias + col0 + 8 * bj + 4 * n);
        u32x4 xr[4][2];
#pragma unroll
        for (int g = 0; g < 4; ++g) { const bf16_t* p = xs + (size_t)(row0 + g * 16) * D + col0; xr[g][0] = *(const u32x4*)p; xr[g][1] = *(const u32x4*)(p + 8); }
#pragma unroll
        for (int g = 0; g < 8; ++g) {
            const int ai = g >> 2, m = g & 3, row = row0 + ai * 128 + m * 16; bf16_t* p = xt + (size_t)row * D + col0;
            const u32x4 xc0 = xr[g & 3][0], xc1 = xr[g & 3][1];
            if (g < 4) { const bf16_t* pn = xs + (size_t)(row0 + 128 + g * 16) * D + col0; xr[g][0] = *(const u32x4*)pn; xr[g][1] = *(const u32x4*)(pn + 8); }
            float s = 0.f, s2 = 0.f;
#pragma unroll
            for (int bj = 0; bj < 2; ++bj) { const u32x4 x4 = bj ? xc1 : xc0;
                const f32x4 v0 = acc[ai][bj][m][0] + bv[bj][0] + (f32x4){bflo(x4.x), bfhi(x4.x), bflo(x4.y), bfhi(x4.y)} * ALPHA;
                const f32x4 v1 = acc[ai][bj][m][1] + bv[bj][1] + (f32x4){bflo(x4.z), bfhi(x4.z), bflo(x4.w), bfhi(x4.w)} * ALPHA;
                u32x4 w; w.x = pg8::cvt_pk_bf16(v0[0], v0[1]); w.y = pg8::cvt_pk_bf16(v0[2], v0[3]); w.z = pg8::cvt_pk_bf16(v1[0], v1[1]); w.w = pg8::cvt_pk_bf16(v1[2], v1[3]);
                *(u32x4*)(p + bj * 8) = w;
                const float r0 = bflo(w.x), r1 = bfhi(w.x), r2 = bflo(w.y), r3 = bfhi(w.y), r4 = bflo(w.z), r5 = bfhi(w.z), r6 = bflo(w.w), r7 = bfhi(w.w);
                s += ((r0 + r1) + (r2 + r3)) + ((r4 + r5) + (r6 + r7));
                s2 += ((r0 * r0 + r1 * r1) + (r2 * r2 + r3 * r3)) + ((r4 * r4 + r5 * r5) + (r6 * r6 + r7 * r7)); }
            s += __shfl_xor(s, 16); s += __shfl_xor(s, 32); s2 += __shfl_xor(s2, 16); s2 += __shfl_xor(s2, 32);
            if (fq == 0) *(f32x2*)(stats + ((size_t)(u.pn * 4 + wc) * M + row) * 2) = (f32x2){s, s2};
        }
    }
};
struct EpiGate2 {
    static constexpr bool PERM = true, AFTER_DRAIN = false;
    const bf16_t* tb; const bf16_t* ple; bf16_t* xo; float* fo; const float* stats; const MK_LAS float* lv;
    __device__ __forceinline__ void operator()(const f32x4 (&acc)[2][2][4][2], const pg8::Unit& u, int wr, int wc, int fr, int fq) const {
        const int row0 = u.pm * 256 + wr * 64 + fr, col0 = u.pn * 256 + wc * 64 + 16 * fq;
        f32x4 sa[2], sb[2]; u32x4 tw[2][2], pw[2][2];
        { const float* sp = stats + ((size_t)(fq * 4) * M + row0) * 2; const f32x2 q0 = *(const f32x2*)sp, q1 = *(const f32x2*)(sp + (size_t)2 * M), q2 = *(const f32x2*)(sp + (size_t)4 * M), q3 = *(const f32x2*)(sp + (size_t)6 * M); sa[0] = (f32x4){q0.x, q0.y, q1.x, q1.y}; sb[0] = (f32x4){q2.x, q2.y, q3.x, q3.y};
          const size_t o = (size_t)row0 * D + col0; tw[0][0] = *(const u32x4*)(tb + o); tw[0][1] = *(const u32x4*)(tb + o + 8); pw[0][0] = *(const u32x4*)(ple + o); pw[0][1] = *(const u32x4*)(ple + o + 8); }
#pragma unroll
        for (int g = 0; g < 8; ++g) {
            const int ai = g >> 2, m = g & 3, row = row0 + ai * 128 + m * 16, cur = g & 1;
            if (g < 7) { const int g1 = g + 1, nb = g1 & 1, rown = row0 + (g1 >> 2) * 128 + (g1 & 3) * 16;
                const float* sp = stats + ((size_t)(fq * 4) * M + rown) * 2; const f32x2 q0 = *(const f32x2*)sp, q1 = *(const f32x2*)(sp + (size_t)2 * M), q2 = *(const f32x2*)(sp + (size_t)4 * M), q3 = *(const f32x2*)(sp + (size_t)6 * M); sa[nb] = (f32x4){q0.x, q0.y, q1.x, q1.y}; sb[nb] = (f32x4){q2.x, q2.y, q3.x, q3.y};
                const size_t o = (size_t)rown * D + col0; tw[nb][0] = *(const u32x4*)(tb + o); tw[nb][1] = *(const u32x4*)(tb + o + 8); pw[nb][0] = *(const u32x4*)(ple + o); pw[nb][1] = *(const u32x4*)(ple + o + 8); }
            float mu, rs;
            { const f32x4 a = sa[cur], b = sb[cur];
              float s = (a[0] + a[2]) + (b[0] + b[2]), s2 = (a[1] + a[3]) + (b[1] + b[3]);
              s += __shfl_xor(s, 16); s += __shfl_xor(s, 32); s2 += __shfl_xor(s2, 16); s2 += __shfl_xor(s2, 32);
              mu = s * (1.f / D); const float var = s2 * (1.f / D) - mu * mu; rs = 1.f / sqrtf(fmaxf(var, 0.f) + LN_EPS); }
#pragma unroll
            for (int bj = 0; bj < 2; ++bj) {
                const int c = col0 + bj * 8; const size_t o = (size_t)row * D + c;
                const u32x4 t4 = tw[cur][bj], p4 = pw[cur][bj];
                f32x4 x[2];
#pragma unroll
                for (int n = 0; n < 2; ++n) {
                    const f32x4 gv = *(const MK_LAS f32x4*)(lv + c + 4 * n), bb = *(const MK_LAS f32x4*)(lv + 1024 + c + 4 * n), c1v = *(const MK_LAS f32x4*)(lv + 2048 + c + 4 * n), c2v = *(const MK_LAS f32x4*)(lv + 3072 + c + 4 * n);
                    const unsigned ta = n ? t4.z : t4.x, tbw = n ? t4.w : t4.y, pa = n ? p4.z : p4.x, pb2 = n ? p4.w : p4.y;
                    const f32x4 tv = (f32x4){bflo(ta), bfhi(ta), bflo(tbw), bfhi(tbw)}, pv = (f32x4){bflo(pa), bfhi(pa), bflo(pb2), bfhi(pb2)};
                    const f32x4 gp = (acc[ai][bj][m][n] - c1v * mu) * rs + c2v;
                    const f32x4 h = (tv - mu) * rs * gv + bb;
#pragma unroll
                    for (int e = 0; e < 4; ++e) x[n][e] = h[e] + sigmoidf_(gp[e]) * pv[e];
                }
                if (fo) { *(f32x4*)(fo + o) = x[0]; *(f32x4*)(fo + o + 4) = x[1]; }
                else { u32x4 w; w.x = pg8::cvt_pk_bf16(x[0][0], x[0][1]); w.y = pg8::cvt_pk_bf16(x[0][2], x[0][3]); w.z = pg8::cvt_pk_bf16(x[1][0], x[1][1]); w.w = pg8::cvt_pk_bf16(x[1][2], x[1][3]); *(u32x4*)(xo + o) = w; }
            }
        }
    }
};

__device__ __forceinline__ int orig_col_odd(int L) {
    if (L < 1024) return L;
    if (L < 2048) { const int g = (L - 1024) >> 4, e = L & 15; return e < 8 ? 1536 + 8 * g + e : 2560 + 8 * g + (e - 8); }
    const int g = (L - 2048) >> 4, e = L & 15;
    return e < 8 ? 1024 + 8 * g + e : 2048 + 8 * g + (e - 8);
}
__device__ __forceinline__ int orig_col_even(int L) {
    if (L < 1024) { const int g = L >> 4, e = L & 15; return e < 8 ? 8 * g + e : 512 + 8 * g + (e - 8); }
    if (L < 1536) return L;
    if (L < 2048) return L + 512;
    const int g = (L - 2048) >> 4, e = L & 15;
    return e < 8 ? 1536 + 8 * g + e : 2560 + 8 * g + (e - 8);
}
__device__ __forceinline__ int phys_row(int L) { const int r = L & 255; return (L & ~255) + 128 * ((r >> 3) & 1) + 32 * (r >> 6) + 8 * ((r >> 4) & 3) + (r & 7); }
__device__ __forceinline__ void p0_transpose_item(const float* W, int K, int N, bf16_t* WT, MK_LAS float* scr, int item, int lane, const float* rowscale = nullptr, bool remap = true, int cmap = 0) {
    const int nblk = N / 32, kb = item / nblk, nb = item % nblk, k0 = 64 * kb, n0 = 32 * nb;
    const int scol = cmap == 1 ? orig_col_odd(n0 + (lane & 31)) : (cmap == 2 ? orig_col_even(n0 + (lane & 31)) : n0 + (lane & 31));
    float wl[32];
#pragma unroll
    for (int i = 0; i < 32; ++i) wl[i] = W[(size_t)(k0 + 2 * i + (lane >> 5)) * N + scol];
#pragma unroll
    for (int i = 0; i < 32; ++i) { const int kk = 2 * i + (lane >> 5); float wv = wl[i]; if (rowscale) wv *= rowscale[k0 + kk]; scr[kk * 33 + (lane & 31)] = wv; }
    asm volatile("s_waitcnt lgkmcnt(0)" ::: "memory");
    const int c = lane & 7;
#pragma unroll
    for (int j = 0; j < 4; ++j) { const int n = (lane >> 3) + 8 * j; const MK_LAS float* s = scr + (8 * c) * 33 + n;
        u32x4 o; o.x = pk2(s[0 * 33], s[1 * 33]); o.y = pk2(s[2 * 33], s[3 * 33]); o.z = pk2(s[4 * 33], s[5 * 33]); o.w = pk2(s[6 * 33], s[7 * 33]);
        *(u32x4*)(WT + (size_t)(remap ? phys_row(n0 + n) : (n0 + n)) * K + k0 + 8 * c) = o; }
    asm volatile("s_waitcnt lgkmcnt(0)" ::: "memory");
}
__device__ __forceinline__ void cvt_rows(const float* src, bf16_t* dst, size_t n8, size_t i0, size_t stride) {
    for (size_t i = i0; i < n8; i += 4 * stride) {
        f32x4 a[4], b[4];
#pragma unroll
        for (int k = 0; k < 4; ++k) { const size_t ii = (i + k * stride < n8) ? i + k * stride : i; a[k] = __builtin_nontemporal_load((const f32x4*)(src + ii * 8)); b[k] = __builtin_nontemporal_load((const f32x4*)(src + ii * 8 + 4)); }
#pragma unroll
        for (int k = 0; k < 4; ++k) { if (i + k * stride < n8) { u32x4 o; o.x = pk2(a[k][0], a[k][1]); o.y = pk2(a[k][2], a[k][3]); o.z = pk2(b[k][0], b[k][1]); o.w = pk2(b[k][2], b[k][3]); *(u32x4*)(dst + (i + k * stride) * 8) = o; } }
    }
}
__device__ __forceinline__ void p0_prologue(const Params& P, MK_LAS unsigned char* lds) {
    int tid_ = threadIdx.x; asm volatile("" : "+v"(tid_));
    const int tid = tid_, lane = tid & 63, wave = tid >> 6;
    MK_LAS float* scr = (MK_LAS float*)(lds + wave * 16384);
    const int gw = blockIdx.x * NWAVES + wave, NGW = gridDim.x * NWAVES;
    unsigned char* ws = P.ws;
    constexpr int I_IN = (D / 64) * (NB / 32), I_SQ = (D / 64) * (D / 32), I_PLE = (DP / 64) * (D / 32), I_POOL = (128 / 64) * (128 / 32);
    constexpr int PER_L = I_IN + 2 * I_SQ + I_PLE, NITEMS = 4 * PER_L + 8 * I_POOL;
    for (int it = gw; it < NITEMS; it += NGW) {
        if (it < 4 * PER_L) {
            const int l = it / PER_L, j = l >> 1; int r = it % PER_L;
            if (r < I_IN) { const float* W = ((l & 1) ? P.in[14] : P.in[2]) + (size_t)j * D * NB; p0_transpose_item(W, D, NB, (bf16_t*)(ws + WS_WIN) + (size_t)l * NB * D, scr, r, lane, nullptr, true, (l & 1) ? 1 : 2); continue; } r -= I_IN;
            if (r < I_SQ) { const float* W = ((l & 1) ? P.in[19] : P.in[12]) + (size_t)j * D * D; p0_transpose_item(W, D, D, (bf16_t*)(ws + WS_WOUT) + (size_t)l * D * D, scr, r, lane); continue; } r -= I_SQ;
            if (r < I_SQ) { p0_transpose_item(P.in[24] + (size_t)l * D * D, D, D, (bf16_t*)(ws + WS_WGATE) + (size_t)l * D * D, scr, r, lane, P.in[21] + (size_t)l * D); continue; } r -= I_SQ;
            p0_transpose_item(P.in[23] + (size_t)l * DP * D, DP, D, (bf16_t*)(ws + WS_WPLE) + (size_t)l * D * DP, scr, r, lane);
        } else {
            const int r = it - 4 * PER_L, mtx = r / I_POOL;
            p0_transpose_item(P.in[16] + (size_t)mtx * 128 * 128, 128, 128, (bf16_t*)(ws + WS_WP) + (size_t)mtx * 128 * 128, scr, r % I_POOL, lane, nullptr, false);
        }
    }
    const size_t gt = (size_t)blockIdx.x * NTHREADS + tid, GT = (size_t)gridDim.x * NTHREADS;
    for (size_t i = gt; i < (size_t)2 * 8 * 128 * 128; i += GT) { const int s = (int)(i & 127), t = (int)((i >> 7) & 127); ((bf16_t*)(ws + WS_WS))[i] = (s <= t) ? f2bf(P.in[10][i]) : (bf16_t)0; }
    cvt_rows(P.in[0], (bf16_t*)(ws + WS_XB), (size_t)M * D / 8, gt, GT);
    cvt_rows(P.in[1], (bf16_t*)(ws + WS_PB), (size_t)4 * M * DP / 8, gt, GT);
    __syncthreads();
    for (int task = blockIdx.x; task < 4 * (D / 16); task += gridDim.x) {
        const int l = task / (D / 16), n = (task % (D / 16)) * 16 + (tid & 15), kg = tid >> 4;
        const float* Wg = P.in[24] + (size_t)l * D * D + n; const float* g = P.in[21] + (size_t)l * D; const float* b = P.in[22] + (size_t)l * D;
        float s1 = 0.f, s2 = 0.f;
#pragma unroll 8
        for (int k = kg * 32; k < kg * 32 + 32; ++k) { const float w = Wg[(size_t)k * D]; s1 += bf2f(f2bf(g[k] * w)); s2 += b[k] * w; }
        MK_LAS float* red = (MK_LAS float*)lds;
        red[tid * 2] = s1; red[tid * 2 + 1] = s2;
        __syncthreads();
        if (tid < 16) { float a1 = 0.f, a2 = 0.f;
            for (int w = 0; w < 32; ++w) { a1 += red[(w * 16 + tid) * 2]; a2 += red[(w * 16 + tid) * 2 + 1]; }
            float* c12 = (float*)(ws + WS_C12) + (size_t)l * 2 * D; c12[n] = a1; c12[D + n] = a2 + P.in[25][(size_t)l * D + n]; }
        __syncthreads();
    }
}

__device__ __forceinline__ void even_a_branch(const bf16_t* z, bf16_t* y, const float* cw, const float* cb, const float* lg, const float* lb, int run, MK_LAS unsigned char* lds) {
    unsigned tid_ = threadIdx.x; asm volatile("" : "+v"(tid_));
    const unsigned tid = tid_, lane = tid & 63u, c = tid; const int wave = __builtin_amdgcn_readfirstlane((int)(tid >> 6));
    MK_LAS float* LA = (MK_LAS float*)lds;
    MK_LAS float* LO = (MK_LAS float*)(lds + 65536);
    float wk[31];
#pragma unroll
    for (int k = 0; k < 31; ++k) wk[k] = (cw + k * WB)[c];
    const float cbv = cb[c];
    const f32x4 g0 = *(const f32x4*)(lg + 8u * lane), g1 = *(const f32x4*)(lg + 8u * lane + 4u), b0 = *(const f32x4*)(lb + 8u * lane), b1 = *(const f32x4*)(lb + 8u * lane + 4u);
    const int row0 = run * 256, pos0 = row0 & (SEQ - 1);
    float win[38];
#pragma unroll
    for (int i = 0; i < 30; ++i) { float v = 0.f;
        if (pos0 - 30 + i >= 0) { const bf16_t* zr = z + (size_t)(row0 - 30 + i) * NB; v = bf2f(zr[c]); }
        win[8 + i] = v; }
    u32x4 rv[4];
    { const bf16_t* zw = z + (size_t)(row0 + 4 * wave) * NB;
#pragma unroll
      for (int tt = 0; tt < 4; ++tt) { rv[tt] = *(const u32x4*)(zw + (size_t)tt * NB + 8u * lane); } }
    for (int st = 0; st < 8; ++st) {
        const bf16_t* zst = z + (size_t)(row0 + st * 32 + 4 * wave) * NB;
#pragma unroll
        for (int tt = 0; tt < 4; ++tt) {
            const u32x4 v = rv[tt];
            const f32x4 a0 = (f32x4){bflo(v.x), bfhi(v.x), bflo(v.y), bfhi(v.y)}, a1 = (f32x4){bflo(v.z), bfhi(v.z), bflo(v.w), bfhi(v.w)};
            MK_LAS float* p = LA + (4 * wave + tt) * 512 + 8u * lane;
            *(MK_LAS f32x4*)p = a0; *(MK_LAS f32x4*)(p + 4) = a1;
        }
        __syncthreads();
        u32x4 gt[4];
#pragma unroll
        for (int tt = 0; tt < 4; ++tt) gt[tt] = *(const u32x4*)(zst + (size_t)tt * NB + 1024u + 8u * lane);
        if (st < 7) {
#pragma unroll
            for (int tt = 0; tt < 4; ++tt) { rv[tt] = *(const u32x4*)(zst + (size_t)(32 + tt) * NB + 8u * lane); }
        }
#pragma unroll
        for (int ch = 0; ch < 4; ++ch) {
#pragma unroll
            for (int i = 0; i < 30; ++i) win[i] = win[i + 8];
#pragma unroll
            for (int i = 0; i < 8; ++i) win[30 + i] = LA[(ch * 8 + i) * 512 + c];
#pragma unroll
            for (int i = 0; i < 8; ++i) { float s = cbv;
#pragma unroll
                for (int k = 0; k < 31; ++k) s += wk[k] * win[i + k];
                LO[(ch * 8 + i) * 512 + c] = s; }
        }
        __syncthreads();
#pragma unroll
        for (int tt = 0; tt < 4; ++tt) {
            const MK_LAS float* p = LO + (4 * wave + tt) * 512 + 8u * lane;
            f32x4 v0 = *(const MK_LAS f32x4*)p, v1 = *(const MK_LAS f32x4*)(p + 4);
            float s = ((v0[0] + v0[1]) + (v0[2] + v0[3])) + ((v1[0] + v1[1]) + (v1[2] + v1[3]));
            float s2 = ((v0[0] * v0[0] + v0[1] * v0[1]) + (v0[2] * v0[2] + v0[3] * v0[3])) + ((v1[0] * v1[0] + v1[1] * v1[1]) + (v1[2] * v1[2] + v1[3] * v1[3]));
            s = wave_sum(s); s2 = wave_sum(s2);
            const float mean = s * (1.f / WB), var = s2 * (1.f / WB) - mean * mean, rstd = 1.f / sqrtf(fmaxf(var, 0.f) + LN_EPS);
            v0 = (v0 - mean) * rstd * g0 + b0; v1 = (v1 - mean) * rstd * g1 + b1;
            const u32x4 g = gt[tt];
            u32x4 o;
            o.x = pk2(silu2_(v0[0], bflo(g.x)), silu2_(v0[1], bfhi(g.x))); o.y = pk2(silu2_(v0[2], bflo(g.y)), silu2_(v0[3], bfhi(g.y)));
            o.z = pk2(silu2_(v1[0], bflo(g.z)), silu2_(v1[1], bfhi(g.z))); o.w = pk2(silu2_(v1[2], bflo(g.w)), silu2_(v1[3], bfhi(g.w)));
            *(u32x4*)(y + (size_t)(row0 + st * 32 + 4 * wave + tt) * D + 8u * lane) = o;
        }
    }
}
__device__ __forceinline__ void even_b_block(const bf16_t* z, bf16_t* y, const float* lvg, const float* lvb, const bf16_t* WsM  , const float* bs  , int blk, MK_LAS unsigned char* lds) {
    int tid_ = threadIdx.x; asm volatile("" : "+v"(tid_));
    const int tid = tid_, lane = tid & 63, wave = __builtin_amdgcn_readfirstlane(tid >> 6);
    const int brow0 = blk * 128;
    const f32x4 g0 = *(const f32x4*)(lvg + 8 * lane), g1 = *(const f32x4*)(lvg + 8 * lane + 4), b0 = *(const f32x4*)(lvb + 8 * lane), b1 = *(const f32x4*)(lvb + 8 * lane + 4);
    for (int grp = 0; grp < 2; ++grp) {
        const int t0 = 16 * wave + 8 * grp;
        const bf16_t* zr = z + (size_t)(brow0 + t0) * NB + 2048 + 8 * lane;
        u32x4 raw[8];
#pragma unroll
        for (int tt = 0; tt < 8; ++tt) raw[tt] = *(const u32x4*)(zr + (size_t)tt * NB);
        u32x4 outp[8];
#pragma unroll
        for (int p = 0; p < 4; ++p) {
            f32x4 va[2][2];
#pragma unroll
            for (int e = 0; e < 2; ++e) { const u32x4 r = raw[2 * p + e];
                f32x4 v0 = (f32x4){geluf_(bflo(r.x)), geluf_(bfhi(r.x)), geluf_(bflo(r.y)), geluf_(bfhi(r.y))}, v1 = (f32x4){geluf_(bflo(r.z)), geluf_(bfhi(r.z)), geluf_(bflo(r.w)), geluf_(bfhi(r.w))};
                float s = ((v0[0] + v0[1]) + (v0[2] + v0[3])) + ((v1[0] + v1[1]) + (v1[2] + v1[3]));
                float s2 = ((v0[0] * v0[0] + v0[1] * v0[1]) + (v0[2] * v0[2] + v0[3] * v0[3])) + ((v1[0] * v1[0] + v1[1] * v1[1]) + (v1[2] * v1[2] + v1[3] * v1[3]));
                s = wave_sum(s); s2 = wave_sum(s2);
                const float mean = s * (1.f / WB), var = s2 * (1.f / WB) - mean * mean, rstd = 1.f / sqrtf(fmaxf(var, 0.f) + LN_EPS);
                va[e][0] = (v0 - mean) * rstd * g0 + b0; va[e][1] = (v1 - mean) * rstd * g1 + b1; }
#pragma unroll
            for (int i = 0; i < 8; ++i) { const unsigned w = pg8::cvt_pk_bf16(va[0][i >> 2][i & 3], va[1][i >> 2][i & 3]);
                if (p == 0) outp[i].x = w; else if (p == 1) outp[i].y = w; else if (p == 2) outp[i].z = w; else outp[i].w = w; }
        }
        const int cbk = (t0 >> 3) ^ (lane & 15);
#pragma unroll
        for (int i = 0; i < 8; ++i) *(MK_LAS u32x4*)(lds + (8 * lane + i) * 256 + cbk * 16) = outp[i];
    }
    __syncthreads();
    const int h = wave, n = lane & 15, q = lane >> 4;
    for (int nh = 0; nh < 2; ++nh) {
        u32x2 uw[4][4];
#pragma unroll
        for (int nt = 0; nt < 4; ++nt) { const size_t row = (size_t)(brow0 + 16 * (nh * 4 + nt) + n);
#pragma unroll
            for (int mt = 0; mt < 4; ++mt) { const int ch = h * 64 + 16 * mt + 4 * q; uw[nt][mt] = *(const u32x2*)(z + row * NB + 1536 + ch); } }
        f32x4 acc[4][4];
#pragma unroll
        for (int mt = 0; mt < 4; ++mt)
#pragma unroll
            for (int nt = 0; nt < 4; ++nt) acc[mt][nt] = (f32x4){0.f, 0.f, 0.f, 0.f};
#pragma unroll
        for (int ks = 0; ks < 4; ++ks) {
            if (2 * ks <= nh * 4 + 3) {
                bf16x8 a[4];
#pragma unroll
                for (int mt = 0; mt < 4; ++mt) { const int row = h * 64 + 16 * mt + n; a[mt] = *(const MK_LAS bf16x8*)(lds + row * 256 + (((4 * ks + q) ^ ((row >> 3) & 15)) * 16)); }
#pragma unroll
                for (int nt = 0; nt < 4; ++nt) {
                    const int ntg = nh * 4 + nt;
                    if (2 * ks <= ntg) {
                        const bf16x8 b = *(const bf16x8*)(WsM + ((size_t)h * 128 + 16 * ntg + n) * 128 + 32 * ks + 8 * q);
#pragma unroll
                        for (int mt = 0; mt < 4; ++mt) acc[mt][nt] = __builtin_amdgcn_mfma_f32_16x16x32_bf16(a[mt], b, acc[mt][nt], 0, 0, 0);
                    }
                }
            }
        }
#pragma unroll
        for (int nt = 0; nt < 4; ++nt) {
            const int t = 16 * (nh * 4 + nt) + n; const size_t row = (size_t)(brow0 + t); const float bsv = bs[h * 128 + t];
#pragma unroll
            for (int mt = 0; mt < 4; ++mt) {
                const int ch = h * 64 + 16 * mt + 4 * q;
                const u32x2 u2 = uw[nt][mt];
                const float o0 = bflo(u2.x) * (acc[mt][nt][0] + bsv), o1 = bfhi(u2.x) * (acc[mt][nt][1] + bsv), o2 = bflo(u2.y) * (acc[mt][nt][2] + bsv), o3 = bfhi(u2.y) * (acc[mt][nt][3] + bsv);
                u32x2 w; w.x = pk2(o0, o1); w.y = pk2(o2, o3); *(u32x2*)(y + row * D + 512 + ch) = w;
            }
        }
    }
    __syncthreads();
}

__device__ __forceinline__ MK_LAS unsigned short* c_elem(MK_LAS unsigned char* lds, int r, int c) { return (MK_LAS unsigned short*)(lds + r * 1024 + ((((c >> 3) ^ (r & 15))) * 16) + (c & 7) * 2); }
template <int G>
__device__ __forceinline__ void odd_c_pool(MK_LAS unsigned char* lds, int c_, bool seqstart) {
    int c = c_; asm volatile("" : "+v"(c));
    constexpr int WIN = 2 << G;
    float ring[WIN]; float sum = 0.f;
#pragma unroll
    for (int i = 0; i < WIN; ++i) ring[i] = 0.f;
#pragma unroll
    for (int h = 16 - WIN; h < 15; ++h) {
        const float v = seqstart ? 0.f : bf2f(*c_elem(lds, h, c));
        sum += v; ring[(h + 1) % WIN] = v; }
#pragma unroll 1
    for (int t0 = 0; t0 < 128; t0 += 16) {
#pragma unroll
        for (int i = 0; i < 16; ++i) {
            const int tt = t0 + i; MK_LAS unsigned short* p = c_elem(lds, tt + 15, c);
            const float v = bf2f(*p);
            sum += v - ring[i % WIN]; ring[i % WIN] = v;
            const float inv = (seqstart && tt < WIN) ? 1.0f / (float)(tt + 1) : 1.0f / (float)WIN;
            *p = f2bf(sum * inv - v);
        }
    }
}
template <int G>
__device__ __forceinline__ void odd_c_mma(const bf16_t* z, bf16_t* y, const float* pscale, const MK_LAS unsigned char* lds, int srow0, int half, int n_, int q_, const bf16x8 (&afr)[8][4]) {
    int n = n_, q = q_; asm volatile("" : "+v"(n), "+v"(q));
#pragma unroll 1
    for (int tl = 0; tl < 4; ++tl) {
        const int tloc = (half * 4 + tl) * 16 + n, row = srow0 + tloc, r = tloc + 15;
        u32x2 gwd[8];
#pragma unroll
        for (int mt = 0; mt < 8; ++mt) gwd[mt] = *(const u32x2*)(z + (size_t)row * NB + 512 + G * 128 + 16 * mt + 4 * q);
        f32x4 acc[8];
#pragma unroll
        for (int mt = 0; mt < 8; ++mt) acc[mt] = (f32x4){0.f, 0.f, 0.f, 0.f};
#pragma unroll
        for (int ks = 0; ks < 4; ++ks) {
            const bf16x8 bfrag = *(const MK_LAS bf16x8*)(lds + r * 1024 + (((G * 16 + 4 * ks + q) ^ (r & 15)) * 16));
#pragma unroll
            for (int mt = 0; mt < 8; ++mt) acc[mt] = __builtin_amdgcn_mfma_f32_16x16x32_bf16(afr[mt][ks], bfrag, acc[mt], 0, 0, 0);
        }
#pragma unroll
        for (int mt = 0; mt < 8; ++mt) {
            const int ch = G * 128 + 16 * mt + 4 * q;
            const f32x4 ps = *(const f32x4*)(pscale + ch);
            u32x2 w; w.x = pk2(acc[mt][0] * ps[0] * siluf_(bflo(gwd[mt].x)), acc[mt][1] * ps[1] * siluf_(bfhi(gwd[mt].x)));
            w.y = pk2(acc[mt][2] * ps[2] * siluf_(bflo(gwd[mt].y)), acc[mt][3] * ps[3] * siluf_(bfhi(gwd[mt].y)));
            *(u32x2*)(y + (size_t)row * D + ch) = w;
        }
    }
}
template <int G>
__device__ __forceinline__ void odd_c_group(const bf16_t* z, bf16_t* y, const bf16_t* WpT, const float* pscale, MK_LAS unsigned char* lds, int half, int tid, int n, int q) {
    bf16x8 afr[8][4];
#pragma unroll
    for (int mt = 0; mt < 8; ++mt)
#pragma unroll
        for (int ks = 0; ks < 4; ++ks) afr[mt][ks] = *(const bf16x8*)(WpT + ((size_t)G * 128 + 16 * mt + n) * 128 + 32 * ks + 8 * q);
    for (int run = blockIdx.x; run < M / 256; run += gridDim.x) {
        for (int sub = 0; sub < 2; ++sub) {
            const int srow0 = run * 256 + sub * 128;
            { int tl_ = tid; asm volatile("" : "+v"(tl_)); const int bk = tl_ & 63, r8 = tl_ >> 6;
#pragma unroll
              for (int hb = 0; hb < 3; ++hb) {
                  u32x4 st[6];
#pragma unroll
                  for (int i = 0; i < 6; ++i) { const int r = (hb * 6 + i) * 8 + r8; int grow = srow0 - 15 + (r < 143 ? r : 142); grow = grow < 0 ? 0 : grow; st[i] = *(const u32x4*)(z + (size_t)grow * NB + 8 * bk); }
#pragma unroll
                  for (int i = 0; i < 6; ++i) { const int r = (hb * 6 + i) * 8 + r8; if (r < 143) *(MK_LAS u32x4*)(lds + r * 1024 + ((bk ^ (r & 15)) * 16)) = st[i]; }
                  asm volatile("" ::: "memory");
              } }
            __syncthreads();
            odd_c_pool<G>(lds, tid, (srow0 & (SEQ - 1)) == 0);
            __syncthreads();
            odd_c_mma<G>(z, y, pscale, lds, srow0, half, n, q, afr);
            __syncthreads();
        }
    }
}
__device__ __forceinline__ void unpack8(const u32x4 w, float (&f)[8]) { f[0] = bflo(w.x); f[1] = bfhi(w.x); f[2] = bflo(w.y); f[3] = bfhi(w.y); f[4] = bflo(w.z); f[5] = bfhi(w.z); f[6] = bflo(w.w); f[7] = bfhi(w.w); }
__device__ __forceinline__ void odd_mixer(const bf16_t* z, bf16_t* y, const bf16_t* WpT  , const float* pscale, const float* cdw  , MK_LAS unsigned char* lds) {
    int tid_ = threadIdx.x; asm volatile("" : "+v"(tid_));
    const int tid = tid_, lane = tid & 63, wave = __builtin_amdgcn_readfirstlane(tid >> 6);
    const int n = lane & 15, q = lane >> 4;
    { const int g = wave >> 1, half = wave & 1;
      if (g == 0) odd_c_group<0>(z, y, WpT, pscale, lds, half, tid, n, q);
      else if (g == 1) odd_c_group<1>(z, y, WpT, pscale, lds, half, tid, n, q);
      else if (g == 2) odd_c_group<2>(z, y, WpT, pscale, lds, half, tid, n, q);
      else odd_c_group<3>(z, y, WpT, pscale, lds, half, tid, n, q); }
    const int c8 = lane * 8;
    f32x4 wa[3], wb[3];
#pragma unroll
    for (int k = 0; k < 3; ++k) { wa[k] = *(const f32x4*)(cdw + k * WB + c8); wb[k] = *(const f32x4*)(cdw + k * WB + c8 + 4); }
    for (int run = blockIdx.x; run < M / 256; run += gridDim.x) {
        const int r0 = run * 256 + 32 * wave, pos = r0 & (SEQ - 1);
        const bf16_t* zr = z + (size_t)r0 * NB + c8;
        float pm1[8], pm2[8];
        { const int bk = pos > 0 ? 1 : 0;
          const u32x4 d1 = *(const u32x4*)(zr - (ptrdiff_t)bk * NB + 1024), d2 = *(const u32x4*)(zr - (ptrdiff_t)(2 * bk) * NB + 1024);
          float a[8]; unpack8(d1, a);
#pragma unroll
          for (int e = 0; e < 8; ++e) pm1[e] = bk ? a[e] : 0.f;
          unpack8(d2, a);
#pragma unroll
          for (int e = 0; e < 8; ++e) pm2[e] = bk ? a[e] : 0.f; }
        for (int i0 = 0; i0 < 32; i0 += 4) {
            u32x4 dd[4], db[4];
#pragma unroll
            for (int i = 0; i < 4; ++i) { const bf16_t* p = zr + (size_t)(i0 + i) * NB; dd[i] = *(const u32x4*)(p + 1024); db[i] = *(const u32x4*)(p + 1536); }
#pragma unroll
            for (int i = 0; i < 4; ++i) {
                float pc[8], dbf[8], o[8]; unpack8(dd[i], pc); unpack8(db[i], dbf);
#pragma unroll
                for (int e = 0; e < 8; ++e) {
                    const float w0 = e < 4 ? wa[0][e & 3] : wb[0][e & 3], w1 = e < 4 ? wa[1][e & 3] : wb[1][e & 3], w2 = e < 4 ? wa[2][e & 3] : wb[2][e & 3];
                    const float conv = w0 * pm2[e] + w1 * pm1[e] + w2 * pc[e];
                    o[e] = dbf[e] * conv; pm2[e] = pm1[e]; pm1[e] = pc[e]; }
                u32x4 ow; ow.x = pk2(o[0], o[1]); ow.y = pk2(o[2], o[3]); ow.z = pk2(o[4], o[5]); ow.w = pk2(o[6], o[7]);
                *(u32x4*)(y + (size_t)(r0 + i0 + i) * D + 512 + c8) = ow;
            }
        }
    }
}

__global__ void __launch_bounds__(512) fwd_megakernel(Params P, int ph_lo, int ph_hi) {
    extern __shared__ __attribute__((aligned(16))) unsigned char lds_raw[];
    MK_LAS unsigned char* lds = (MK_LAS unsigned char*)lds_raw;
    cg::grid_group grid = cg::this_grid();
    if (threadIdx.x == 0) { ((MK_LAS unsigned*)(lds + LDS_BYTES - 16))[0] = 0u; ((MK_LAS unsigned*)(lds + LDS_BYTES - 16))[1] = 0u; }
    __syncthreads();
    const XcdBarrier xbar = xcd_barrier_post((unsigned*)(P.ws + WS_BAR), (volatile LAS unsigned*)(lds + LDS_BYTES - 16));
    int ph = 0;
#define MK_IN() (ph_lo <= ph && ph < ph_hi)
#define MK_STAGGER(ticks) do { if ((ticks) > 0 && ((blockIdx.x >> 3) & 1)) { const unsigned long long t0_ = __builtin_amdgcn_s_memrealtime(); while (__builtin_amdgcn_s_memrealtime() - t0_ < (unsigned long long)(ticks)) __builtin_amdgcn_s_sleep(16); } } while (0)
#define MK_SEAM() do { if (ph_lo <= ph && ph + 1 < ph_hi) { for (int r_ = 0; r_ < REP_SYNC; ++r_) { if (ph_hi < 0) grid.sync(); else xcd_barrier(xbar); } } ++ph; } while (0)
    if (MK_IN()) { for (int r0_ = 0; r0_ < REP_P0; ++r0_) { p0_prologue(P, lds); __syncthreads(); } }
    MK_SEAM();
#pragma clang loop unroll(disable)
    for (int l0 = 0; l0 < DEPTH; ++l0) {
#define MK_LAUNDER() int l = l0; asm volatile("" : "+s"(l)); const int j = l >> 1; const bool odd = l & 1; unsigned char* ws = P.ws; asm volatile("" : "+s"(ws)); bf16_t* xcur = (bf16_t*)(ws + WS_XB); bf16_t* tbuf = (bf16_t*)(ws + WS_XB) + (size_t)M * D; bf16_t* z = (bf16_t*)(ws + WS_Z); bf16_t* yb = (bf16_t*)(ws + WS_Y); bf16_t* ple = (bf16_t*)(ws + WS_Z);
        if (MK_IN()) { MK_LAUNDER()
            pg8::Gemm g{xcur, (const bf16_t*)(ws + WS_WIN) + (size_t)l * NB * D, M, NB, D}; pg8::StaticOrder S; S.init(M, NB, (int)gridDim.x, (int)blockIdx.x);
            { const float* bsrc = (odd ? P.in[15] : P.in[3]) + (size_t)j * NB; MK_LAS float* lb = (MK_LAS float*)(lds + 131072);
              int ti_ = threadIdx.x; asm volatile("" : "+v"(ti_));
              for (int i = ti_; i < NB; i += NTHREADS) lb[i] = bsrc[odd ? orig_col_odd(i) : orig_col_even(i)];
              __syncthreads(); }
            EpiZ E{z, NB, (const MK_LAS float*)(lds + 131072), odd ? 1 : 2};
            MK_STAGGER(STAG1);
            for (int rep = 0; rep < REP_P1; ++rep) pg8::gemm_phase<EpiZ, pg8::StaticOrder, MK_ALIGN_EPI, MK_SP2>(lds, g, S, E);
        }
        MK_SEAM();
        if (MK_IN()) { MK_LAUNDER()
            for (int rep = 0; rep < (odd ? REP_P2O : REP_P2E); ++rep)
            if (!odd) {
                for (int run = blockIdx.x; run < M / 256; run += gridDim.x) {
                    for (int ra = 0; ra < REP_A; ++ra) even_a_branch(z, yb, P.in[4] + (size_t)j * 31 * WB, P.in[5] + j * WB, P.in[6] + j * WB, P.in[7] + j * WB, run, lds);
                    __syncthreads();
                    for (int bb = 0; bb < 2; ++bb)
                        even_b_block(z, yb, P.in[8] + j * WB, P.in[9] + j * WB, (const bf16_t*)(ws + WS_WS) + (size_t)j * 8 * 128 * 128, P.in[11] + j * 8 * 128, run * 2 + bb, lds);
                }
            } else {
                odd_mixer(z, yb, (const bf16_t*)(ws + WS_WP) + (size_t)j * 4 * 128 * 128, P.in[17] + j * WB, P.in[18] + (size_t)j * 3 * WB, lds);
            }
        }
        MK_SEAM();
        if (MK_IN()) { MK_LAUNDER()
            { pg8::Gemm g{yb, (const bf16_t*)(ws + WS_WOUT) + (size_t)l * D * D, M, D, D}; pg8::StaticOrder S; S.init(M, D, (int)gridDim.x, (int)blockIdx.x);
              MK_STAGGER(STAG3);
              EpiT E{xcur, tbuf, (odd ? P.in[20] : P.in[13]) + (size_t)j * D, (float*)(ws + WS_STATS)};
#if REP_K3
              { EpiNull EN; pg8::gemm_phase<EpiNull, pg8::StaticOrder, MK_ALIGN_EPI, MK_SP2>(lds, g, S, EN); }
#endif
              pg8::gemm_phase<EpiT, pg8::StaticOrder, MK_ALIGN_EPI, MK_SP2>(lds, g, S, E); }
            { pg8::Gemm g{(const bf16_t*)(ws + WS_PB) + (size_t)l * M * DP, (const bf16_t*)(ws + WS_WPLE) + (size_t)l * D * DP, M, D, DP}; pg8::StaticOrder S; S.init(M, D, (int)gridDim.x, (int)blockIdx.x);
              EpiZ E{ple, D, nullptr, 0};
              for (int rp_ = 0; rp_ < REP_PLE; ++rp_) pg8::gemm_phase<EpiZ, pg8::StaticOrder, MK_ALIGN_EPI, MK_SP2>(lds, g, S, E); }
        }
        MK_SEAM();
        if (MK_IN()) { MK_LAUNDER()
            pg8::Gemm g{tbuf, (const bf16_t*)(ws + WS_WGATE) + (size_t)l * D * D, M, D, D}; pg8::StaticOrder S; S.init(M, D, (int)gridDim.x, (int)blockIdx.x);
            const float* c12 = (const float*)(ws + WS_C12) + (size_t)l * 2 * D;
            { int ti_ = threadIdx.x; asm volatile("" : "+v"(ti_)); MK_LAS float* lvw = (MK_LAS float*)(lds + 131072);
              const float* lg_ = P.in[21] + (size_t)l * D; const float* lb_ = P.in[22] + (size_t)l * D;
              for (int i = ti_; i < 1024; i += NTHREADS) { const int vec = i >> 8, idx = (i & 255) * 4; const float* src = vec == 0 ? lg_ : vec == 1 ? lb_ : vec == 2 ? c12 : c12 + D;
                  *(MK_LAS f32x4*)(lvw + vec * 1024 + idx) = *(const f32x4*)(src + idx); }
              __syncthreads(); }
            MK_STAGGER(STAG5);
            EpiGate2 E{tbuf, ple, xcur, (l == DEPTH - 1) ? P.out : nullptr, (const float*)(ws + WS_STATS), (const MK_LAS float*)(lds + 131072)};
            for (int r5_ = 0; r5_ < REP_P5; ++r5_) pg8::gemm_phase<EpiGate2, pg8::StaticOrder, MK_ALIGN_EPI, MK_SP2>(lds, g, S, E);
        }
        MK_SEAM();
    }
#undef MK_IN
#undef MK_LAUNDER
#undef MK_SEAM
}
}

extern "C" void kernel_launch(void* const* d_in, const int* in_sizes, int n_in, void* d_out, int out_size, void* d_ws, size_t ws_size, hipStream_t stream) {
    static int ready = 0;
    if (!ready) {
        if (n_in != 26 || out_size != mk::M * mk::D || ws_size < mk::WS_END) { fprintf(stderr, "kernel_launch: unexpected shapes (n_in %d out %d ws %zu need %zu)\n", n_in, out_size, ws_size, (size_t)mk::WS_END); }
        if (hipFuncSetAttribute((const void*)mk::fwd_megakernel, hipFuncAttributeMaxDynamicSharedMemorySize, mk::LDS_BYTES) != hipSuccess) fprintf(stderr, "kernel_launch: hipFuncSetAttribute failed\n");
        ready = 1;
    }
    (void)hipMemsetAsync((unsigned char*)d_ws + mk::WS_BAR, 0, (size_t)XCD_BAR_WORDS * 4, stream);
    mk::Params P{};
    for (int i = 0; i < 26; ++i) P.in[i] = (const float*)d_in[i];
    P.out = (float*)d_out; P.ws = (unsigned char*)d_ws;
    int lo = 0, hi = 1 + 4 * mk::DEPTH;
    void* args[] = {&P, &lo, &hi};
    hipError_t e = hipLaunchCooperativeKernel((const void*)mk::fwd_megakernel, dim3(256), dim3(mk::NTHREADS), args, mk::LDS_BYTES, stream);
    if (e != hipSuccess) fprintf(stderr, "cooperative launch failed: %s\n", hipGetErrorString(e));
}
```
